# Optimizing an MI355X kernel written in HIP

```python
import math
import jax
import jax.numpy as jnp
from jax import lax
import numpy as np


D_MODEL = 1024
BATCH = 16
SEQ = 2048
DEPTH = 1

CTX_LEN = 256
GRID_W = 64
EPS = 1e-6

N_ATTN_HEADS = 8
ATTN_DH = 64
ATTN_DV = 2 * ATTN_DH
ATTN_QK_DIM = N_ATTN_HEADS * 2 * ATTN_DH
ATTN_V_DIM = N_ATTN_HEADS * ATTN_DV
ATTN_SCALE = ATTN_DH ** -0.5
ATTN_QBLOCK = 128
ROPE_THETA = 10000.0
ROPE_AXIS_DIM = ATTN_DH // 2

D_SSD = D_MODEL
SSD_HEADDIM = 64
SSD_HEADS = D_SSD // SSD_HEADDIM
SSD_GROUPS = 4
SSD_HPG = SSD_HEADS // SSD_GROUPS
SSD_STATE = 128
SSD_CONV_W = 3
SSD_CHUNK = 64
XBC_DIM = D_SSD + 2 * SSD_GROUPS * SSD_STATE

IN_SPLITS = (ATTN_QK_DIM, 2 * ATTN_QK_DIM, 2 * ATTN_QK_DIM + ATTN_V_DIM, 2 * ATTN_QK_DIM + ATTN_V_DIM + D_SSD, 2 * ATTN_QK_DIM + ATTN_V_DIM + D_SSD + XBC_DIM, 2 * ATTN_QK_DIM + ATTN_V_DIM + D_SSD + XBC_DIM + 2 * SSD_HEADS)
IN_COLS = IN_SPLITS[-1] + 2 * D_MODEL

N_EXPERTS = 64
EXPERT_FF = 256
SHARED_FF = 256
TOP_K = 8
N_EXPERT_GROUPS = 8
TOPK_GROUPS = 4
ROUTED_SCALE = 2.5
MOE_BLOCK = 128

kernel_name = 'hybrid_diffattn_ssd_moe_dit_layer'


def rmsnorm(u, g):
    uf = u.astype(jnp.float32)
    y = uf * lax.rsqrt(jnp.mean(uf * uf, axis=-1, keepdims=True) + EPS)
    return (y * g.astype(jnp.float32)).astype(u.dtype)


def modulate(u, shift, scale):
    return u * (1 + scale) + shift


def rev(t):
    return jnp.flip(t, axis=1)


def axial_rope_tables(n_tok):
    rows = n_tok // GRID_W
    row = jnp.repeat(jnp.arange(rows, dtype=jnp.float32), GRID_W)
    col = jnp.broadcast_to(jnp.arange(GRID_W, dtype=jnp.float32)[None, :], (rows, GRID_W)).reshape(-1)
    inv_freq = ROPE_THETA ** (-jnp.arange(0, ROPE_AXIS_DIM, 2, dtype=jnp.float32) / ROPE_AXIS_DIM)
    ang = jnp.concatenate([row[:, None] * inv_freq, col[:, None] * inv_freq], axis=-1)
    ang = jnp.concatenate([ang, ang], axis=-1)
    return jnp.cos(ang), jnp.sin(ang)


def apply_rope(u, cos, sin):
    half = ATTN_DH // 2
    uf = u.astype(jnp.float32)
    rot = jnp.concatenate([-uf[..., half:], uf[..., :half]], axis=-1)
    return (uf * cos[:, None, None, :] + rot * sin[:, None, None, :]).astype(u.dtype)


def diff_attend(q, k, v, lam, g_subln, lam_init):
    s = jnp.einsum('bqhcd,bkhcd->bchqk', q.astype(jnp.float32), k.astype(jnp.float32)) * ATTN_SCALE
    p = jax.nn.softmax(s, axis=-1)
    w = p[:, 0] - lam * p[:, 1]
    o = jnp.einsum('bhqk,bkhd->bqhd', w, v.astype(jnp.float32))
    o = o * lax.rsqrt(jnp.mean(o * o, axis=-1, keepdims=True) + EPS) * g_subln.astype(jnp.float32)
    return (o * (1.0 - lam_init)).astype(v.dtype)


def centred_dwconv(u, w, b):
    pad = SSD_CONV_W // 2
    n = u.shape[1]
    up = jnp.pad(u, ((0, 0), (pad, pad), (0, 0)))
    out = b
    for i in range(SSD_CONV_W):
        out = out + up[:, i:i + n] * w[i]
    return out


def ssd_inputs(xbc, dt_raw, conv_w, conv_b, dt_bias):
    nb, nl, _ = xbc.shape
    u = jax.nn.silu(centred_dwconv(xbc, conv_w, conv_b)).astype(jnp.float32)
    xs, bm, cm = jnp.split(u, (D_SSD, D_SSD + SSD_GROUPS * SSD_STATE), axis=-1)
    xh = xs.reshape(nb, nl, SSD_GROUPS, SSD_HPG, SSD_HEADDIM)
    bm = bm.reshape(nb, nl, SSD_GROUPS, SSD_STATE)
    cm = cm.reshape(nb, nl, SSD_GROUPS, SSD_STATE)
    dt = jax.nn.softplus(dt_raw.astype(jnp.float32).reshape(nb, nl, 2, SSD_GROUPS, SSD_HPG) + dt_bias.astype(jnp.float32).reshape(2, SSD_GROUPS, SSD_HPG))
    return xh, bm, cm, dt[:, :, 0], dt[:, :, 1]


def ssd_chunked(xh, dt, a, bm, cm, h0, with_output):
    nb, nl, ng, nr, npd = xh.shape
    nn = bm.shape[-1]
    nc = nl // SSD_CHUNK
    xc = xh.reshape(nb, nc, SSD_CHUNK, ng, nr, npd)
    dtc = dt.reshape(nb, nc, SSD_CHUNK, ng, nr)
    bc = bm.reshape(nb, nc, SSD_CHUNK, ng, nn)
    acum = jnp.cumsum(dtc * a, axis=2)
    to_end = jnp.exp(acum[:, :, -1:] - acum)
    states = jnp.einsum('bcqgn,bcqgr,bcqgrp->bcgrpn', bc, to_end * dtc, xc)
    chunk_decay = jnp.exp(acum[:, :, -1])

    def step(h, inp):
        st, dec = inp
        return h * dec[..., None, None] + st, (h if with_output else None)

    h_last, h_prev = lax.scan(step, h0, (jnp.moveaxis(states, 1, 0), jnp.moveaxis(chunk_decay, 1, 0)))
    if not with_output:
        return None, h_last
    cc = cm.reshape(nb, nc, SSD_CHUNK, ng, nn)
    seg = acum[:, :, :, None] - acum[:, :, None]
    lower = (jnp.arange(SSD_CHUNK)[:, None] >= jnp.arange(SSD_CHUNK)[None, :])[:, :, None, None]
    decay = jnp.where(lower, jnp.exp(jnp.where(lower, seg, 0.0)), 0.0)
    cb = jnp.einsum('bcign,bcjgn->bcijg', cc, bc)
    y_diag = jnp.einsum('bcijg,bcijgr,bcjgr,bcjgrp->bcigrp', cb, decay, dtc, xc)
    y_off = jnp.einsum('bcign,cbgrpn,bcigr->bcigrp', cc, h_prev, jnp.exp(acum))
    y = (y_diag + y_off).reshape(nb, nl, ng, nr, npd)
    return y, h_last


def merge_branches(o_attn, y_ssd, z, gates, g_ssd_norm, w_branch_attn, w_branch_ssd, w_out):
    out_dtype = z.dtype
    y = y_ssd * jax.nn.silu(z.astype(jnp.float32))
    shp = y.shape
    yg = y.reshape(shp[:-1] + (SSD_GROUPS, D_SSD // SSD_GROUPS))
    yg = yg * lax.rsqrt(jnp.mean(yg * yg, axis=-1, keepdims=True) + EPS)
    y = (yg.reshape(shp) * g_ssd_norm.astype(jnp.float32)).astype(out_dtype)
    ya = o_attn @ w_branch_attn
    ys = y @ w_branch_ssd
    g_a, g_s = jnp.split(jax.nn.sigmoid(gates), 2, axis=-1)
    return (g_a * ya + g_s * ys) @ w_out


def token_mixer(h, hc, update_ctx, lam_init, w_in, lam_q1, lam_k1, lam_q2, lam_k2, g_attn_subln, conv_w, conv_b, dt_bias, a_log, d_skip, g_ssd_norm, w_branch_attn, w_branch_ssd, w_out):
    nb, ns, _ = h.shape
    nl = hc.shape[1]
    w_q, w_k, w_v, w_z, w_xbc, w_dt, w_g = jnp.split(w_in, IN_SPLITS, axis=1)
    q, k, v, z, xbc, dt_raw, gates = jnp.split(h @ w_in, IN_SPLITS, axis=-1)

    lam = (jnp.exp(jnp.sum(lam_q1.astype(jnp.float32) * lam_k1.astype(jnp.float32)))
           - jnp.exp(jnp.sum(lam_q2.astype(jnp.float32) * lam_k2.astype(jnp.float32))) + lam_init)
    cos, sin = axial_rope_tables(ns)
    q = apply_rope(q.reshape(nb, ns, N_ATTN_HEADS, 2, ATTN_DH), cos, sin)
    k = apply_rope(k.reshape(nb, ns, N_ATTN_HEADS, 2, ATTN_DH), cos, sin)
    v = v.reshape(nb, ns, N_ATTN_HEADS, ATTN_DV)
    kc = (hc @ w_k).reshape(nb, nl, N_ATTN_HEADS, 2, ATTN_DH)
    vc = (hc @ w_v).reshape(nb, nl, N_ATTN_HEADS, ATTN_DV)
    k_all = jnp.concatenate([kc, k], axis=1)
    v_all = jnp.concatenate([vc, v], axis=1)
    n_qb = ns // ATTN_QBLOCK
    q_blocks = jnp.swapaxes(q.reshape(nb, n_qb, ATTN_QBLOCK, N_ATTN_HEADS, 2, ATTN_DH), 0, 1)
    o = lax.map(lambda qb: diff_attend(qb, k_all, v_all, lam, g_attn_subln, lam_init), q_blocks)
    o_lat = jnp.swapaxes(o, 0, 1).reshape(nb, ns, ATTN_V_DIM)

    a = -jnp.exp(a_log.astype(jnp.float32)).reshape(2, SSD_GROUPS, SSD_HPG)
    d = d_skip.astype(jnp.float32).reshape(SSD_GROUPS, SSD_HPG, 1)
    xh_c, bm_c, cm_c, dtf_c, dtb_c = ssd_inputs(hc @ w_xbc, hc @ w_dt, conv_w, conv_b, dt_bias)
    h0 = jnp.zeros((nb, SSD_GROUPS, SSD_HPG, SSD_HEADDIM, SSD_STATE), jnp.float32)
    yf_c, hf = ssd_chunked(xh_c, dtf_c, a[0], bm_c, cm_c, h0, update_ctx)
    yb_c, hb = ssd_chunked(rev(xh_c), rev(dtb_c), a[1], rev(bm_c), rev(cm_c), h0, update_ctx)
    xh, bm, cm, dtf, dtb = ssd_inputs(xbc, dt_raw, conv_w, conv_b, dt_bias)
    yf, _ = ssd_chunked(xh, dtf, a[0], bm, cm, hf, True)
    yb, _ = ssd_chunked(rev(xh), rev(dtb), a[1], rev(bm), rev(cm), hb, True)
    y_lat = (yf + rev(yb) + d * xh).reshape(nb, ns, D_SSD)

    out_lat = merge_branches(o_lat, y_lat, z, gates, g_ssd_norm, w_branch_attn, w_branch_ssd, w_out)
    if not update_ctx:
        return out_lat, None
    qc = (hc @ w_q).reshape(nb, nl, N_ATTN_HEADS, 2, ATTN_DH)
    o_ctx = diff_attend(qc, kc, vc, lam, g_attn_subln, lam_init).reshape(nb, nl, ATTN_V_DIM)
    y_ctx = (yf_c + rev(yb_c) + d * xh_c).reshape(nb, nl, D_SSD)
    out_ctx = merge_branches(o_ctx, y_ctx, hc @ w_z, hc @ w_g, g_ssd_norm, w_branch_attn, w_branch_ssd, w_out)
    return out_lat, out_ctx


def moe_ffn(h, w_router, router_bias, w_e_gate, w_e_up, w_e_down, w_sh_gate, w_sh_up, w_sh_down):
    n_tok, d = h.shape
    scores = jax.nn.sigmoid((h @ w_router).astype(jnp.float32))
    sel = scores + router_bias.astype(jnp.float32)
    grp = sel.reshape(n_tok, N_EXPERT_GROUPS, N_EXPERTS // N_EXPERT_GROUPS)
    grp_score = lax.top_k(grp, 2)[0].sum(-1)
    top_g = lax.top_k(grp_score, TOPK_GROUPS)[1]
    gmask = jax.nn.one_hot(top_g, N_EXPERT_GROUPS, dtype=jnp.float32).sum(1) > 0
    emask = jnp.repeat(gmask, N_EXPERTS // N_EXPERT_GROUPS, axis=1)
    top_e = lax.top_k(jnp.where(emask, sel, -jnp.inf), TOP_K)[1]
    wts = jnp.take_along_axis(scores, top_e, axis=1)
    wts = wts / jnp.sum(wts, axis=-1, keepdims=True) * ROUTED_SCALE

    n_assign = n_tok * TOP_K
    n_blocks = -(-n_assign // MOE_BLOCK) + N_EXPERTS
    n_pad = n_blocks * MOE_BLOCK
    e_flat = top_e.reshape(-1)
    order = jnp.argsort(e_flat)
    e_sorted = e_flat[order]
    tok_sorted = (jnp.arange(n_assign, dtype=jnp.int32) // TOP_K)[order]
    w_sorted = wts.reshape(-1)[order]
    counts = jnp.bincount(e_flat, length=N_EXPERTS)
    start = jnp.cumsum(counts) - counts
    padded = (counts + MOE_BLOCK - 1) // MOE_BLOCK * MOE_BLOCK
    pend = jnp.cumsum(padded)
    pstart = pend - padded
    dest = pstart[e_sorted] + jnp.arange(n_assign, dtype=jnp.int32) - start[e_sorted]
    buf_tok = jnp.zeros((n_pad,), jnp.int32).at[dest].set(tok_sorted)
    buf_w = jnp.zeros((n_pad,), jnp.float32).at[dest].set(w_sorted)
    block_e = jnp.minimum(jnp.searchsorted(pend, jnp.arange(n_blocks, dtype=jnp.int32) * MOE_BLOCK, side='right'), N_EXPERTS - 1)

    def expert_block(args):
        tok_b, w_b, e = args
        xb = h[tok_b]
        hid = jax.nn.silu(xb @ w_e_gate[e]) * (xb @ w_e_up[e])
        return (hid @ w_e_down[e]) * w_b[:, None].astype(h.dtype)

    out = lax.map(expert_block, (buf_tok.reshape(n_blocks, MOE_BLOCK), buf_w.reshape(n_blocks, MOE_BLOCK), block_e))
    routed = jax.ops.segment_sum(out.reshape(n_pad, d), buf_tok, num_segments=n_tok)
    shared = (jax.nn.silu(h @ w_sh_gate) * (h @ w_sh_up)) @ w_sh_down
    return routed + shared


def setup_inputs(seed: int = 0) -> dict:
    key = jax.random.key(seed)
    ks = jax.random.split(key, 40)
    f32 = jnp.float32

    def nrm(k, shape, scale):
        return jax.random.normal(k, shape, f32) * scale

    def gain(k, shape):
        return 1.0 + 0.05 * jax.random.normal(k, shape, f32)

    u_dt = jax.random.uniform(ks[18], (DEPTH, 2, SSD_HEADS), f32)
    dt0 = jnp.exp(u_dt * (math.log(0.1) - math.log(0.001)) + math.log(0.001))
    return {
        'x': nrm(ks[0], (BATCH, SEQ, D_MODEL), 1.0),
        'c': nrm(ks[1], (BATCH, D_MODEL), 1.0),
        'ctx': nrm(ks[2], (BATCH, CTX_LEN, D_MODEL), 1.0),
        'c_ctx': nrm(ks[3], (D_MODEL,), 1.0),
        'w_ada': nrm(ks[4], (DEPTH, D_MODEL, 6 * D_MODEL), 0.5 * D_MODEL ** -0.5),
        'b_ada': nrm(ks[5], (DEPTH, 6 * D_MODEL), 0.02),
        'g_pre_mix': gain(ks[6], (DEPTH, D_MODEL)),
        'g_post_mix': gain(ks[7], (DEPTH, D_MODEL)),
        'g_pre_ffn': gain(ks[8], (DEPTH, D_MODEL)),
        'g_post_ffn': gain(ks[9], (DEPTH, D_MODEL)),
        'w_in': nrm(ks[10], (DEPTH, D_MODEL, IN_COLS), D_MODEL ** -0.5),
        'lam_q1': nrm(ks[11], (DEPTH, ATTN_DH), 0.1),
        'lam_k1': nrm(ks[12], (DEPTH, ATTN_DH), 0.1),
        'lam_q2': nrm(ks[13], (DEPTH, ATTN_DH), 0.1),
        'lam_k2': nrm(ks[14], (DEPTH, ATTN_DH), 0.1),
        'g_attn_subln': gain(ks[15], (DEPTH, ATTN_DV)),
        'conv_w': nrm(ks[16], (DEPTH, SSD_CONV_W, XBC_DIM), SSD_CONV_W ** -0.5),
        'conv_b': nrm(ks[17], (DEPTH, XBC_DIM), 0.02),
        'dt_bias': dt0 + jnp.log(-jnp.expm1(-dt0)),
        'a_log': jnp.log(jax.random.uniform(ks[19], (DEPTH, 2, SSD_HEADS), f32, 1.0, 16.0)),
        'd_skip': gain(ks[20], (DEPTH, SSD_HEADS)),
        'g_ssd_norm': gain(ks[21], (DEPTH, D_SSD)),
        'w_branch_attn': nrm(ks[22], (DEPTH, ATTN_V_DIM, D_MODEL), ATTN_V_DIM ** -0.5),
        'w_branch_ssd': nrm(ks[23], (DEPTH, D_SSD, D_MODEL), D_SSD ** -0.5),
        'w_out': nrm(ks[24], (DEPTH, D_MODEL, D_MODEL), D_MODEL ** -0.5),
        'w_router': nrm(ks[25], (DEPTH, D_MODEL, N_EXPERTS), D_MODEL ** -0.5),
        'router_bias': nrm(ks[26], (DEPTH, N_EXPERTS), 0.01),
        'w_e_gate': nrm(ks[27], (DEPTH, N_EXPERTS, D_MODEL, EXPERT_FF), D_MODEL ** -0.5),
        'w_e_up': nrm(ks[28], (DEPTH, N_EXPERTS, D_MODEL, EXPERT_FF), D_MODEL ** -0.5),
        'w_e_down': nrm(ks[29], (DEPTH, N_EXPERTS, EXPERT_FF, D_MODEL), EXPERT_FF ** -0.5),
        'w_sh_gate': nrm(ks[30], (DEPTH, D_MODEL, SHARED_FF), D_MODEL ** -0.5),
        'w_sh_up': nrm(ks[31], (DEPTH, D_MODEL, SHARED_FF), D_MODEL ** -0.5),
        'w_sh_down': nrm(ks[32], (DEPTH, SHARED_FF, D_MODEL), SHARED_FF ** -0.5),
    }


def reference(x, c, ctx, c_ctx, w_ada, b_ada, g_pre_mix, g_post_mix, g_pre_ffn, g_post_ffn, w_in, lam_q1, lam_k1, lam_q2, lam_k2, g_attn_subln, conv_w, conv_b, dt_bias, a_log, d_skip, g_ssd_norm, w_branch_attn, w_branch_ssd, w_out, w_router, router_bias, w_e_gate, w_e_up, w_e_down, w_sh_gate, w_sh_up, w_sh_down):
    nb, ns, d = x.shape
    for li in range(DEPTH):
        update_ctx = li < DEPTH - 1
        lam_init = 0.8 - 0.6 * math.exp(-0.3 * li)
        mod = jax.nn.silu(c) @ w_ada[li] + b_ada[li]
        sh1, sc1, gt1, sh2, sc2, gt2 = jnp.split(mod[:, None, :], 6, axis=-1)
        mod_c = jax.nn.silu(c_ctx) @ w_ada[li] + b_ada[li]
        sh1c, sc1c, gt1c, sh2c, sc2c, gt2c = jnp.split(mod_c, 6)

        h = modulate(rmsnorm(x, g_pre_mix[li]), sh1, sc1)
        hc = modulate(rmsnorm(ctx, g_pre_mix[li]), sh1c, sc1c)
        mix, mix_c = token_mixer(h, hc, update_ctx, lam_init, w_in[li], lam_q1[li], lam_k1[li], lam_q2[li], lam_k2[li], g_attn_subln[li], conv_w[li], conv_b[li], dt_bias[li], a_log[li], d_skip[li], g_ssd_norm[li], w_branch_attn[li], w_branch_ssd[li], w_out[li])
        x = x + gt1 * rmsnorm(mix, g_post_mix[li])

        h = modulate(rmsnorm(x, g_pre_ffn[li]), sh2, sc2)
        moe_w = (w_router[li], router_bias[li], w_e_gate[li], w_e_up[li], w_e_down[li], w_sh_gate[li], w_sh_up[li], w_sh_down[li])
        if update_ctx:
            ctx = ctx + gt1c * rmsnorm(mix_c, g_post_mix[li])
            hc = modulate(rmsnorm(ctx, g_pre_ffn[li]), sh2c, sc2c)
            f = moe_ffn(jnp.concatenate([h.reshape(-1, d), hc.reshape(-1, d)], axis=0), *moe_w)
            f_lat = f[: nb * ns]
            ctx = ctx + gt2c * rmsnorm(f[nb * ns:].reshape(ctx.shape), g_post_ffn[li])
        else:
            f_lat = moe_ffn(h.reshape(-1, d), *moe_w)
        x = x + gt2 * rmsnorm(f_lat.reshape(x.shape), g_post_ffn[li])
    return x
```

```cpp
#include <hip/hip_runtime.h>
#include <stdint.h>
#include <stdio.h>

#ifndef N_LAUNCH_MODE
#define N_LAUNCH_MODE 1
#endif

#define LAS __attribute__((address_space(3)))
#define DI __device__ __forceinline__
typedef unsigned short bf16_t;
typedef short bf16x8 __attribute__((ext_vector_type(8)));
typedef float f32x4 __attribute__((ext_vector_type(4)));
typedef float f32x2 __attribute__((ext_vector_type(2)));
typedef float f32x16 __attribute__((ext_vector_type(16)));
typedef unsigned u32x4 __attribute__((ext_vector_type(4)));
typedef unsigned u32x2 __attribute__((ext_vector_type(2)));
typedef __bf16 bf16v2 __attribute__((ext_vector_type(2)));

DI unsigned pk_bf16(float lo, float hi) { f32x2 v = {lo, hi}; bf16v2 b = __builtin_convertvector(v, bf16v2); return __builtin_bit_cast(unsigned, b); }
DI bf16_t f2bf(float x) { return (bf16_t)(pk_bf16(x, 0.f) & 0xffffu); }
DI float bflo(unsigned u) { return __uint_as_float(u << 16); }
DI float bfhi(unsigned u) { return __uint_as_float(u & 0xffff0000u); }
DI float bf2f(bf16_t x) { return __uint_as_float(((unsigned)x) << 16); }
DI float sigmoidf_(float x) { return __builtin_amdgcn_rcpf(1.0f + __expf(-x)); }
DI float siluf_(float x) { return x * __builtin_amdgcn_rcpf(1.0f + __expf(-x)); }
DI int swap23(int i) { return (i & ~12) | ((i & 4) << 1) | ((i & 8) >> 1); }
DI int crow(int reg, int h) { return (reg & 3) + 8 * (reg >> 2) + 4 * h; }
#define MFMA32(a, b, c) __builtin_amdgcn_mfma_f32_32x32x16_bf16((a), (b), (c), 0, 0, 0)
DI bf16x8 pack_step(const f32x16& x, int s) {
    u32x4 p;
    p[0] = pk_bf16(x[8 * s + 0], x[8 * s + 1]); p[1] = pk_bf16(x[8 * s + 2], x[8 * s + 3]);
    p[2] = pk_bf16(x[8 * s + 4], x[8 * s + 5]); p[3] = pk_bf16(x[8 * s + 6], x[8 * s + 7]);
    return __builtin_bit_cast(bf16x8, p);
}
DI float shx(float v, int o, int lane) { return __int_as_float(__builtin_amdgcn_ds_bpermute((lane ^ o) << 2, __float_as_int(v))); }
DI int shxi(int v, int o, int lane) { return __builtin_amdgcn_ds_bpermute((lane ^ o) << 2, v); }
DI float shidx(float v, int src) { return __int_as_float(__builtin_amdgcn_ds_bpermute(src << 2, __float_as_int(v))); }
DI float wave_sum(float v, int lane) {
#pragma unroll
    for (int o = 32; o >= 1; o >>= 1) v += shx(v, o, lane);
    return v;
}

constexpr int NB = 16, SEQ = 2048, DM = 1024, CTXL = 256, SALL = SEQ + CTXL;
constexpr int GB = 8;
constexpr int NGRP = NB / GB;
constexpr int TG = GB * SEQ;
constexpr int CG = GB * CTXL;
constexpr int HR = TG + CG;
constexpr int QT = 8192;
constexpr int NQ = TG / QT;
constexpr int IN_COLS = 8224;
constexpr float EPS = 1e-6f;
constexpr float LAM_INIT = 0.2f;
constexpr float QSCALE = 0.125f * 1.4426950408889634f;
constexpr int NEXP = 64;
constexpr int MAXROWS = QT * 8 + NEXP * 256;
constexpr int SH_ROW0 = MAXROWS;
constexpr int HID_ROWS = MAXROWS + QT;

constexpr size_t AL(size_t x) { return (x + 255) & ~(size_t)255; }
constexpr size_t WS_CTL   = 0;
constexpr size_t CTL_BYTES = 16384;
constexpr size_t WS_MOD   = WS_CTL + CTL_BYTES;
constexpr size_t WS_ROPE  = WS_MOD + AL(17 * 6144 * 4);
constexpr size_t WS_WIN   = WS_ROPE + AL(2048 * 32 * 2 * 4);
constexpr size_t WS_WV    = WS_WIN + AL((size_t)4352 * 1024 * 2);
constexpr size_t WS_WZG   = WS_WV + AL((size_t)1024 * 1024 * 2);
constexpr size_t WS_WA    = WS_WZG + AL((size_t)3072 * 1024 * 2);
constexpr size_t WS_WS    = WS_WA + AL((size_t)1024 * 1024 * 2);
constexpr size_t WS_WO    = WS_WS + AL((size_t)1024 * 1024 * 2);
constexpr size_t WS_W1    = WS_WO + AL((size_t)1024 * 1024 * 2);
constexpr size_t WS_W2    = WS_W1 + AL(((size_t)65 * 512 + 256) * 1024 * 2);
constexpr size_t WS_GRP   = WS_W2 + AL((size_t)65 * 1024 * 256 * 2);
constexpr size_t G_H   = WS_GRP;
constexpr size_t G_Q   = G_H + AL((size_t)HR * 1024 * 2);
constexpr size_t G_K   = G_Q + AL((size_t)TG * 1024 * 2);
constexpr size_t G_VT  = G_K + AL((size_t)GB * SALL * 1024 * 2);
constexpr size_t G_XBC = G_VT + AL((size_t)GB * 1024 * SALL * 2);
constexpr size_t G_DT  = G_XBC + AL((size_t)GB * SALL * 2048 * 2);
constexpr size_t G_O   = G_DT + AL((size_t)GB * SALL * 32 * 4);
constexpr size_t G_YF  = G_O + AL((size_t)TG * 1024 * 2);
constexpr size_t G_YB  = G_YF + AL((size_t)TG * 1024 * 2);
constexpr size_t G_END = G_YB + AL((size_t)TG * 1024 * 2);
constexpr size_t G_YN  = G_Q;
constexpr size_t G_G   = G_XBC;
constexpr size_t G_P   = G_K;
constexpr size_t G_U   = G_VT;
constexpr size_t G_MIX = G_YF;
constexpr size_t G_H2  = G_O;
constexpr size_t M_LOG  = G_H;
constexpr size_t M_TOPE = M_LOG + AL((size_t)QT * 64 * 4);
constexpr size_t M_TOPW = M_TOPE + AL((size_t)QT * 8 * 4);
constexpr size_t M_TPOS = M_TOPW + AL((size_t)QT * 8 * 4);
constexpr size_t M_ROWL = M_TPOS + AL((size_t)QT * 8 * 4);
constexpr size_t M_HID  = M_ROWL + AL((size_t)MAXROWS * 4);
constexpr size_t M_AOUT = M_HID + AL((size_t)HID_ROWS * 256 * 2);
constexpr size_t M_SOUT = M_AOUT + AL((size_t)QT * 8 * 1024 * 2);
constexpr size_t M_END  = M_SOUT + AL((size_t)QT * 1024 * 2);
static_assert(M_END <= G_O, "MoE quarter buffers must fit under H2");
constexpr size_t WS_NEED = G_END;
constexpr int CW_CNT = 3584;

#define XB_TMO      128
#define XB_XCNT(j)  (256  + 64 * (j))
#define XB_XSUB(j)  (1280 + 64 * (j))
#define XB_XGEN(j)  (2304 + 64 * (j))
#define XB_TOP      3328
#define XB_TOPGEN   3392
#define XCD_BAR_WORDS 3456
#define XB_SPIN_CAP (1u << 18)
DI unsigned xb_ld(unsigned* p)              { return __hip_atomic_load(p, __ATOMIC_RELAXED, __HIP_MEMORY_SCOPE_AGENT); }
DI unsigned xb_add(unsigned* p, unsigned v) { return __hip_atomic_fetch_add(p, v, __ATOMIC_RELAXED, __HIP_MEMORY_SCOPE_AGENT); }
DI unsigned xb_xcc_id() { return (unsigned)__builtin_amdgcn_s_getreg((3 << 11) | 20) & 0xFu; }
#define XB_SPIN(cond, bar) do { unsigned _sp = 0; while (cond) { __builtin_amdgcn_s_sleep(1); \
    if ((++_sp & 255u) == 0u) { if (xb_ld(&(bar)[XB_TMO])) break; if (_sp > XB_SPIN_CAP) { atomicAdd(&(bar)[XB_TMO], 1u); break; } } } } while (0)
struct XcdBarrier { unsigned* bar; unsigned x; volatile LAS unsigned* st; };
DI XcdBarrier xcd_barrier_post(unsigned* bar, volatile LAS unsigned* st, int tid) {
    XcdBarrier b; b.bar = bar; b.x = xb_xcc_id(); b.st = st;
    if (tid == 0) (void)xb_add(&bar[XB_XCNT(b.x)], 1u);
    return b;
}
DI void xcd_barrier_complete(unsigned* bar, unsigned x, unsigned& nloc, unsigned& nx) {
    const unsigned G = gridDim.x * gridDim.y * gridDim.z;
    unsigned sum, cnt, mine, sp = 0u;
    for (;;) {
        sum = 0u; cnt = 0u; mine = 0u;
#pragma unroll 1
        for (unsigned j = 0; j < 16; ++j) { const unsigned c = xb_ld(&bar[XB_XCNT(j)]); sum += c; cnt += (c > 0u) ? 1u : 0u; mine = (j == x) ? c : mine; }
        if (sum == G) break;
        __builtin_amdgcn_s_sleep(1);
        if ((++sp & 255u) == 0u) { if (xb_ld(&bar[XB_TMO])) break; if (sp > XB_SPIN_CAP) { atomicAdd(&bar[XB_TMO], 1u); break; } }
    }
    nloc = mine > 0u ? mine : 1u; nx = cnt > 0u ? cnt : 1u;
}
DI void xcd_barrier(const XcdBarrier& b, int tid) {
    asm volatile("s_waitcnt vmcnt(0)" ::: "memory");
    __syncthreads();
    if (tid == 0) {
        unsigned* bar = b.bar;
        __builtin_amdgcn_s_waitcnt(0);
        unsigned nloc = b.st[0], nx = b.st[1];
        if (nloc == 0u) { xcd_barrier_complete(bar, b.x, nloc, nx); b.st[0] = nloc; b.st[1] = nx; }
        const unsigned old = xb_add(&bar[XB_XSUB(b.x)], 1u);
        const unsigned gen = old / nloc;
        if (old + 1u == (gen + 1u) * nloc) {
            __builtin_amdgcn_fence(__ATOMIC_RELEASE, "agent");
            asm volatile("s_waitcnt vmcnt(0)" ::: "memory");
            const unsigned og = xb_add(&bar[XB_TOP], 1u);
            const unsigned tg = og / nx;
            if (og + 1u == (tg + 1u) * nx) xb_add(&bar[XB_TOPGEN], 1u);
            else XB_SPIN(xb_ld(&bar[XB_TOPGEN]) == tg, bar);
            __builtin_amdgcn_fence(__ATOMIC_ACQUIRE, "agent");
            xb_add(&bar[XB_XGEN(b.x)], 1u);
            asm volatile("s_waitcnt vmcnt(0)" ::: "memory");
        } else {
            XB_SPIN(xb_ld(&bar[XB_XGEN(b.x)]) == gen, bar);
            __builtin_amdgcn_fence(__ATOMIC_ACQUIRE, "agent");
            asm volatile("s_waitcnt vmcnt(0)" ::: "memory");
        }
    }
    __syncthreads();
}

namespace pg {
constexpr int BM = 256, BK = 64, HALF = 128, HTB = HALF * BK * 2, STAGE_BYTES = 8 * HTB;
DI int lds_byte(int r, int c) { const int st = (r >> 4) * 2 + (c >> 5), rr = r & 15, cc = c & 31, ob = rr * 64 + cc * 2; return st * 1024 + (ob ^ (((ob >> 9) & 1) << 5)); }
DI void stage_rc(int b, int& R, int& C) { const int st = b / 1024, sb = b % 1024, swz = sb ^ (((sb >> 9) & 1) << 5); R = (st >> 1) * 16 + swz / 64; C = (st & 1) * 32 + (swz % 64) / 2; }
DI int perm32(int rho) { const int n = rho >> 4, i = rho & 15; return 8 * (i >> 2) + 4 * n + (i & 3); }
struct Unit { int pm, pn, kind, aux; };
DI void decode_tiles(int L, int nM, int nN, int& pm, int& pn) {
    const int nwg = nM * nN; int wgid = L;
    { const int q = nwg / 8, r = nwg % 8, xcd = wgid % 8, off = wgid / 8; wgid = (xcd < r ? xcd * (q + 1) : r * (q + 1) + (xcd - r) * q) + off; }
    const int nig = 8 * nN, gid = wgid / nig, fm = gid * 8, gsz = (nM - fm) < 8 ? (nM - fm) : 8;
    pm = fm + ((wgid % nig) % gsz); pn = (wgid % nig) / gsz;
}
template <class Epi, class Sched>
DI void gemm_phase(LAS unsigned char* lds, const int K, const Sched& S, const Epi& E, int tid_in) {
    constexpr bool GATHER = Sched::GATHER;
    int tid = tid_in; asm volatile("" : "+v"(tid));
    const int wid = __builtin_amdgcn_readfirstlane(tid >> 6), lane = tid & 63, wr = wid >> 2, wc = wid & 3, fr = lane & 15, fq = lane >> 4;
    const int nt = K / BK;
    unsigned voffA[2], voffB[2];
    int Rr[2], Cc[2];
#pragma unroll
    for (int i = 0; i < 2; ++i) { int R, C; stage_rc(tid * 16 + i * 8192, R, C); const int Rb = (R & ~31) + perm32(R & 31);
        Rr[i] = R; Cc[i] = C; voffA[i] = (unsigned)(R * K + C) * 2u; voffB[i] = (unsigned)(Rb * K + C) * 2u; }
    const size_t kstep = (size_t)(BK * 2);
    const size_t hstep = (size_t)HALF * K * 2;
    const unsigned ldsw = (unsigned)wid * 1024u;
    const int aoff = lds_byte(wr * 64 + fr, fq * 8), boff = lds_byte(wc * 32 + fr, fq * 8);
#define PG_SA(b, h) (((b) * 2 + (h)) * HTB)
#define PG_SB(b, h) ((4 + (b) * 2 + (h)) * HTB)
#define PG_STAGE(bufoff, gbase, voff) do { _Pragma("unroll") for (int _i = 0; _i < 2; ++_i) \
        __builtin_amdgcn_global_load_lds((const unsigned*)((const char*)(gbase) + (voff)[_i]), (LAS unsigned*)(lds + (bufoff) + ldsw + _i * 8192), 16, 0, 0); } while (0)
#define PG_STAGE_A(bufoff, gb, kofs, h, o0, o1) do { if constexpr (GATHER) { if ((h) == 0) PG_STAGE(bufoff, (gb) + (kofs), o0); else PG_STAGE(bufoff, (gb) + (kofs), o1); } \
        else { PG_STAGE(bufoff, (gb) + (kofs) + (h) * hstep, voffA); } } while (0)
#define PG_LDA(dst, b, h) do { _Pragma("unroll") for (int m = 0; m < 4; ++m) _Pragma("unroll") for (int k = 0; k < 2; ++k) dst[m][k] = *(const LAS bf16x8*)(lds + PG_SA(b, h) + aoff + m * 2048 + k * 1024); } while (0)
#define PG_LDB(dst, b, h) do { _Pragma("unroll") for (int n = 0; n < 2; ++n) _Pragma("unroll") for (int k = 0; k < 2; ++k) dst[n][k] = *(const LAS bf16x8*)(lds + PG_SB(b, h) + boff + n * 2048 + k * 1024); } while (0)
#define PG_MMA(ai, bj, At, Bt) do { __builtin_amdgcn_s_setprio(1); _Pragma("unroll") for (int m = 0; m < 4; ++m) _Pragma("unroll") for (int n = 0; n < 2; ++n) _Pragma("unroll") for (int k = 0; k < 2; ++k) \
        acc[ai][bj][m][n] = __builtin_amdgcn_mfma_f32_16x16x32_bf16(Bt[n][k], At[m][k], acc[ai][bj][m][n], 0, 0, 0); __builtin_amdgcn_s_setprio(0); } while (0)
#define PG_WAIT_V(n) asm volatile("s_waitcnt vmcnt(" #n ")" ::: "memory")
#define PG_WAIT_L(n) asm volatile("s_waitcnt lgkmcnt(" #n ")" ::: "memory")
#define PG_BAR __builtin_amdgcn_s_barrier()
#define PG_SCHED __builtin_amdgcn_sched_barrier(0)
#define PG_AOFFS(u, o0, o1) do { if constexpr (GATHER) { _Pragma("unroll") for (int _i = 0; _i < 2; ++_i) { \
        o0[_i] = (unsigned)(S.a_row(u, Rr[_i]) * K + Cc[_i]) * 2u; o1[_i] = (unsigned)(S.a_row(u, HALF + Rr[_i]) * K + Cc[_i]) * 2u; } } } while (0)
    Unit cur, nxt; int ui = 0;
    if (!S.next(0, cur)) return;
    f32x4 acc[2][2][4][2];
#pragma unroll
    for (int a = 0; a < 2; ++a)
#pragma unroll
        for (int b = 0; b < 2; ++b)
#pragma unroll
            for (int m = 0; m < 4; ++m)
#pragma unroll
                for (int n = 0; n < 2; ++n) acc[a][b][m][n] = (f32x4){0.f, 0.f, 0.f, 0.f};
    bf16x8 At[4][2], B0[2][2], B1[2][2];
    unsigned cA0[2] = {0u, 0u}, cA1[2] = {0u, 0u}, nA0[2] = {0u, 0u}, nA1[2] = {0u, 0u};
    const char* cA = S.a_tile(cur); const char* cB = S.b_base(cur);
    PG_AOFFS(cur, cA0, cA1);
    PG_STAGE(PG_SB(0, 0), cB, voffB); PG_STAGE(PG_SB(0, 1), cB + hstep, voffB); PG_STAGE_A(PG_SA(0, 0), cA, 0, 0, cA0, cA1); PG_STAGE_A(PG_SA(0, 1), cA, 0, 1, cA0, cA1);
    if (wr == 1) PG_BAR;
    PG_WAIT_V(2); PG_BAR;
    PG_STAGE(PG_SB(1, 0), cB + kstep, voffB); PG_STAGE_A(PG_SA(1, 0), cA, kstep, 0, cA0, cA1); PG_STAGE(PG_SB(1, 1), cB + hstep + kstep, voffB);
    PG_WAIT_V(6); PG_BAR;
    for (;;) {
        const bool has_next = S.next(ui + 1, nxt);
        const char* nA = cA; const char* nB = cB;
        if (has_next) { nA = S.a_tile(nxt); nB = S.b_base(nxt); PG_AOFFS(nxt, nA0, nA1); }
        else if constexpr (GATHER) { nA0[0] = cA0[0]; nA0[1] = cA0[1]; nA1[0] = cA1[0]; nA1[1] = cA1[1]; }
        for (int t = 0; t < nt; t += 2) {
            const bool last = (t == nt - 2);
            const char* a1 = cA + (size_t)(t + 1) * kstep;
            const char* a2 = last ? nA : cA + (size_t)(t + 2) * kstep; const char* b2 = last ? nB : cB + (size_t)(t + 2) * kstep;
            const char* b3 = b2 + kstep;
            unsigned s0[2] = {0u, 0u}, s1[2] = {0u, 0u};
            if constexpr (GATHER) { s0[0] = last ? nA0[0] : cA0[0]; s0[1] = last ? nA0[1] : cA0[1]; s1[0] = last ? nA1[0] : cA1[0]; s1[1] = last ? nA1[1] : cA1[1]; }
            PG_LDB(B0, 0, 0); PG_LDB(B1, 0, 1); PG_SCHED; PG_LDA(At, 0, 0); PG_STAGE_A(PG_SA(1, 1), a1, 0, 1, cA0, cA1);
            PG_WAIT_V(8); PG_WAIT_L(0); PG_BAR; PG_MMA(0, 0, At, B0); PG_MMA(0, 1, At, B1); PG_BAR; PG_SCHED;
            PG_LDA(At, 0, 1); PG_STAGE(PG_SB(0, 0), b2, voffB); PG_STAGE(PG_SB(0, 1), b2 + hstep, voffB); PG_STAGE_A(PG_SA(0, 0), a2, 0, 0, s0, s1);
            PG_WAIT_V(8); PG_WAIT_L(0); PG_BAR; PG_MMA(1, 0, At, B0); PG_MMA(1, 1, At, B1); PG_BAR; PG_SCHED;
            PG_LDB(B0, 1, 0); PG_LDB(B1, 1, 1); PG_SCHED; PG_LDA(At, 1, 0); PG_STAGE_A(PG_SA(0, 1), a2, 0, 1, s0, s1);
            PG_WAIT_V(8); PG_WAIT_L(0); PG_BAR; PG_MMA(0, 0, At, B0); PG_MMA(0, 1, At, B1); PG_BAR; PG_SCHED;
            PG_LDA(At, 1, 1); PG_STAGE(PG_SB(1, 0), b3, voffB); PG_STAGE(PG_SB(1, 1), b3 + hstep, voffB); PG_STAGE_A(PG_SA(1, 0), a2, kstep, 0, s0, s1);
            PG_WAIT_V(8); PG_WAIT_L(0); PG_BAR; PG_MMA(1, 0, At, B0); PG_MMA(1, 1, At, B1); PG_BAR; PG_SCHED;
        }
        if (wr == 0) PG_BAR;
        { int fr_ = fr, fq_ = fq; asm volatile("" : "+v"(fr_), "+v"(fq_));
          E(acc, cur, wr, wc, fr_, fq_, lane); }
        if (!has_next) break;
#pragma unroll
        for (int a = 0; a < 2; ++a)
#pragma unroll
            for (int b = 0; b < 2; ++b)
#pragma unroll
                for (int m = 0; m < 4; ++m)
#pragma unroll
                    for (int n = 0; n < 2; ++n) acc[a][b][m][n] = (f32x4){0.f, 0.f, 0.f, 0.f};
        cur = nxt; cA = nA; cB = nB; ++ui;
        if constexpr (GATHER) { cA0[0] = nA0[0]; cA0[1] = nA0[1]; cA1[0] = nA1[0]; cA1[1] = nA1[1]; }
        if (wr == 1) PG_BAR;
    }
    PG_WAIT_V(0);
    PG_BAR;
#undef PG_SA
#undef PG_SB
#undef PG_STAGE
#undef PG_STAGE_A
#undef PG_LDA
#undef PG_LDB
#undef PG_MMA
#undef PG_WAIT_V
#undef PG_WAIT_L
#undef PG_BAR
#undef PG_SCHED
#undef PG_AOFFS
}
template <class F> DI void for_each8(const f32x4 (&acc)[2][2][4][2], int wr, int wc, int fr, int fq, F&& f) {
#pragma unroll
    for (int ai = 0; ai < 2; ++ai)
#pragma unroll
        for (int m = 0; m < 4; ++m)
#pragma unroll
            for (int bj = 0; bj < 2; ++bj) { f(ai * HALF + wr * 64 + m * 16 + fr, bj * HALF + wc * 32 + 8 * fq, acc[ai][bj][m][0], acc[ai][bj][m][1]); asm volatile("" ::: "memory"); }
}
DI u32x4 pack8(const f32x4& a, const f32x4& b) { u32x4 w; w.x = pk_bf16(a[0], a[1]); w.y = pk_bf16(a[2], a[3]); w.z = pk_bf16(b[0], b[1]); w.w = pk_bf16(b[2], b[3]); return w; }
}

struct Args { const float* in[33]; float* out; unsigned char* ws; int ph_lo, ph_hi; };
typedef const Args __attribute__((address_space(4))) KArgs;
#define KA KArgs&
enum { I_X = 0, I_C, I_CTX, I_CCTX, I_WADA, I_BADA, I_GPRE1, I_GPOST1, I_GPRE2, I_GPOST2, I_WIN, I_LQ1, I_LK1, I_LQ2, I_LK2, I_GSUB, I_CONVW, I_CONVB, I_DTB, I_ALOG,
       I_DSKIP, I_GSSD, I_WBA, I_WBS, I_WOUT, I_WR, I_RB, I_WEG, I_WEU, I_WED, I_WSG, I_WSU, I_WSD };
constexpr int NT = 512;
constexpr int RING_BYTES = pg::STAGE_BYTES;
constexpr int EPI_OFF = RING_BYTES;
constexpr int MISC_OFF = EPI_OFF + 4096;
constexpr int LDS_BYTES = MISC_OFF + 256;

DI void cvt_seg(const float* src, int ld, int col0, bf16_t* dst, int ncols, int nvalid, int K, int mode, int rowoff, int bid, int nblk, int tid_in) {
    int tid_ = tid_in; asm volatile("" : "+v"(tid_)); const int tid = tid_, jl = tid & 63, kg = tid >> 6;
    const int njb = ncols / 64, nkb = K / 64, nitems = njb * nkb;
    for (int it = bid; it < nitems; it += nblk) {
        const int jb = it % njb, kb = it / njb;
        const int j = jb * 64 + jl, k0 = kb * 64 + kg * 8;
        float v[8];
#pragma unroll
        for (int i = 0; i < 8; ++i) v[i] = (j < nvalid) ? src[(size_t)(k0 + i) * ld + col0 + j] : 0.f;
        int row = j;
        if (mode == 1) { const int blk = j >> 6, d = j & 63; row = blk * 64 + 2 * (d & 31) + (d >> 5); }
        else if (mode == 2) { row = (j >> 7) * 256 + (j & 127); }
        u32x4 w; w.x = pk_bf16(v[0], v[1]); w.y = pk_bf16(v[2], v[3]); w.z = pk_bf16(v[4], v[5]); w.w = pk_bf16(v[6], v[7]);
        *(u32x4*)(dst + (size_t)(rowoff + row) * K + k0) = w;
    }
}
DI void p0_prologue(KA a, LAS unsigned char* lds, int bid, int nblk, int tid_in) {
    unsigned char* ws = a.ws;
    int tid_ = tid_in; asm volatile("" : "+v"(tid_)); const int tid = tid_;
    const float* w_in = a.in[I_WIN];
    bf16_t* WIN = (bf16_t*)(ws + WS_WIN);
    cvt_seg(w_in, IN_COLS, 0,    WIN, 1024, 1024, 1024, 1, 0,    bid, nblk, tid);
    cvt_seg(w_in, IN_COLS, 1024, WIN, 1024, 1024, 1024, 1, 1024, bid, nblk, tid);
    cvt_seg(w_in, IN_COLS, 4096, WIN, 2048, 2048, 1024, 0, 2048, bid, nblk, tid);
    cvt_seg(w_in, IN_COLS, 6144, WIN, 256,  32,   1024, 0, 4096, bid, nblk, tid);
    cvt_seg(w_in, IN_COLS, 2048, (bf16_t*)(ws + WS_WV),  1024, 1024, 1024, 0, 0,    bid, nblk, tid);
    cvt_seg(w_in, IN_COLS, 3072, (bf16_t*)(ws + WS_WZG), 1024, 1024, 1024, 0, 0,    bid, nblk, tid);
    cvt_seg(w_in, IN_COLS, 6176, (bf16_t*)(ws + WS_WZG), 2048, 2048, 1024, 0, 1024, bid, nblk, tid);
    cvt_seg(a.in[I_WBA],  1024, 0, (bf16_t*)(ws + WS_WA), 1024, 1024, 1024, 0, 0, bid, nblk, tid);
    cvt_seg(a.in[I_WBS],  1024, 0, (bf16_t*)(ws + WS_WS), 1024, 1024, 1024, 0, 0, bid, nblk, tid);
    cvt_seg(a.in[I_WOUT], 1024, 0, (bf16_t*)(ws + WS_WO), 1024, 1024, 1024, 0, 0, bid, nblk, tid);
    bf16_t* W1 = (bf16_t*)(ws + WS_W1); bf16_t* W2 = (bf16_t*)(ws + WS_W2);
    for (int e = 0; e < NEXP; ++e) {
        cvt_seg(a.in[I_WEG] + (size_t)e * 1024 * 256, 256, 0, W1 + (size_t)e * 512 * 1024, 256, 256, 1024, 2, 0,   bid, nblk, tid);
        cvt_seg(a.in[I_WEU] + (size_t)e * 1024 * 256, 256, 0, W1 + (size_t)e * 512 * 1024, 256, 256, 1024, 2, 128, bid, nblk, tid);
        cvt_seg(a.in[I_WED] + (size_t)e * 256 * 1024, 1024, 0, W2 + (size_t)e * 1024 * 256, 1024, 1024, 256, 0, 0, bid, nblk, tid);
    }
    cvt_seg(a.in[I_WSG], 256, 0, W1 + (size_t)NEXP * 512 * 1024, 256, 256, 1024, 2, 0,   bid, nblk, tid);
    cvt_seg(a.in[I_WSU], 256, 0, W1 + (size_t)NEXP * 512 * 1024, 256, 256, 1024, 2, 128, bid, nblk, tid);
    cvt_seg(a.in[I_WSD], 1024, 0, W2 + (size_t)NEXP * 1024 * 256, 1024, 1024, 256, 0, 0, bid, nblk, tid);
    cvt_seg(a.in[I_WR], 64, 0, W1 + (size_t)65 * 512 * 1024, 256, 64, 1024, 0, 0, bid, nblk, tid);
    {
        float* rope = (float*)(ws + WS_ROPE);
        for (int idx = bid * NT + tid; idx < 2048 * 32; idx += nblk * NT) {
            const int n = idx >> 5, i = idx & 31, m = i & 15;
            const float inv = powf(10000.0f, -(float)(2 * m) / 32.0f);
            const float ang = (float)(i < 16 ? (n >> 6) : (n & 63)) * inv;
            float s, c; sincosf(ang, &s, &c);
            rope[idx * 2] = c; rope[idx * 2 + 1] = s;
        }
    }
    {
        LAS float* sc = (LAS float*)lds;
        LAS float* red = (LAS float*)(lds + 17 * 1024 * 4);
        float* MOD = (float*)(ws + WS_MOD);
        const float* w_ada = a.in[I_WADA];
        bool filled = false;
        for (int it = bid; it < 6144 / 64; it += nblk) {
            if (!filled) {
                for (int idx = tid; idx < 17 * 1024; idx += NT) { const int r = idx >> 10, k = idx & 1023; const float c = (r < 16) ? a.in[I_C][r * 1024 + k] : a.in[I_CCTX][k]; sc[idx] = siluf_(c); }
                filled = true;
            }
            __syncthreads();
            const int jl = tid & 63, kg = tid >> 6, j = it * 64 + jl;
            float acc[17];
#pragma unroll
            for (int r = 0; r < 17; ++r) acc[r] = 0.f;
            for (int k = kg * 128; k < kg * 128 + 128; ++k) {
                const float w = w_ada[(size_t)k * 6144 + j];
#pragma unroll
                for (int r = 0; r < 17; ++r) acc[r] += sc[r * 1024 + k] * w;
            }
#pragma unroll
            for (int r = 0; r < 17; ++r) red[(kg * 64 + jl) * 17 + r] = acc[r];
            __syncthreads();
            for (int idx = tid; idx < 64 * 17; idx += NT) {
                const int jj = idx / 17, r = idx % 17; float s = 0.f;
#pragma unroll
                for (int g = 0; g < 8; ++g) s += red[(g * 64 + jj) * 17 + r];
                MOD[r * 6144 + it * 64 + jj] = s + a.in[I_BADA][it * 64 + jj];
            }
            __syncthreads();
        }
    }
}

DI void p1_norm(KA a, int grp, int bid, int nblk, int tid_in) {
    int tid_ = tid_in; asm volatile("" : "+v"(tid_)); const int tid = tid_, wid = tid >> 6, lane = tid & 63;
    bf16_t* H = (bf16_t*)(a.ws + G_H);
    const float* MOD = (const float*)(a.ws + WS_MOD);
    const float* g = a.in[I_GPRE1];
    for (int row = bid * 8 + wid; row < HR; row += nblk * 8) {
        const float* src; int mrow;
        if (row < TG) { const int grow = grp * TG + row; src = a.in[I_X] + (size_t)grow * 1024; mrow = grow >> 11; }
        else { const int crow_ = grp * CG + (row - TG); src = a.in[I_CTX] + (size_t)crow_ * 1024; mrow = 16; }
        f32x4 v[4]; float ss = 0.f;
#pragma unroll
        for (int i = 0; i < 4; ++i) { v[i] = *(const f32x4*)(src + i * 256 + lane * 4); ss += v[i][0] * v[i][0] + v[i][1] * v[i][1] + v[i][2] * v[i][2] + v[i][3] * v[i][3]; }
        ss = wave_sum(ss, lane);
        const float rs = rsqrtf(ss * (1.0f / 1024.0f) + EPS);
        const float* sh = MOD + mrow * 6144; const float* scl = sh + 1024;
#pragma unroll
        for (int i = 0; i < 4; ++i) {
            const int c = i * 256 + lane * 4;
            const f32x4 gg = *(const f32x4*)(g + c), s1 = *(const f32x4*)(sh + c), s2 = *(const f32x4*)(scl + c);
            f32x4 y = v[i] * rs * gg * (s2 + 1.0f) + s1;
            u32x2 w; w.x = pk_bf16(y[0], y[1]); w.y = pk_bf16(y[2], y[3]);
            *(u32x2*)(H + (size_t)row * 1024 + c) = w;
        }
    }
}

struct SchedInproj {
    const bf16_t* H; const bf16_t* WIN; const bf16_t* WV; int G, c;
    static constexpr int NA = 72 * 17, NTOT = NA + 4 * 72;
    DI bool next(int i, pg::Unit& u) const {
        const int L = i * G + c; if (L >= NTOT) return false;
        if (L < NA) { pg::decode_tiles(L, 72, 17, u.pm, u.pn); u.kind = 0; }
        else { const int j = L - NA; u.pm = j & 3; u.pn = j >> 2; u.kind = 1; }
        u.aux = 0; return true;
    }
    static constexpr bool GATHER = false;
    DI const char* a_tile(const pg::Unit& u) const { return (const char*)((u.kind == 0 ? H : WV) + (size_t)u.pm * 256 * 1024); }
    DI int a_row(const pg::Unit&, int) const { return 0; }
    DI const char* b_base(const pg::Unit& u) const { return (const char*)((u.kind == 0 ? WIN : H) + (size_t)u.pn * 256 * 1024); }
};
struct EpiInproj {
    bf16_t* Q; bf16_t* Kb; bf16_t* VT; bf16_t* XBC; float* DT; const float* rope; const float* dtb;
    DI void operator()(const f32x4 (&acc)[2][2][4][2], const pg::Unit& u, int wr, int wc, int fr, int fq, int lane) const {
        if (u.kind == 1) {
            pg::for_each8(acc, wr, wc, fr, fq, [&](int r, int c, const f32x4& v0, const f32x4& v1) {
                const int vcol = u.pm * 256 + r, tok = u.pn * 256 + c; int b, pos;
                if (tok < TG) { b = tok >> 11; pos = CTXL + (tok & 2047); } else { const int t2 = tok - TG; b = t2 >> 8; pos = t2 & 255; }
                *(u32x4*)(VT + ((size_t)b * 1024 + vcol) * SALL + pos) = pg::pack8(v0, v1);
            });
            return;
        }
        const bool isctx = u.pm >= 64;
        if (u.pn < 8) {
            if (isctx && u.pn < 4) return;
            const bool isq = u.pn < 4;
            pg::for_each8(acc, wr, wc, fr, fq, [&](int r, int c, const f32x4& v0, const f32x4& v1) {
                const int R = u.pm * 256 + r, col = (u.pn & 3) * 256 + c;
                f32x4 o0 = v0, o1 = v1; size_t drow;
                if (!isctx) {
                    const int n = R & 2047, i0 = (col & 63) >> 1;
                    const f32x4 cs0 = *(const f32x4*)(rope + (size_t)(n * 32 + i0) * 2), cs1 = *(const f32x4*)(rope + (size_t)(n * 32 + i0 + 2) * 2);
                    o0[0] = v0[0] * cs0[0] - v0[1] * cs0[1]; o0[1] = v0[1] * cs0[0] + v0[0] * cs0[1];
                    o0[2] = v0[2] * cs0[2] - v0[3] * cs0[3]; o0[3] = v0[3] * cs0[2] + v0[2] * cs0[3];
                    o1[0] = v1[0] * cs1[0] - v1[1] * cs1[1]; o1[1] = v1[1] * cs1[0] + v1[0] * cs1[1];
                    o1[2] = v1[2] * cs1[2] - v1[3] * cs1[3]; o1[3] = v1[3] * cs1[2] + v1[2] * cs1[3];
                    drow = isq ? (size_t)R : (size_t)(R >> 11) * SALL + CTXL + n;
                } else { const int t2 = R - TG; drow = (size_t)(t2 >> 8) * SALL + (t2 & 255); }
                if (isq) { o0 = o0 * QSCALE; o1 = o1 * QSCALE; }
                *(u32x4*)((isq ? Q : Kb) + drow * 1024 + col) = pg::pack8(o0, o1);
            });
            return;
        }
        if (u.pn < 16) {
            pg::for_each8(acc, wr, wc, fr, fq, [&](int r, int c, const f32x4& v0, const f32x4& v1) {
                const int R = u.pm * 256 + r, col = (u.pn - 8) * 256 + c; size_t drow;
                if (!isctx) drow = (size_t)(R >> 11) * SALL + CTXL + (R & 2047); else { const int t2 = R - TG; drow = (size_t)(t2 >> 8) * SALL + (t2 & 255); }
                *(u32x4*)(XBC + drow * 2048 + col) = pg::pack8(v0, v1);
            });
            return;
        }
        pg::for_each8(acc, wr, wc, fr, fq, [&](int r, int c, const f32x4& v0, const f32x4& v1) {
            if (c >= 32) return;
            const int R = u.pm * 256 + r; size_t drow;
            if (!isctx) drow = (size_t)(R >> 11) * SALL + CTXL + (R & 2047); else { const int t2 = R - TG; drow = (size_t)(t2 >> 8) * SALL + (t2 & 255); }
            f32x4 o0, o1;
#pragma unroll
            for (int i = 0; i < 4; ++i) {
                const float x0 = v0[i] + dtb[c + i], x1 = v1[i] + dtb[c + 4 + i];
                o0[i] = fmaxf(x0, 0.f) + log1pf(__expf(-fabsf(x0))); o1[i] = fmaxf(x1, 0.f) + log1pf(__expf(-fabsf(x1)));
            }
            *(f32x4*)(DT + drow * 32 + c) = o0; *(f32x4*)(DT + drow * 32 + c + 4) = o1;
        });
    }
};

DI void attn_unit(KA a, LAS unsigned char* lds, int grp, int b, int head, int qb, int tid_in) {
    int tid = tid_in; asm volatile("" : "+v"(tid));
    const int wid = tid >> 6, lane = tid & 63, l31 = lane & 31, hh = lane >> 5;
    const bf16_t* Qg = (const bf16_t*)(a.ws + G_Q) + ((size_t)(b * SEQ + qb * 256 + wid * 32 + l31)) * 1024 + head * 128;
    const bf16_t* Kg = (const bf16_t*)(a.ws + G_K) + (size_t)b * SALL * 1024 + head * 128;
    const bf16_t* Vg = (const bf16_t*)(a.ws + G_VT) + ((size_t)b * 1024 + head * 128) * SALL;
    const int krow = tid >> 3, kch = tid & 7;
    const unsigned kst = (unsigned)(krow * 128 + ((kch ^ ((krow >> 1) & 7)) * 16));
    const unsigned vst0 = (unsigned)(krow * 128 + ((kch ^ ((krow >> 1) & 7)) * 16)), vst1 = vst0 + 64 * 128;
    const unsigned vst1b = (unsigned)((krow + 64) * 128 + ((kch ^ (((krow + 64) >> 1) & 7)) * 16));
    (void)vst1;
    const int kr0 = swap23(l31);
    LAS u32x4* o0s = (LAS u32x4*)(lds + 49152 + tid * 128);
    float lam;
    {
        const float p1 = wave_sum(a.in[I_LQ1][lane] * a.in[I_LK1][lane], lane), p2 = wave_sum(a.in[I_LQ2][lane] * a.in[I_LK2][lane], lane);
        lam = __expf(p1) - __expf(p2) + LAM_INIT;
    }
#pragma unroll 1
    for (int c = 0; c < 2; ++c) {
        bf16x8 qf[4];
#pragma unroll
        for (int s = 0; s < 4; ++s) qf[s] = *(const bf16x8*)(Qg + c * 64 + 16 * s + 8 * hh);
        f32x16 O[4];
#pragma unroll
        for (int d = 0; d < 4; ++d)
#pragma unroll
            for (int r = 0; r < 16; ++r) O[d][r] = 0.f;
        float mrun = -INFINITY, lrun = 0.f;
        {
            const u32x4 kx = *(const u32x4*)(Kg + (size_t)krow * 1024 + c * 64 + kch * 8);
            const u32x4 v0 = *(const u32x4*)(Vg + (size_t)krow * SALL + kch * 8), v1 = *(const u32x4*)(Vg + (size_t)(krow + 64) * SALL + kch * 8);
            __syncthreads();
            *(LAS u32x4*)(lds + kst) = kx; *(LAS u32x4*)(lds + 16384 + vst0) = v0; *(LAS u32x4*)(lds + 16384 + vst1b) = v1;
            __syncthreads();
        }
#pragma unroll 1
        for (int jt = 0; jt < SALL / 64; ++jt) {
            const int buf = jt & 1;
            const bool more = jt + 1 < SALL / 64;
            u32x4 kx, v0, v1;
            if (more) {
                const int key0 = (jt + 1) * 64;
                kx = *(const u32x4*)(Kg + (size_t)(key0 + krow) * 1024 + c * 64 + kch * 8);
                v0 = *(const u32x4*)(Vg + (size_t)krow * SALL + key0 + kch * 8); v1 = *(const u32x4*)(Vg + (size_t)(krow + 64) * SALL + key0 + kch * 8);
            }
            const LAS unsigned char* Kb = lds + buf * 8192; const LAS unsigned char* Vb = lds + 16384 + buf * 16384;
            f32x16 S[2];
#pragma unroll
            for (int kh = 0; kh < 2; ++kh) {
#pragma unroll
                for (int r = 0; r < 16; ++r) S[kh][r] = 0.f;
                const int row = kh * 32 + kr0;
#pragma unroll
                for (int s = 0; s < 4; ++s) {
                    const bf16x8 kf = *(const LAS bf16x8*)(Kb + row * 128 + (((2 * s + hh) ^ ((row >> 1) & 7)) * 16));
                    S[kh] = MFMA32(kf, qf[s], S[kh]);
                }
            }
            float mx = S[0][0];
#pragma unroll
            for (int r = 0; r < 16; ++r) { mx = fmaxf(mx, S[0][r]); mx = fmaxf(mx, S[1][r]); }
            mx = fmaxf(mx, shx(mx, 32, lane));
            const float mnew = fmaxf(mrun, mx);
            const float alpha = exp2f(mrun - mnew);
            mrun = mnew;
            float ls = 0.f;
#pragma unroll
            for (int kh = 0; kh < 2; ++kh)
#pragma unroll
                for (int r = 0; r < 16; ++r) { const float pv = exp2f(S[kh][r] - mnew); S[kh][r] = pv; ls += pv; }
            lrun = lrun * alpha + ls;
            if (__any(alpha != 1.0f)) {
#pragma unroll
                for (int d = 0; d < 4; ++d)
#pragma unroll
                    for (int r = 0; r < 16; ++r) O[d][r] *= alpha;
            }
            bf16x8 pf[2][2];
#pragma unroll
            for (int kh = 0; kh < 2; ++kh)
#pragma unroll
                for (int s2 = 0; s2 < 2; ++s2) pf[kh][s2] = pack_step(S[kh], s2);
#pragma unroll
            for (int d = 0; d < 4; ++d) {
                const int row = d * 32 + l31;
#pragma unroll
                for (int kh = 0; kh < 2; ++kh)
#pragma unroll
                    for (int s2 = 0; s2 < 2; ++s2) {
                        const bf16x8 vf = *(const LAS bf16x8*)(Vb + row * 128 + (((kh * 4 + s2 * 2 + hh) ^ ((row >> 1) & 7)) * 16));
                        O[d] = MFMA32(vf, pf[kh][s2], O[d]);
                    }
            }
            if (more) {
                LAS unsigned char* Kn = lds + (buf ^ 1) * 8192; LAS unsigned char* Vn = lds + 16384 + (buf ^ 1) * 16384;
                *(LAS u32x4*)(Kn + kst) = kx; *(LAS u32x4*)(Vn + vst0) = v0; *(LAS u32x4*)(Vn + vst1b) = v1;
            }
            __syncthreads();
        }
        const float ltot = lrun + shx(lrun, 32, lane);
        const float inv = 1.0f / ltot;
        if (c == 0) {
#pragma unroll
            for (int d = 0; d < 4; ++d)
#pragma unroll
                for (int rp = 0; rp < 2; ++rp) {
                    u32x4 w;
                    w.x = pk_bf16(O[d][rp * 8 + 0] * inv, O[d][rp * 8 + 1] * inv); w.y = pk_bf16(O[d][rp * 8 + 2] * inv, O[d][rp * 8 + 3] * inv);
                    w.z = pk_bf16(O[d][rp * 8 + 4] * inv, O[d][rp * 8 + 5] * inv); w.w = pk_bf16(O[d][rp * 8 + 6] * inv, O[d][rp * 8 + 7] * inv);
                    o0s[d * 2 + rp] = w;
                }
        } else {
            float ss = 0.f;
#pragma unroll
            for (int d = 0; d < 4; ++d)
#pragma unroll
                for (int rq = 0; rq < 4; ++rq) {
                    const u32x4 wq = o0s[d * 2 + (rq >> 1)];
                    const unsigned w0 = wq[(rq & 1) * 2 + 0], w1 = wq[(rq & 1) * 2 + 1];
                    const float a0 = bflo(w0) - lam * O[d][rq * 4 + 0] * inv, a1 = bfhi(w0) - lam * O[d][rq * 4 + 1] * inv;
                    const float a2 = bflo(w1) - lam * O[d][rq * 4 + 2] * inv, a3 = bfhi(w1) - lam * O[d][rq * 4 + 3] * inv;
                    O[d][rq * 4 + 0] = a0; O[d][rq * 4 + 1] = a1; O[d][rq * 4 + 2] = a2; O[d][rq * 4 + 3] = a3;
                    ss += a0 * a0 + a1 * a1 + a2 * a2 + a3 * a3;
                }
            ss += shx(ss, 32, lane);
            const float rs = rsqrtf(ss * (1.0f / 128.0f) + EPS) * (1.0f - LAM_INIT);
            bf16_t* Og = (bf16_t*)(a.ws + G_O) + ((size_t)(b * SEQ + qb * 256 + wid * 32 + l31)) * 1024 + head * 128;
            const float* gs = a.in[I_GSUB];
#pragma unroll
            for (int d = 0; d < 4; ++d)
#pragma unroll
                for (int rq = 0; rq < 4; ++rq) {
                    const int d0 = d * 32 + 8 * rq + 4 * hh;
                    const f32x4 g4 = *(const f32x4*)(gs + d0);
                    u32x2 w; w.x = pk_bf16(O[d][rq * 4 + 0] * rs * g4[0], O[d][rq * 4 + 1] * rs * g4[1]); w.y = pk_bf16(O[d][rq * 4 + 2] * rs * g4[2], O[d][rq * 4 + 3] * rs * g4[3]);
                    *(u32x2*)(Og + d0) = w;
                }
        }
    }
    (void)grp;
}

#ifndef SSD_NO_B
#define SSD_NO_B 0
#endif
constexpr int SS_C = 0, SS_B = 16384, SS_BT = 32768, SS_XT = 49152, SS_WXT = 81920, SS_SM = 114688;
DI void ssd_unit(KA a, LAS unsigned char* lds, int b, int g, int dir, int tid_in) {
    int tid = tid_in; asm volatile("" : "+v"(tid));
    const int wid = __builtin_amdgcn_readfirstlane(tid >> 6);
    const int hl = wid >> 1, pt = wid & 1, head = g * 4 + hl;
    const bf16_t* xbc = (const bf16_t*)(a.ws + G_XBC) + (size_t)b * SALL * 2048;
    const float* dtp = (const float*)(a.ws + G_DT) + (size_t)b * SALL * 32;
    bf16_t* Yout = (bf16_t*)(a.ws + (dir == 0 ? G_YF : G_YB)) + (size_t)b * SEQ * 1024 + head * 64 + pt * 32 + (tid & 31);
    const float dsk = (dir == 0) ? a.in[I_DSKIP][head] : 0.f;
    LAS float* sm_acum = (LAS float*)(lds + SS_SM);
    LAS float* sm_dt   = sm_acum + 256;
    LAS float* sm_w    = sm_acum + 512;
    LAS float* sm_ea   = sm_acum + 768;
    LAS float* sm_dec  = sm_acum + 1024;
    f32x16 hT[4];
#pragma unroll
    for (int n = 0; n < 4; ++n)
#pragma unroll
        for (int r = 0; r < 16; ++r) hT[n][r] = 0.f;
#pragma unroll 1
    for (int ci = 0; ci < 36; ++ci) {
        const bool isctx = ci < 4; const int cc = isctx ? ci : ci - 4;
        const int seg0 = isctx ? 0 : CTXL, seglen = isctx ? CTXL : SEQ;
        const int t0 = (dir == 0) ? cc * 64 : seglen - 64 * (cc + 1);
        int tidc = tid; asm volatile("" : "+v"(tidc));
        const int lane = tidc & 63;
        const int cg = tidc & 63, tg = tidc >> 6;
        int gcol;
        if (cg < 32) gcol = g * 256 + cg * 8; else if (cg < 48) gcol = 1024 + g * 128 + (cg - 32) * 8; else gcol = 1536 + g * 128 + (cg - 48) * 8;
        if (wid < 4) {
            const int tok = seg0 + (dir == 0 ? t0 + lane : t0 + 63 - lane);
            const float dtv = dtp[(size_t)tok * 32 + dir * 16 + g * 4 + wid];
            const float av = -__expf(a.in[I_ALOG][dir * 16 + g * 4 + wid]);
            float v = dtv * av;
#pragma unroll
            for (int o = 1; o < 64; o <<= 1) { const float n = shidx(v, lane - o); if (lane >= o) v += n; }
            const float tot = shidx(v, 63);
            sm_acum[wid * 64 + lane] = v; sm_dt[wid * 64 + lane] = dtv; sm_w[wid * 64 + lane] = __expf(tot - v) * dtv; sm_ea[wid * 64 + lane] = __expf(v);
            if (lane == 63) sm_dec[wid] = __expf(tot);
        }
        __syncthreads();
#pragma unroll 1
        for (int hf = 0; hf < (SSD_NO_B ? 0 : 2); ++hf) {
            const float* cw = a.in[I_CONVW]; const float* cb = a.in[I_CONVB];
            const int gc = gcol + hf * 4;
            const f32x4 w0 = *(const f32x4*)(cw + gc), w1 = *(const f32x4*)(cw + 2048 + gc), w2 = *(const f32x4*)(cw + 4096 + gc), bb = *(const f32x4*)(cb + gc);
            float raw[10][4];
#pragma unroll
            for (int k = 0; k < 10; ++k) {
                const int tt = t0 + tg * 8 + k - 1;
                u32x2 rv = (u32x2){0u, 0u};
                if (tt >= 0 && tt < seglen) rv = *(const u32x2*)(xbc + (size_t)(seg0 + tt) * 2048 + gc);
                raw[k][0] = bflo(rv.x); raw[k][1] = bfhi(rv.x); raw[k][2] = bflo(rv.y); raw[k][3] = bfhi(rv.y);
            }
            float val[8][4];
#pragma unroll
            for (int k = 0; k < 8; ++k)
#pragma unroll
                for (int i = 0; i < 4; ++i) val[k][i] = siluf_(bb[i] + w0[i] * raw[k][i] + w1[i] * raw[k + 1][i] + w2[i] * raw[k + 2][i]);
            const int sbase = (dir == 0) ? tg * 8 : 56 - tg * 8;
            if (cg >= 32) {
                const bool isC = cg >= 48; const int n0 = (isC ? cg - 48 : cg - 32) * 8;
                LAS unsigned char* rowimg = lds + (isC ? SS_C : SS_B);
#pragma unroll
                for (int k = 0; k < 8; ++k) {
                    const int sp = (dir == 0) ? tg * 8 + k : 63 - (tg * 8 + k);
                    u32x2 w; w.x = pk_bf16(val[k][0], val[k][1]); w.y = pk_bf16(val[k][2], val[k][3]);
                    *(LAS u32x2*)(rowimg + sp * 256 + ((((n0 >> 3)) ^ (sp & 15)) * 16) + hf * 8) = w;
                }
                if (!isC) {
#pragma unroll
                    for (int i = 0; i < 4; ++i) {
                        const int n = n0 + hf * 4 + i;
                        u32x4 w;
                        if (dir == 0) { w.x = pk_bf16(val[0][i], val[1][i]); w.y = pk_bf16(val[2][i], val[3][i]); w.z = pk_bf16(val[4][i], val[5][i]); w.w = pk_bf16(val[6][i], val[7][i]); }
                        else          { w.x = pk_bf16(val[7][i], val[6][i]); w.y = pk_bf16(val[5][i], val[4][i]); w.z = pk_bf16(val[3][i], val[2][i]); w.w = pk_bf16(val[1][i], val[0][i]); }
                        *(LAS u32x4*)(lds + SS_BT + n * 128 + (((sbase >> 3) ^ ((n >> 1) & 7)) * 16)) = w;
                    }
                }
            } else {
                const int xh = cg >> 3, p0 = (cg & 7) * 8 + hf * 4;
                float wv[8];
#pragma unroll
                for (int e = 0; e < 8; ++e) wv[e] = sm_w[xh * 64 + sbase + e];
#pragma unroll
                for (int i = 0; i < 4; ++i) {
                    const int p = p0 + i;
                    float x[8];
#pragma unroll
                    for (int e = 0; e < 8; ++e) x[e] = (dir == 0) ? val[e][i] : val[7 - e][i];
                    u32x4 w, ww;
                    w.x = pk_bf16(x[0], x[1]); w.y = pk_bf16(x[2], x[3]); w.z = pk_bf16(x[4], x[5]); w.w = pk_bf16(x[6], x[7]);
                    ww.x = pk_bf16(x[0] * wv[0], x[1] * wv[1]); ww.y = pk_bf16(x[2] * wv[2], x[3] * wv[3]); ww.z = pk_bf16(x[4] * wv[4], x[5] * wv[5]); ww.w = pk_bf16(x[6] * wv[6], x[7] * wv[7]);
                    const unsigned off = (unsigned)(xh * 8192 + p * 128 + (((sbase >> 3) ^ ((p >> 1) & 7)) * 16));
                    *(LAS u32x4*)(lds + SS_XT + off) = w; *(LAS u32x4*)(lds + SS_WXT + off) = ww;
                }
            }
        }
        __syncthreads();
        int lo_ = lane; asm volatile("" : "+v"(lo_));
        const int l31 = lo_ & 31, hh = lo_ >> 5;
        const LAS unsigned char* Ci = lds + SS_C; const LAS unsigned char* Bi = lds + SS_B; const LAS unsigned char* BTi = lds + SS_BT;
        const LAS unsigned char* XTi = lds + SS_XT + hl * 8192; const LAS unsigned char* WXTi = lds + SS_WXT + hl * 8192;
        const int prow = pt * 32 + l31;
        const LAS float* ea_c = sm_ea + hl * 64 + 4 * hh;
        const LAS float* ac_p = sm_acum + hl * 64 + 8 * hh;
        const LAS float* dt_p = sm_dt + hl * 64 + 8 * hh;
        if (!isctx) {
#pragma unroll
            for (int it = 0; it < 2; ++it) {
                f32x16 acc;
#pragma unroll
                for (int r = 0; r < 16; ++r) acc[r] = 0.f;
                const int irow = it * 32 + l31;
#pragma unroll
                for (int nt = 0; nt < 4; ++nt)
#pragma unroll
                    for (int s = 0; s < 2; ++s) {
                        const bf16x8 cf = *(const LAS bf16x8*)(Ci + irow * 256 + (((nt * 4 + 2 * s + hh) ^ (irow & 15)) * 16));
                        acc = MFMA32(cf, pack_step(hT[nt], s), acc);
                    }
                __builtin_amdgcn_sched_barrier(0);
#pragma unroll
                for (int r = 0; r < 16; ++r) acc[r] *= ea_c[it * 32 + 8 * (r >> 2) + (r & 3)];
                const float acum_i = sm_acum[hl * 64 + irow];
                __builtin_amdgcn_sched_barrier(0);
#pragma unroll
                for (int jt = 0; jt <= it; ++jt) {
                    f32x16 cb;
#pragma unroll
                    for (int r = 0; r < 16; ++r) cb[r] = 0.f;
                    const int jrow = jt * 32 + swap23(l31);
#pragma unroll
                    for (int ks = 0; ks < 8; ++ks) {
                        const bf16x8 bf = *(const LAS bf16x8*)(Bi + jrow * 256 + (((2 * ks + hh) ^ (jrow & 15)) * 16));
                        const bf16x8 cf = *(const LAS bf16x8*)(Ci + irow * 256 + (((2 * ks + hh) ^ (irow & 15)) * 16));
                        cb = MFMA32(bf, cf, cb);
                    }
                    __builtin_amdgcn_sched_barrier(0);
#pragma unroll
                    for (int r = 0; r < 16; ++r) {
                        const int jc = jt * 32 + 16 * (r >> 3) + 4 * ((r >> 2) & 1) + (r & 3);
                        const float dec = __expf(fminf(acum_i - ac_p[jc], 0.f)) * dt_p[jc];
                        cb[r] = (jc + 8 * hh <= irow) ? cb[r] * dec : 0.f;
                    }
#pragma unroll
                    for (int s = 0; s < 2; ++s) {
                        const bf16x8 xf = *(const LAS bf16x8*)(XTi + prow * 128 + (((jt * 4 + 2 * s + hh) ^ ((prow >> 1) & 7)) * 16));
                        acc = MFMA32(pack_step(cb, s), xf, acc);
                    }
                    __builtin_amdgcn_sched_barrier(0);
                }
#pragma unroll
                for (int rq = 0; rq < 4; ++rq) {
                    const u32x2 xs = *(const LAS u32x2*)(XTi + prow * 128 + (((it * 4 + rq) ^ ((prow >> 1) & 7)) * 16) + hh * 8);
                    const float xv[4] = {bflo(xs.x), bfhi(xs.x), bflo(xs.y), bfhi(xs.y)};
#pragma unroll
                    for (int j = 0; j < 4; ++j) {
                        const int i = it * 32 + 8 * rq + 4 * hh + j;
                        const int tnat = (dir == 0) ? t0 + i : t0 + 63 - i;
                        Yout[(size_t)tnat * 1024] = f2bf(acc[rq * 4 + j] + dsk * xv[j]);
                    }
                }
            }
        }
        {
            __builtin_amdgcn_sched_barrier(0);
            const float dec = sm_dec[hl];
#pragma unroll
            for (int nt = 0; nt < 4; ++nt) {
                __builtin_amdgcn_sched_barrier(0);
#pragma unroll
                for (int r = 0; r < 16; ++r) hT[nt][r] *= dec;
                const int nrow = nt * 32 + swap23(l31);
#pragma unroll
                for (int ks = 0; ks < 4; ++ks) {
                    const bf16x8 bf = *(const LAS bf16x8*)(BTi + nrow * 128 + (((2 * ks + hh) ^ ((nrow >> 1) & 7)) * 16));
                    const bf16x8 xf = *(const LAS bf16x8*)(WXTi + prow * 128 + (((2 * ks + hh) ^ ((prow >> 1) & 7)) * 16));
                    hT[nt] = MFMA32(bf, xf, hT[nt]);
                }
            }
        }
        __syncthreads();
    }
}

struct SchedPlain {
    const bf16_t* A; const bf16_t* Bt; int nM, nN, K, G, c;
    DI bool next(int i, pg::Unit& u) const {
        const int L = i * G + c; if (L >= nM * nN) return false;
        pg::decode_tiles(L, nM, nN, u.pm, u.pn); u.kind = 0; u.aux = 0; return true;
    }
    static constexpr bool GATHER = false;
    DI const char* a_tile(const pg::Unit& u) const { return (const char*)(A + (size_t)u.pm * 256 * K); }
    DI int a_row(const pg::Unit&, int) const { return 0; }
    DI const char* b_base(const pg::Unit& u) const { return (const char*)(Bt + (size_t)u.pn * 256 * K); }
};
struct EpiZG {
    const bf16_t* YF; const bf16_t* YB; bf16_t* YN; bf16_t* Gt; const float* gnorm; LAS float* scr;
    DI void operator()(const f32x4 (&acc)[2][2][4][2], const pg::Unit& u, int wr, int wc, int fr, int fq, int lane) const {
        if (u.pn >= 4) {
            pg::for_each8(acc, wr, wc, fr, fq, [&](int r, int c, const f32x4& v0, const f32x4& v1) {
                const int R = u.pm * 256 + r, col = (u.pn - 4) * 256 + c;
                f32x4 s0, s1;
#pragma unroll
                for (int i = 0; i < 4; ++i) { s0[i] = sigmoidf_(v0[i]); s1[i] = sigmoidf_(v1[i]); }
                *(u32x4*)(Gt + (size_t)R * 2048 + col) = pg::pack8(s0, s1);
            });
            return;
        }
        u32x4 yp[2][4][2];
#pragma unroll
        for (int ai = 0; ai < 2; ++ai)
#pragma unroll
            for (int m = 0; m < 4; ++m) {
                const int r = ai * 128 + wr * 64 + m * 16 + fr, R = u.pm * 256 + r; float ss = 0.f;
#pragma unroll
                for (int bj = 0; bj < 2; ++bj) {
                    const int col = u.pn * 256 + bj * 128 + wc * 32 + 8 * fq;
                    const u32x4 f = *(const u32x4*)(YF + (size_t)R * 1024 + col), bw = *(const u32x4*)(YB + (size_t)R * 1024 + col);
                    const float yv[8] = {bflo(f.x) + bflo(bw.x), bfhi(f.x) + bfhi(bw.x), bflo(f.y) + bflo(bw.y), bfhi(f.y) + bfhi(bw.y),
                                         bflo(f.z) + bflo(bw.z), bfhi(f.z) + bfhi(bw.z), bflo(f.w) + bflo(bw.w), bfhi(f.w) + bfhi(bw.w)};
                    float y[8];
#pragma unroll
                    for (int n = 0; n < 2; ++n)
#pragma unroll
                        for (int i = 0; i < 4; ++i) { const float z = acc[ai][bj][m][n][i]; y[n * 4 + i] = yv[n * 4 + i] * siluf_(z); ss += y[n * 4 + i] * y[n * 4 + i]; }
                    u32x4 w; w.x = pk_bf16(y[0], y[1]); w.y = pk_bf16(y[2], y[3]); w.z = pk_bf16(y[4], y[5]); w.w = pk_bf16(y[6], y[7]);
                    asm volatile("" : "+v"(w.x), "+v"(w.y), "+v"(w.z), "+v"(w.w));
                    yp[ai][m][bj] = w;
                }
                ss += shx(ss, 16, lane); ss += shx(ss, 32, lane);
                if (fq == 0) scr[r * 4 + wc] = ss;
                asm volatile("" ::: "memory");
            }
        asm volatile("s_waitcnt lgkmcnt(0)" ::: "memory"); __builtin_amdgcn_s_barrier(); asm volatile("" ::: "memory");
        asm volatile("" : "+v"(fr), "+v"(fq));
#pragma unroll
        for (int ai = 0; ai < 2; ++ai)
#pragma unroll
            for (int m = 0; m < 4; ++m) {
                const int r = ai * 128 + wr * 64 + m * 16 + fr, R = u.pm * 256 + r;
                const f32x4 ps = *(const LAS f32x4*)(scr + r * 4);
                const float rs = rsqrtf((ps[0] + ps[1] + ps[2] + ps[3]) * (1.0f / 256.0f) + EPS);
#pragma unroll
                for (int bj = 0; bj < 2; ++bj) {
                    const int col = u.pn * 256 + bj * 128 + wc * 32 + 8 * fq;
                    const f32x4 g0 = *(const f32x4*)(gnorm + col), g1 = *(const f32x4*)(gnorm + col + 4);
                    const u32x4 w = yp[ai][m][bj];
                    const f32x4 y0 = {bflo(w.x), bfhi(w.x), bflo(w.y), bfhi(w.y)}, y1 = {bflo(w.z), bfhi(w.z), bflo(w.w), bfhi(w.w)};
                    *(u32x4*)(YN + (size_t)R * 1024 + col) = pg::pack8(y0 * rs * g0, y1 * rs * g1);
                }
                asm volatile("" ::: "memory");
            }
        asm volatile("s_waitcnt lgkmcnt(0)" ::: "memory"); __builtin_amdgcn_s_barrier(); asm volatile("" ::: "memory");
        (void)lane;
    }
};
struct EpiBranchA {
    const bf16_t* Gt; bf16_t* P;
    DI void operator()(const f32x4 (&acc)[2][2][4][2], const pg::Unit& u, int wr, int wc, int fr, int fq, int) const {
        pg::for_each8(acc, wr, wc, fr, fq, [&](int r, int c, const f32x4& v0, const f32x4& v1) {
            const int R = u.pm * 256 + r, col = u.pn * 256 + c;
            const u32x4 gw = *(const u32x4*)(Gt + (size_t)R * 2048 + col);
            const f32x4 g0 = {bflo(gw.x), bfhi(gw.x), bflo(gw.y), bfhi(gw.y)}, g1 = {bflo(gw.z), bfhi(gw.z), bflo(gw.w), bfhi(gw.w)};
            *(u32x4*)(P + (size_t)R * 1024 + col) = pg::pack8(v0 * g0, v1 * g1);
        });
    }
};
struct EpiBranchS {
    const bf16_t* Gt; const bf16_t* P; bf16_t* U;
    DI void operator()(const f32x4 (&acc)[2][2][4][2], const pg::Unit& u, int wr, int wc, int fr, int fq, int) const {
        pg::for_each8(acc, wr, wc, fr, fq, [&](int r, int c, const f32x4& v0, const f32x4& v1) {
            const int R = u.pm * 256 + r, col = u.pn * 256 + c;
            const u32x4 gw = *(const u32x4*)(Gt + (size_t)R * 2048 + 1024 + col), pw = *(const u32x4*)(P + (size_t)R * 1024 + col);
            const f32x4 g0 = {bflo(gw.x), bfhi(gw.x), bflo(gw.y), bfhi(gw.y)}, g1 = {bflo(gw.z), bfhi(gw.z), bflo(gw.w), bfhi(gw.w)};
            const f32x4 p0 = {bflo(pw.x), bfhi(pw.x), bflo(pw.y), bfhi(pw.y)}, p1 = {bflo(pw.z), bfhi(pw.z), bflo(pw.w), bfhi(pw.w)};
            *(u32x4*)(U + (size_t)R * 1024 + col) = pg::pack8(p0 + v0 * g0, p1 + v1 * g1);
        });
    }
};
struct EpiF32 {
    float* O; int ldc;
    DI void operator()(const f32x4 (&acc)[2][2][4][2], const pg::Unit& u, int wr, int wc, int fr, int fq, int) const {
        pg::for_each8(acc, wr, wc, fr, fq, [&](int r, int c, const f32x4& v0, const f32x4& v1) {
            float* o = O + (size_t)(u.pm * 256 + r) * ldc + u.pn * 256 + c;
            *(f32x4*)o = v0; *(f32x4*)(o + 4) = v1;
        });
    }
};

DI void p8_post(KA a, int grp, int bid, int nblk, int tid_in) {
    int tid_ = tid_in; asm volatile("" : "+v"(tid_)); const int tid = tid_, wid = tid >> 6, lane = tid & 63;
    const float* MIX = (const float*)(a.ws + G_MIX); bf16_t* H2 = (bf16_t*)(a.ws + G_H2);
    const float* MOD = (const float*)(a.ws + WS_MOD);
    const float* g1 = a.in[I_GPOST1]; const float* g2 = a.in[I_GPRE2];
    for (int row = bid * 8 + wid; row < TG; row += nblk * 8) {
        const int grow = grp * TG + row; const float* md = MOD + (grow >> 11) * 6144;
        const float* xs = a.in[I_X] + (size_t)grow * 1024; const float* ms = MIX + (size_t)row * 1024; float* od = a.out + (size_t)grow * 1024;
        f32x4 mv[4], xv[4]; float ss = 0.f;
#pragma unroll
        for (int i = 0; i < 4; ++i) { mv[i] = *(const f32x4*)(ms + i * 256 + lane * 4); xv[i] = *(const f32x4*)(xs + i * 256 + lane * 4); ss += mv[i][0] * mv[i][0] + mv[i][1] * mv[i][1] + mv[i][2] * mv[i][2] + mv[i][3] * mv[i][3]; }
        ss = wave_sum(ss, lane);
        const float rs = rsqrtf(ss * (1.0f / 1024.0f) + EPS);
        float s2 = 0.f;
#pragma unroll
        for (int i = 0; i < 4; ++i) {
            const int c = i * 256 + lane * 4;
            const f32x4 gg = *(const f32x4*)(g1 + c), gt = *(const f32x4*)(md + 2048 + c);
            xv[i] = xv[i] + gt * (mv[i] * rs * gg);
            *(f32x4*)(od + c) = xv[i];
            s2 += xv[i][0] * xv[i][0] + xv[i][1] * xv[i][1] + xv[i][2] * xv[i][2] + xv[i][3] * xv[i][3];
        }
        s2 = wave_sum(s2, lane);
        const float rs2 = rsqrtf(s2 * (1.0f / 1024.0f) + EPS);
#pragma unroll
        for (int i = 0; i < 4; ++i) {
            const int c = i * 256 + lane * 4;
            const f32x4 gg = *(const f32x4*)(g2 + c), sh = *(const f32x4*)(md + 3072 + c), sc = *(const f32x4*)(md + 4096 + c);
            const f32x4 y = xv[i] * rs2 * gg * (sc + 1.0f) + sh;
            u32x2 w; w.x = pk_bf16(y[0], y[1]); w.y = pk_bf16(y[2], y[3]);
            *(u32x2*)(H2 + (size_t)row * 1024 + c) = w;
        }
    }
}

struct EpiQ1 {
    bf16_t* HID; float* LOG;
    DI void operator()(const f32x4 (&acc)[2][2][4][2], const pg::Unit& u, int wr, int wc, int fr, int fq, int) const {
        if (u.pn == 2) {
            pg::for_each8(acc, wr, wc, fr, fq, [&](int r, int c, const f32x4& v0, const f32x4& v1) {
                if (c >= 64) return;
                float* o = LOG + (size_t)(u.pm * 256 + r) * 64 + c; *(f32x4*)o = v0; *(f32x4*)(o + 4) = v1;
            });
            return;
        }
#pragma unroll
        for (int ai = 0; ai < 2; ++ai)
#pragma unroll
            for (int m = 0; m < 4; ++m) {
                const int r = ai * 128 + wr * 64 + m * 16 + fr, c = wc * 32 + 8 * fq;
                f32x4 h0, h1;
#pragma unroll
                for (int i = 0; i < 4; ++i) { h0[i] = siluf_(acc[ai][0][m][0][i]) * acc[ai][1][m][0][i]; h1[i] = siluf_(acc[ai][0][m][1][i]) * acc[ai][1][m][1][i]; }
                *(u32x4*)(HID + (size_t)(SH_ROW0 + u.pm * 256 + r) * 256 + u.pn * 128 + c) = pg::pack8(h0, h1);
            }
    }
};
DI void q2_route(KA a, int bid, int nblk, int tid_in) {
    int tid_ = tid_in; asm volatile("" : "+v"(tid_)); const int tid = tid_, wid = tid >> 6, lane = tid & 63;
    const float* LOG = (const float*)(a.ws + M_LOG); int* TOPE = (int*)(a.ws + M_TOPE); float* TOPW = (float*)(a.ws + M_TOPW); int* TPOS = (int*)(a.ws + M_TPOS);
    int* CNT = (int*)(a.ws + WS_CTL) + CW_CNT;
    const float bias = a.in[I_RB][lane];
    for (int t = bid * 8 + wid; t < QT; t += nblk * 8) {
        const float score = sigmoidf_(LOG[(size_t)t * 64 + lane]);
        const float sel = score + bias;
        float m1 = sel;
        m1 = fmaxf(m1, shx(m1, 1, lane)); m1 = fmaxf(m1, shx(m1, 2, lane)); m1 = fmaxf(m1, shx(m1, 4, lane));
        int i1 = (sel == m1) ? lane : 64;
        i1 = min(i1, shxi(i1, 1, lane)); i1 = min(i1, shxi(i1, 2, lane)); i1 = min(i1, shxi(i1, 4, lane));
        float m2 = (lane == i1) ? -INFINITY : sel;
        m2 = fmaxf(m2, shx(m2, 1, lane)); m2 = fmaxf(m2, shx(m2, 2, lane)); m2 = fmaxf(m2, shx(m2, 4, lane));
        const float gs = m1 + m2; const int myg = lane >> 3;
        int grank = 0;
#pragma unroll
        for (int g2 = 0; g2 < 8; ++g2) { const float o = __int_as_float(__builtin_amdgcn_readlane(__float_as_int(gs), g2 * 8)); grank += (o > gs || (o == gs && g2 < myg)) ? 1 : 0; }
        const float v = (grank < 4) ? sel : -INFINITY;
        int rank = 0;
#pragma unroll 4
        for (int e2 = 0; e2 < 64; ++e2) { const float o = __int_as_float(__builtin_amdgcn_readlane(__float_as_int(v), e2)); rank += (o > v || (o == v && e2 < lane)) ? 1 : 0; }
        const bool chosen = (rank < 8) && (grank < 4);
        const float wsum = wave_sum(chosen ? score : 0.f, lane);
        if (chosen) {
            const int pos = atomicAdd(&CNT[lane], 1);
            TOPE[t * 8 + rank] = lane; TOPW[t * 8 + rank] = score / wsum * 2.5f; TPOS[t * 8 + rank] = pos;
        }
    }
}
DI void moe_offsets(KA a, LAS int* offs  , int tid) {
    const int* CNT = (const int*)(a.ws + WS_CTL) + CW_CNT;
    if (tid == 0) { int o = 0; for (int e = 0; e < NEXP; ++e) { offs[e] = o; o += (CNT[e] + 255) & ~255; } offs[64] = o; offs[65] = o >> 8; }
    __syncthreads();
}
DI void q3_scatter(KA a, LAS unsigned char* lds, int bid, int nblk, int tid_in) {
    LAS int* offs = (LAS int*)lds; moe_offsets(a, offs, tid_in);
    int tid_ = tid_in; asm volatile("" : "+v"(tid_)); const int tid = tid_;
    const int* CNT = (const int*)(a.ws + WS_CTL) + CW_CNT;
    const int* TOPE = (const int*)(a.ws + M_TOPE); const int* TPOS = (const int*)(a.ws + M_TPOS); int* ROWL = (int*)(a.ws + M_ROWL);
    for (int idx = bid * NT + tid; idx < QT * 8; idx += nblk * NT) ROWL[offs[TOPE[idx]] + TPOS[idx]] = idx;
    for (int idx = bid * NT + tid; idx < NEXP * 256; idx += nblk * NT) {
        const int e = idx >> 8, k = idx & 255, c = CNT[e], pad = ((c + 255) & ~255) - c;
        if (k < pad) ROWL[offs[e] + c + k] = -1;
    }
    __syncthreads();
}
struct SchedQ4 {
    const bf16_t* H2q; const bf16_t* W1; const int* ROWL; const LAS int* offs; int G, c;
    DI bool next(int i, pg::Unit& u) const {
        const int L = i * G + c; const int ntiles = offs[65]; if (L >= ntiles * 2) return false;
        u.pm = L >> 1; u.pn = L & 1; int e = 0;
#pragma unroll 1
        for (int k = 1; k < NEXP; ++k) e = (offs[k] <= u.pm * 256) ? k : e;
        u.kind = 0; u.aux = e; return true;
    }
    static constexpr bool GATHER = true;
    DI const char* a_tile(const pg::Unit&) const { return (const char*)H2q; }
    DI int a_row(const pg::Unit& u, int r) const { const int id = ROWL[u.pm * 256 + r]; return id < 0 ? 0 : (id >> 3); }
    DI const char* b_base(const pg::Unit& u) const { return (const char*)(W1 + ((size_t)u.aux * 512 + u.pn * 256) * 1024); }
};
struct EpiQ4 {
    bf16_t* HID;
    DI void operator()(const f32x4 (&acc)[2][2][4][2], const pg::Unit& u, int wr, int wc, int fr, int fq, int) const {
#pragma unroll
        for (int ai = 0; ai < 2; ++ai)
#pragma unroll
            for (int m = 0; m < 4; ++m) {
                const int r = ai * 128 + wr * 64 + m * 16 + fr, c = wc * 32 + 8 * fq;
                f32x4 h0, h1;
#pragma unroll
                for (int i = 0; i < 4; ++i) { h0[i] = siluf_(acc[ai][0][m][0][i]) * acc[ai][1][m][0][i]; h1[i] = siluf_(acc[ai][0][m][1][i]) * acc[ai][1][m][1][i]; }
                *(u32x4*)(HID + (size_t)(u.pm * 256 + r) * 256 + u.pn * 128 + c) = pg::pack8(h0, h1);
            }
    }
};
struct SchedQ5 {
    const bf16_t* HID; const bf16_t* W2; const LAS int* offs; int G, c;
    DI bool next(int i, pg::Unit& u) const {
        const int L = i * G + c; const int ne = offs[65] * 4; if (L >= ne + (QT / 256) * 4) return false;
        if (L < ne) { u.pm = L >> 2; u.pn = L & 3; int e = 0;
#pragma unroll 1
            for (int k = 1; k < NEXP; ++k) e = (offs[k] <= u.pm * 256) ? k : e;
            u.kind = 0; u.aux = e; }
        else { const int j = L - ne; u.pm = j >> 2; u.pn = j & 3; u.kind = 1; u.aux = NEXP; }
        return true;
    }
    static constexpr bool GATHER = false;
    DI const char* a_tile(const pg::Unit& u) const { return (const char*)(HID + (size_t)((u.kind == 0 ? 0 : SH_ROW0) + u.pm * 256) * 256); }
    DI int a_row(const pg::Unit&, int) const { return 0; }
    DI const char* b_base(const pg::Unit& u) const { return (const char*)(W2 + ((size_t)u.aux * 1024 + u.pn * 256) * 256); }
};
struct EpiQ5 {
    const int* ROWL; const float* TOPW; bf16_t* AOUT; bf16_t* SOUT;
    DI void operator()(const f32x4 (&acc)[2][2][4][2], const pg::Unit& u, int wr, int wc, int fr, int fq, int) const {
        pg::for_each8(acc, wr, wc, fr, fq, [&](int r, int c, const f32x4& v0, const f32x4& v1) {
            const int col = u.pn * 256 + c;
            if (u.kind == 1) { *(u32x4*)(SOUT + (size_t)(u.pm * 256 + r) * 1024 + col) = pg::pack8(v0, v1); return; }
            const int id = ROWL[u.pm * 256 + r]; if (id < 0) return;
            const float w = TOPW[id];
            *(u32x4*)(AOUT + (size_t)id * 1024 + col) = pg::pack8(v0 * w, v1 * w);
        });
    }
};
DI void q6_combine(KA a, int grp, int qi, int bid, int nblk, int tid_in) {
    int tid_ = tid_in; asm volatile("" : "+v"(tid_)); const int tid = tid_, wid = tid >> 6, lane = tid & 63;
    const bf16_t* AOUT = (const bf16_t*)(a.ws + M_AOUT); const bf16_t* SOUT = (const bf16_t*)(a.ws + M_SOUT);
    const float* MOD = (const float*)(a.ws + WS_MOD); const float* g = a.in[I_GPOST2];
    for (int t = bid * 8 + wid; t < QT; t += nblk * 8) {
        const int grow = grp * TG + qi * QT + t; const float* md = MOD + (grow >> 11) * 6144; float* od = a.out + (size_t)grow * 1024;
        float f[16];
        { const u32x4 s0 = *(const u32x4*)(SOUT + (size_t)t * 1024 + lane * 8), s1 = *(const u32x4*)(SOUT + (size_t)t * 1024 + 512 + lane * 8);
          f[0] = bflo(s0.x); f[1] = bfhi(s0.x); f[2] = bflo(s0.y); f[3] = bfhi(s0.y); f[4] = bflo(s0.z); f[5] = bfhi(s0.z); f[6] = bflo(s0.w); f[7] = bfhi(s0.w);
          f[8] = bflo(s1.x); f[9] = bfhi(s1.x); f[10] = bflo(s1.y); f[11] = bfhi(s1.y); f[12] = bflo(s1.z); f[13] = bfhi(s1.z); f[14] = bflo(s1.w); f[15] = bfhi(s1.w); }
#pragma unroll
        for (int s = 0; s < 8; ++s) {
            const bf16_t* rp = AOUT + ((size_t)t * 8 + s) * 1024;
            const u32x4 s0 = *(const u32x4*)(rp + lane * 8), s1 = *(const u32x4*)(rp + 512 + lane * 8);
            f[0] += bflo(s0.x); f[1] += bfhi(s0.x); f[2] += bflo(s0.y); f[3] += bfhi(s0.y); f[4] += bflo(s0.z); f[5] += bfhi(s0.z); f[6] += bflo(s0.w); f[7] += bfhi(s0.w);
            f[8] += bflo(s1.x); f[9] += bfhi(s1.x); f[10] += bflo(s1.y); f[11] += bfhi(s1.y); f[12] += bflo(s1.z); f[13] += bfhi(s1.z); f[14] += bflo(s1.w); f[15] += bfhi(s1.w);
        }
        float ss = 0.f;
#pragma unroll
        for (int i = 0; i < 16; ++i) ss += f[i] * f[i];
        ss = wave_sum(ss, lane);
        const float rs = rsqrtf(ss * (1.0f / 1024.0f) + EPS);
#pragma unroll
        for (int hf = 0; hf < 2; ++hf)
#pragma unroll
            for (int q4 = 0; q4 < 2; ++q4) {
                const int c = hf * 512 + lane * 8 + q4 * 4;
                const f32x4 gg = *(const f32x4*)(g + c), gt = *(const f32x4*)(md + 5120 + c), x1 = *(const f32x4*)(od + c);
                f32x4 fv = {f[hf * 8 + q4 * 4 + 0], f[hf * 8 + q4 * 4 + 1], f[hf * 8 + q4 * 4 + 2], f[hf * 8 + q4 * 4 + 3]};
                *(f32x4*)(od + c) = x1 + gt * (fv * rs * gg);
            }
    }
}

constexpr int STEPS_PER_GRP = 8 + NQ * 6;
constexpr int N_STEPS = 1 + NGRP * STEPS_PER_GRP;
template <unsigned PH_MASK>
__global__ void __launch_bounds__(NT, 2) fwd(Args a_) {
    extern __shared__ __attribute__((aligned(16))) unsigned char lds_raw[];
    LAS unsigned char* lds = (LAS unsigned char*)lds_raw;
    const int wave_id = __builtin_amdgcn_readfirstlane(threadIdx.x >> 6);
#define TID_NOW (wave_id * 64 + (int)__builtin_amdgcn_mbcnt_hi(~0u, __builtin_amdgcn_mbcnt_lo(~0u, 0u)))
    volatile LAS unsigned* misc = (volatile LAS unsigned*)(lds + MISC_OFF);
    { const int t = TID_NOW; if (t < 4) misc[t] = 0u; }
    __syncthreads();
    const int lo = a_.ph_lo, hi = a_.ph_hi;
    XcdBarrier bar; bar.bar = (unsigned*)(a_.ws + WS_CTL); bar.x = 0; bar.st = misc;
    if (hi - lo > 1) bar = xcd_barrier_post((unsigned*)(a_.ws + WS_CTL), misc, TID_NOW);
#define IN(k) (lo <= (k) && (k) < hi)
#define SEAM(k) do { if (IN(k) && IN((k) + 1)) xcd_barrier(bar, TID_NOW); } while (0)
#define FRESH_ARGS KArgs* ap_ = (KArgs*)__builtin_amdgcn_kernarg_segment_ptr(); asm volatile("" : "+s"(ap_)); KA a = *ap_; unsigned char* ws = a.ws; (void)ws; int bid = blockIdx.x, nblk = gridDim.x; asm volatile("" : "+s"(bid), "+s"(nblk)); int tid = TID_NOW; asm volatile("" : "+v"(tid))
    if (((PH_MASK >> 0) & 1) && IN(0)) { FRESH_ARGS; p0_prologue(a, lds, bid, nblk, tid); SEAM(0); }
#pragma unroll 1
    for (int grp = 0; grp < NGRP; ++grp) {
        const int base = 1 + grp * STEPS_PER_GRP;
        if (((PH_MASK >> 1) & 1) && IN(base + 0)) { FRESH_ARGS; p1_norm(a, grp, bid, nblk, tid); SEAM(base + 0); }
        if (((PH_MASK >> 2) & 1) && IN(base + 1)) { FRESH_ARGS;
            SchedInproj S{(const bf16_t*)(ws + G_H), (const bf16_t*)(ws + WS_WIN), (const bf16_t*)(ws + WS_WV), nblk, bid};
            EpiInproj E{(bf16_t*)(ws + G_Q), (bf16_t*)(ws + G_K), (bf16_t*)(ws + G_VT), (bf16_t*)(ws + G_XBC), (float*)(ws + G_DT), (const float*)(ws + WS_ROPE), a.in[I_DTB]};
            pg::gemm_phase(lds, 1024, S, E, tid);
            SEAM(base + 1);
        }
        if (((PH_MASK >> 3) & 1) && IN(base + 2)) { FRESH_ARGS;
#pragma unroll 1
            for (int L = bid; L < 64 + 512; L += nblk) {
#ifndef NO_SSD
                if (L < 64) ssd_unit(a, lds, L >> 3, (L >> 1) & 3, L & 1, tid);
#endif
#ifndef NO_ATTN
                if (L >= 64) { const int j = L - 64; attn_unit(a, lds, grp, j >> 6, (j >> 3) & 7, j & 7, tid); }
#endif
                __syncthreads();
            }
            SEAM(base + 2);
        }
        if (((PH_MASK >> 4) & 1) && IN(base + 3)) { FRESH_ARGS;
            SchedPlain S{(const bf16_t*)(ws + G_H), (const bf16_t*)(ws + WS_WZG), TG / 256, 12, 1024, nblk, bid};
            EpiZG E{(const bf16_t*)(ws + G_YF), (const bf16_t*)(ws + G_YB), (bf16_t*)(ws + G_YN), (bf16_t*)(ws + G_G), a.in[I_GSSD], (LAS float*)(lds + EPI_OFF)};
            pg::gemm_phase(lds, 1024, S, E, tid);
            SEAM(base + 3);
        }
        if (((PH_MASK >> 5) & 1) && IN(base + 4)) { FRESH_ARGS;
            SchedPlain S{(const bf16_t*)(ws + G_O), (const bf16_t*)(ws + WS_WA), TG / 256, 4, 1024, nblk, bid};
            EpiBranchA E{(const bf16_t*)(ws + G_G), (bf16_t*)(ws + G_P)};
            pg::gemm_phase(lds, 1024, S, E, tid);
            SEAM(base + 4);
        }
        if (((PH_MASK >> 6) & 1) && IN(base + 5)) { FRESH_ARGS;
            SchedPlain S{(const bf16_t*)(ws + G_YN), (const bf16_t*)(ws + WS_WS), TG / 256, 4, 1024, nblk, bid};
            EpiBranchS E{(const bf16_t*)(ws + G_G), (const bf16_t*)(ws + G_P), (bf16_t*)(ws + G_U)};
            pg::gemm_phase(lds, 1024, S, E, tid);
            SEAM(base + 5);
        }
        if (((PH_MASK >> 7) & 1) && IN(base + 6)) { FRESH_ARGS;
            SchedPlain S{(const bf16_t*)(ws + G_U), (const bf16_t*)(ws + WS_WO), TG / 256, 4, 1024, nblk, bid};
            EpiF32 E{(float*)(ws + G_MIX), 1024};
            pg::gemm_phase(lds, 1024, S, E, tid);
            SEAM(base + 6);
        }
        if (((PH_MASK >> 8) & 1) && IN(base + 7)) { FRESH_ARGS; p8_post(a, grp, bid, nblk, tid); SEAM(base + 7); }
#pragma unroll 1
        for (int qi = 0; qi < NQ; ++qi) {
            const int qb = base + 8 + qi * 6;
            if (((PH_MASK >> 9) & 1) && IN(qb + 0)) { FRESH_ARGS;
                if (bid == 0 && tid < NEXP) ((int*)(ws + WS_CTL))[CW_CNT + tid] = 0;
                const bf16_t* H2q = (const bf16_t*)(ws + G_H2) + (size_t)qi * QT * 1024;
                SchedPlain S{H2q, (const bf16_t*)(ws + WS_W1) + (size_t)NEXP * 512 * 1024, QT / 256, 3, 1024, nblk, bid};
                EpiQ1 E{(bf16_t*)(ws + M_HID), (float*)(ws + M_LOG)};
                pg::gemm_phase(lds, 1024, S, E, tid);
                SEAM(qb + 0);
            }
            if (((PH_MASK >> 10) & 1) && IN(qb + 1)) { FRESH_ARGS; q2_route(a, bid, nblk, tid); SEAM(qb + 1); }
            if (((PH_MASK >> 11) & 1) && IN(qb + 2)) { FRESH_ARGS; q3_scatter(a, lds, bid, nblk, tid); SEAM(qb + 2); }
            if (((PH_MASK >> 12) & 1) && IN(qb + 3)) { FRESH_ARGS;
                LAS int* offs = (LAS int*)(lds + EPI_OFF); moe_offsets(a, offs, tid);
                const bf16_t* H2q = (const bf16_t*)(ws + G_H2) + (size_t)qi * QT * 1024;
                SchedQ4 S{H2q, (const bf16_t*)(ws + WS_W1), (const int*)(ws + M_ROWL), offs, nblk, bid};
                EpiQ4 E{(bf16_t*)(ws + M_HID)};
                pg::gemm_phase(lds, 1024, S, E, tid);
                SEAM(qb + 3);
            }
            if (((PH_MASK >> 13) & 1) && IN(qb + 4)) { FRESH_ARGS;
                LAS int* offs = (LAS int*)(lds + EPI_OFF); moe_offsets(a, offs, tid);
                SchedQ5 S{(const bf16_t*)(ws + M_HID), (const bf16_t*)(ws + WS_W2), offs, nblk, bid};
                EpiQ5 E{(const int*)(ws + M_ROWL), (const float*)(ws + M_TOPW), (bf16_t*)(ws + M_AOUT), (bf16_t*)(ws + M_SOUT)};
                pg::gemm_phase(lds, 256, S, E, tid);
                SEAM(qb + 4);
            }
            if (((PH_MASK >> 14) & 1) && IN(qb + 5)) { FRESH_ARGS; q6_combine(a, grp, qi, bid, nblk, tid); SEAM(qb + 5); }
        }
    }
#undef IN
#undef SEAM
}

typedef void (*KernFn)(Args);
template <unsigned M> static KernFn kern() { return fwd<M>; }
static KernFn phase_kernel(int bit) {
    switch (bit) {
        case 0: return kern<1u << 0>(); case 1: return kern<1u << 1>(); case 2: return kern<1u << 2>(); case 3: return kern<1u << 3>(); case 4: return kern<1u << 4>();
        case 5: return kern<1u << 5>(); case 6: return kern<1u << 6>(); case 7: return kern<1u << 7>(); case 8: return kern<1u << 8>(); case 9: return kern<1u << 9>();
        case 10: return kern<1u << 10>(); case 11: return kern<1u << 11>(); case 12: return kern<1u << 12>(); case 13: return kern<1u << 13>(); default: return kern<1u << 14>();
    }
}
static int step_bit(int s) { if (s == 0) return 0; const int r = (s - 1) % STEPS_PER_GRP; return r < 8 ? 1 + r : 9 + (r - 8) % 6; }
extern "C" void kernel_launch(void* const* d_in, const int* in_sizes, int n_in, void* d_out, int out_size, void* d_ws, size_t ws_size, hipStream_t stream) {
    static int grid = 0;
    if (grid == 0) {
        if (n_in != 33 || ws_size < WS_NEED) { fprintf(stderr, "kernel_launch: need 33 inputs and %zu bytes of workspace (got %d, %zu)\n", (size_t)WS_NEED, n_in, ws_size); grid = -1; return; }
        int dev = 0, cus = 0;
        if (hipGetDevice(&dev) != hipSuccess || hipDeviceGetAttribute(&cus, hipDeviceAttributeMultiprocessorCount, dev) != hipSuccess) { grid = -1; return; }
#if N_LAUNCH_MODE == 1
        if (hipFuncSetAttribute((const void*)kern<0x7FFFu>(), hipFuncAttributeMaxDynamicSharedMemorySize, LDS_BYTES) != hipSuccess) { fprintf(stderr, "kernel_launch: hipFuncSetAttribute failed\n"); grid = -1; return; }
        int per_cu = 0;
        if (hipOccupancyMaxActiveBlocksPerMultiprocessor(&per_cu, (const void*)kern<0x7FFFu>(), NT, LDS_BYTES) != hipSuccess || per_cu < 1) fprintf(stderr, "kernel_launch: occupancy query reports %d\n", per_cu);
#else
        for (int b = 0; b < 15; ++b) if (hipFuncSetAttribute((const void*)phase_kernel(b), hipFuncAttributeMaxDynamicSharedMemorySize, LDS_BYTES) != hipSuccess) { fprintf(stderr, "kernel_launch: hipFuncSetAttribute failed\n"); grid = -1; return; }
#endif
        (void)hipGetLastError();
        grid = cus;
    }
    if (grid < 0) return;
    (void)in_sizes; (void)out_size;
    (void)hipMemsetAsync((char*)d_ws + WS_CTL, 0, CTL_BYTES, stream);
    Args a{};
    for (int i = 0; i < 33; ++i) a.in[i] = (const float*)d_in[i];
    a.out = (float*)d_out; a.ws = (unsigned char*)d_ws;
#if N_LAUNCH_MODE == 1
    a.ph_lo = 0; a.ph_hi = N_STEPS;
    hipLaunchKernelGGL(kern<0x7FFFu>(), dim3(grid), dim3(NT), LDS_BYTES, stream, a);
#else
    for (int s = 0; s < N_STEPS; ++s) { a.ph_lo = s; a.ph_hi = s + 1; hipLaunchKernelGGL(phase_kernel(step_bit(s)), dim3(grid), dim3(NT), LDS_BYTES, stream, a); }
#endif
}
```

```cpp
#include <hip/hip_runtime.h>
#include <stdint.h>
#include <stdio.h>

#ifndef REPEAT_MASK
#define REPEAT_MASK 0u
#endif
#ifndef N_LAUNCH_MODE
#define N_LAUNCH_MODE 1
#endif

#define LAS __attribute__((address_space(3)))
#define DI __device__ __forceinline__
typedef unsigned short bf16_t;
typedef short bf16x8 __attribute__((ext_vector_type(8)));
typedef float f32x4 __attribute__((ext_vector_type(4)));
typedef float f32x2 __attribute__((ext_vector_type(2)));
typedef float f32x16 __attribute__((ext_vector_type(16)));
typedef unsigned u32x4 __attribute__((ext_vector_type(4)));
typedef unsigned u32x2 __attribute__((ext_vector_type(2)));
typedef __bf16 bf16v2 __attribute__((ext_vector_type(2)));

DI unsigned pk_bf16(float lo, float hi) { f32x2 v = {lo, hi}; bf16v2 b = __builtin_convertvector(v, bf16v2); return __builtin_bit_cast(unsigned, b); }
DI bf16_t f2bf(float x) { return (bf16_t)(pk_bf16(x, 0.f) & 0xffffu); }
DI float bflo(unsigned u) { return __uint_as_float(u << 16); }
DI float bfhi(unsigned u) { return __uint_as_float(u & 0xffff0000u); }
DI float bf2f(bf16_t x) { return __uint_as_float(((unsigned)x) << 16); }
DI float sigmoidf_(float x) { return __builtin_amdgcn_rcpf(1.0f + __expf(-x)); }
DI float siluf_(float x) { return x * __builtin_amdgcn_rcpf(1.0f + __expf(-x)); }
DI int swap23(int i) { return (i & ~12) | ((i & 4) << 1) | ((i & 8) >> 1); }
DI int crow(int reg, int h) { return (reg & 3) + 8 * (reg >> 2) + 4 * h; }
#define MFMA32(a, b, c) __builtin_amdgcn_mfma_f32_32x32x16_bf16((a), (b), (c), 0, 0, 0)
DI bf16x8 pack_step(const f32x16& x, int s) {
    u32x4 p;
    p[0] = pk_bf16(x[8 * s + 0], x[8 * s + 1]); p[1] = pk_bf16(x[8 * s + 2], x[8 * s + 3]);
    p[2] = pk_bf16(x[8 * s + 4], x[8 * s + 5]); p[3] = pk_bf16(x[8 * s + 6], x[8 * s + 7]);
    return __builtin_bit_cast(bf16x8, p);
}
DI float shx(float v, int o, int lane) { return __int_as_float(__builtin_amdgcn_ds_bpermute((lane ^ o) << 2, __float_as_int(v))); }
DI int shxi(int v, int o, int lane) { return __builtin_amdgcn_ds_bpermute((lane ^ o) << 2, v); }
DI float shidx(float v, int src) { return __int_as_float(__builtin_amdgcn_ds_bpermute(src << 2, __float_as_int(v))); }
DI float wave_sum(float v, int lane) {
#pragma unroll
    for (int o = 32; o >= 1; o >>= 1) v += shx(v, o, lane);
    return v;
}

constexpr int NB = 16, SEQ = 2048, DM = 1024, CTXL = 256, SALL = SEQ + CTXL;
constexpr int GB = 8;
constexpr int NGRP = NB / GB;
constexpr int TG = GB * SEQ;
constexpr int CG = GB * CTXL;
constexpr int HR = TG + CG;
constexpr int QT = 8192;
constexpr int NQ = TG / QT;
constexpr int IN_COLS = 8224;
constexpr float EPS = 1e-6f;
constexpr float LAM_INIT = 0.2f;
constexpr float QSCALE = 0.125f * 1.4426950408889634f;
constexpr int NEXP = 64;
constexpr int MAXROWS = QT * 8 + NEXP * 256;
constexpr int SH_ROW0 = MAXROWS;
constexpr int HID_ROWS = MAXROWS + QT;

constexpr size_t AL(size_t x) { return (x + 255) & ~(size_t)255; }
constexpr size_t WS_CTL   = 0;
constexpr size_t CTL_BYTES = 16384;
constexpr size_t WS_MOD   = WS_CTL + CTL_BYTES;
constexpr size_t WS_ROPE  = WS_MOD + AL(17 * 6144 * 4);
constexpr size_t WS_WIN   = WS_ROPE + AL(2048 * 32 * 2 * 4);
constexpr size_t WS_WV    = WS_WIN + AL((size_t)4352 * 1024 * 2);
constexpr size_t WS_WZG   = WS_WV + AL((size_t)1024 * 1024 * 2);
constexpr size_t WS_WA    = WS_WZG + AL((size_t)3072 * 1024 * 2);
constexpr size_t WS_WS    = WS_WA + AL((size_t)1024 * 1024 * 2);
constexpr size_t WS_WO    = WS_WS + AL((size_t)1024 * 1024 * 2);
constexpr size_t WS_W1    = WS_WO + AL((size_t)1024 * 1024 * 2);
constexpr size_t WS_W2    = WS_W1 + AL(((size_t)65 * 512 + 256) * 1024 * 2);
constexpr size_t WS_GRP   = WS_W2 + AL((size_t)65 * 1024 * 256 * 2);
constexpr size_t G_H   = WS_GRP;
constexpr size_t G_Q   = G_H + AL((size_t)HR * 1024 * 2);
constexpr size_t G_K   = G_Q + AL((size_t)TG * 1024 * 2);
constexpr size_t G_VT  = G_K + AL((size_t)GB * SALL * 1024 * 2);
constexpr size_t G_XBC = G_VT + AL((size_t)GB * 1024 * SALL * 2);
constexpr size_t G_DT  = G_XBC + AL((size_t)GB * SALL * 2048 * 2);
constexpr size_t G_O   = G_DT + AL((size_t)GB * SALL * 32 * 4);
constexpr size_t G_YF  = G_O + AL((size_t)TG * 1024 * 2);
constexpr size_t G_YB  = G_YF + AL((size_t)TG * 1024 * 2);
constexpr size_t G_END = G_YB + AL((size_t)TG * 1024 * 2);
constexpr size_t G_YN  = G_Q;
constexpr size_t G_G   = G_XBC;
constexpr size_t G_P   = G_K;
constexpr size_t G_U   = G_VT;
constexpr size_t G_MIX = G_YF;
constexpr size_t G_H2  = G_O;
constexpr size_t M_LOG  = G_H;
constexpr size_t M_TOPE = M_LOG + AL((size_t)QT * 64 * 4);
constexpr size_t M_TOPW = M_TOPE + AL((size_t)QT * 8 * 4);
constexpr size_t M_TPOS = M_TOPW + AL((size_t)QT * 8 * 4);
constexpr size_t M_BCNT = M_TPOS + AL((size_t)QT * 8 * 4);
constexpr size_t M_OFFS = M_BCNT + AL((size_t)1024 * 64 * 4);
constexpr size_t M_ROWL = M_OFFS + AL(66 * 4);
constexpr size_t M_HID  = M_ROWL + AL((size_t)MAXROWS * 4);
constexpr size_t M_AOUT = M_HID + AL((size_t)HID_ROWS * 256 * 2);
constexpr size_t M_SOUT = M_AOUT + AL((size_t)QT * 8 * 1024 * 2);
constexpr size_t M_END  = M_SOUT + AL((size_t)QT * 1024 * 2);
static_assert(M_END <= G_O, "MoE quarter buffers must fit under H2");
constexpr size_t WS_NEED = G_END;
constexpr int CW_Q3 = 3584;
#ifndef SSD_REPEAT
#define SSD_REPEAT 0
#endif

#define XB_TMO      128
#define XB_XCNT(j)  (256  + 64 * (j))
#define XB_XSUB(j)  (1280 + 64 * (j))
#define XB_XGEN(j)  (2304 + 64 * (j))
#define XB_TOP      3328
#define XB_TOPGEN   3392
#define XCD_BAR_WORDS 3456
#define XB_SPIN_CAP (1u << 18)
DI unsigned xb_ld(unsigned* p)              { return __hip_atomic_load(p, __ATOMIC_RELAXED, __HIP_MEMORY_SCOPE_AGENT); }
DI unsigned xb_add(unsigned* p, unsigned v) { return __hip_atomic_fetch_add(p, v, __ATOMIC_RELAXED, __HIP_MEMORY_SCOPE_AGENT); }
DI unsigned xb_xcc_id() { return (unsigned)__builtin_amdgcn_s_getreg((3 << 11) | 20) & 0xFu; }
#define XB_SPIN(cond, bar) do { unsigned _sp = 0; while (cond) { __builtin_amdgcn_s_sleep(1); \
    if ((++_sp & 255u) == 0u) { if (xb_ld(&(bar)[XB_TMO])) break; if (_sp > XB_SPIN_CAP) { atomicAdd(&(bar)[XB_TMO], 1u); break; } } } } while (0)
struct XcdBarrier { unsigned* bar; unsigned x; volatile LAS unsigned* st; };
DI XcdBarrier xcd_barrier_post(unsigned* bar, volatile LAS unsigned* st, int tid) {
    XcdBarrier b; b.bar = bar; b.x = xb_xcc_id(); b.st = st;
    if (tid == 0) (void)xb_add(&bar[XB_XCNT(b.x)], 1u);
    return b;
}
DI void xcd_barrier_complete(unsigned* bar, unsigned x, unsigned& nloc, unsigned& nx) {
    const unsigned G = gridDim.x * gridDim.y * gridDim.z;
    unsigned sum, cnt, mine, sp = 0u;
    for (;;) {
        sum = 0u; cnt = 0u; mine = 0u;
#pragma unroll 1
        for (unsigned j = 0; j < 16; ++j) { const unsigned c = xb_ld(&bar[XB_XCNT(j)]); sum += c; cnt += (c > 0u) ? 1u : 0u; mine = (j == x) ? c : mine; }
        if (sum == G) break;
        __builtin_amdgcn_s_sleep(1);
        if ((++sp & 255u) == 0u) { if (xb_ld(&bar[XB_TMO])) break; if (sp > XB_SPIN_CAP) { atomicAdd(&bar[XB_TMO], 1u); break; } }
    }
    nloc = mine > 0u ? mine : 1u; nx = cnt > 0u ? cnt : 1u;
}
DI void xcd_barrier(const XcdBarrier& b, int tid) {
    asm volatile("s_waitcnt vmcnt(0)" ::: "memory");
    __syncthreads();
    if (tid == 0) {
        unsigned* bar = b.bar;
        __builtin_amdgcn_s_waitcnt(0);
        unsigned nloc = b.st[0], nx = b.st[1];
        if (nloc == 0u) { xcd_barrier_complete(bar, b.x, nloc, nx); b.st[0] = nloc; b.st[1] = nx; }
        const unsigned old = xb_add(&bar[XB_XSUB(b.x)], 1u);
        const unsigned gen = old / nloc;
        if (old + 1u == (gen + 1u) * nloc) {
            __builtin_amdgcn_fence(__ATOMIC_RELEASE, "agent");
            asm volatile("s_waitcnt vmcnt(0)" ::: "memory");
            const unsigned og = xb_add(&bar[XB_TOP], 1u);
            const unsigned tg = og / nx;
            if (og + 1u == (tg + 1u) * nx) xb_add(&bar[XB_TOPGEN], 1u);
            else XB_SPIN(xb_ld(&bar[XB_TOPGEN]) == tg, bar);
            __builtin_amdgcn_fence(__ATOMIC_ACQUIRE, "agent");
            xb_add(&bar[XB_XGEN(b.x)], 1u);
            asm volatile("s_waitcnt vmcnt(0)" ::: "memory");
        } else {
            XB_SPIN(xb_ld(&bar[XB_XGEN(b.x)]) == gen, bar);
            __builtin_amdgcn_fence(__ATOMIC_ACQUIRE, "agent");
            asm volatile("s_waitcnt vmcnt(0)" ::: "memory");
        }
    }
    __syncthreads();
}

namespace pg {
constexpr int BM = 256, BK = 64, HALF = 128, HTB = HALF * BK * 2, STAGE_BYTES = 8 * HTB;
DI int lds_byte(int r, int c) { const int st = (r >> 4) * 2 + (c >> 5), rr = r & 15, cc = c & 31, ob = rr * 64 + cc * 2; return st * 1024 + (ob ^ (((ob >> 9) & 1) << 5)); }
DI void stage_rc(int b, int& R, int& C) { const int st = b / 1024, sb = b % 1024, swz = sb ^ (((sb >> 9) & 1) << 5); R = (st >> 1) * 16 + swz / 64; C = (st & 1) * 32 + (swz % 64) / 2; }
DI int perm32(int rho) { const int n = rho >> 4, i = rho & 15; return 8 * (i >> 2) + 4 * n + (i & 3); }
struct Unit { int pm, pn, kind, aux; };
DI void decode_tiles(int L, int nM, int nN, int& pm, int& pn) {
    const int nwg = nM * nN; int wgid = L;
    { const int q = nwg / 8, r = nwg % 8, xcd = wgid % 8, off = wgid / 8; wgid = (xcd < r ? xcd * (q + 1) : r * (q + 1) + (xcd - r) * q) + off; }
    const int nig = 8 * nN, gid = wgid / nig, fm = gid * 8, gsz = (nM - fm) < 8 ? (nM - fm) : 8;
    pm = fm + ((wgid % nig) % gsz); pn = (wgid % nig) / gsz;
}
template <class Epi, class Sched>
DI void gemm_phase(LAS unsigned char* lds, const int K, const Sched& S, const Epi& E, int tid_in) {
    constexpr bool GATHER = Sched::GATHER;
    int tid = tid_in; asm volatile("" : "+v"(tid));
    const int wid = __builtin_amdgcn_readfirstlane(tid >> 6), lane = tid & 63, wr = wid >> 2, wc = wid & 3, fr = lane & 15, fq = lane >> 4;
    const int nt = K / BK;
    unsigned voffA[2], voffB[2];
    int Rr[2], Cc[2];
#pragma unroll
    for (int i = 0; i < 2; ++i) { int R, C; stage_rc(tid * 16 + i * 8192, R, C); const int Rb = (R & ~31) + perm32(R & 31);
        Rr[i] = R; Cc[i] = C; voffA[i] = (unsigned)(R * K + C) * 2u; voffB[i] = (unsigned)(Rb * K + C) * 2u; }
    const size_t kstep = (size_t)(BK * 2);
    const size_t hstep = (size_t)HALF * K * 2;
    const unsigned ldsw = (unsigned)wid * 1024u;
    const int aoff = lds_byte(wr * 64 + fr, fq * 8), boff = lds_byte(wc * 32 + fr, fq * 8);
#define PG_SA(b, h) (((b) * 2 + (h)) * HTB)
#define PG_SB(b, h) ((4 + (b) * 2 + (h)) * HTB)
#define PG_STAGE(bufoff, gbase, voff) do { _Pragma("unroll") for (int _i = 0; _i < 2; ++_i) \
        __builtin_amdgcn_global_load_lds((const unsigned*)((const char*)(gbase) + (voff)[_i]), (LAS unsigned*)(lds + (bufoff) + ldsw + _i * 8192), 16, 0, 0); } while (0)
#define PG_STAGE_A(bufoff, gb, kofs, h, o0, o1) do { if constexpr (GATHER) { if ((h) == 0) PG_STAGE(bufoff, (gb) + (kofs), o0); else PG_STAGE(bufoff, (gb) + (kofs), o1); } \
        else { PG_STAGE(bufoff, (gb) + (kofs) + (h) * hstep, voffA); } } while (0)
#define PG_LDA(dst, b, h) do { _Pragma("unroll") for (int m = 0; m < 4; ++m) _Pragma("unroll") for (int k = 0; k < 2; ++k) dst[m][k] = *(const LAS bf16x8*)(lds + PG_SA(b, h) + aoff + m * 2048 + k * 1024); } while (0)
#define PG_LDB(dst, b, h) do { _Pragma("unroll") for (int n = 0; n < 2; ++n) _Pragma("unroll") for (int k = 0; k < 2; ++k) dst[n][k] = *(const LAS bf16x8*)(lds + PG_SB(b, h) + boff + n * 2048 + k * 1024); } while (0)
#define PG_MMA(ai, bj, At, Bt) do { __builtin_amdgcn_s_setprio(1); _Pragma("unroll") for (int m = 0; m < 4; ++m) _Pragma("unroll") for (int n = 0; n < 2; ++n) _Pragma("unroll") for (int k = 0; k < 2; ++k) \
        acc[ai][bj][m][n] = __builtin_amdgcn_mfma_f32_16x16x32_bf16(Bt[n][k], At[m][k], acc[ai][bj][m][n], 0, 0, 0); __builtin_amdgcn_s_setprio(0); } while (0)
#define PG_WAIT_V(n) asm volatile("s_waitcnt vmcnt(" #n ")" ::: "memory")
#define PG_WAIT_L(n) asm volatile("s_waitcnt lgkmcnt(" #n ")" ::: "memory")
#define PG_BAR __builtin_amdgcn_s_barrier()
#define PG_SCHED __builtin_amdgcn_sched_barrier(0)
#define PG_AOFFS(u, o0, o1) do { if constexpr (GATHER) { _Pragma("unroll") for (int _i = 0; _i < 2; ++_i) { \
        o0[_i] = (unsigned)(S.a_row(u, Rr[_i]) * K + Cc[_i]) * 2u; o1[_i] = (unsigned)(S.a_row(u, HALF + Rr[_i]) * K + Cc[_i]) * 2u; } } } while (0)
    Unit cur, nxt; int ui = 0;
    if (!S.next(0, cur)) return;
    f32x4 acc[2][2][4][2];
#pragma unroll
    for (int a = 0; a < 2; ++a)
#pragma unroll
        for (int b = 0; b < 2; ++b)
#pragma unroll
            for (int m = 0; m < 4; ++m)
#pragma unroll
                for (int n = 0; n < 2; ++n) acc[a][b][m][n] = (f32x4){0.f, 0.f, 0.f, 0.f};
    bf16x8 At[4][2], B0[2][2], B1[2][2];
    unsigned cA0[2] = {0u, 0u}, cA1[2] = {0u, 0u}, nA0[2] = {0u, 0u}, nA1[2] = {0u, 0u};
    const char* cA = S.a_tile(cur); const char* cB = S.b_base(cur);
    PG_AOFFS(cur, cA0, cA1);
    PG_STAGE(PG_SB(0, 0), cB, voffB); PG_STAGE(PG_SB(0, 1), cB + hstep, voffB); PG_STAGE_A(PG_SA(0, 0), cA, 0, 0, cA0, cA1); PG_STAGE_A(PG_SA(0, 1), cA, 0, 1, cA0, cA1);
    if (wr == 1) PG_BAR;
    PG_WAIT_V(2); PG_BAR;
    PG_STAGE(PG_SB(1, 0), cB + kstep, voffB); PG_STAGE_A(PG_SA(1, 0), cA, kstep, 0, cA0, cA1); PG_STAGE(PG_SB(1, 1), cB + hstep + kstep, voffB);
    PG_WAIT_V(6); PG_BAR;
    for (;;) {
        const bool has_next = S.next(ui + 1, nxt);
        const char* nA = cA; const char* nB = cB;
        if (has_next) { nA = S.a_tile(nxt); nB = S.b_base(nxt); PG_AOFFS(nxt, nA0, nA1); }
        else if constexpr (GATHER) { nA0[0] = cA0[0]; nA0[1] = cA0[1]; nA1[0] = cA1[0]; nA1[1] = cA1[1]; }
        for (int t = 0; t < nt; t += 2) {
            const bool last = (t == nt - 2);
            const char* a1 = cA + (size_t)(t + 1) * kstep;
            const char* a2 = last ? nA : cA + (size_t)(t + 2) * kstep; const char* b2 = last ? nB : cB + (size_t)(t + 2) * kstep;
            const char* b3 = b2 + kstep;
            unsigned s0[2] = {0u, 0u}, s1[2] = {0u, 0u};
            if constexpr (GATHER) { s0[0] = last ? nA0[0] : cA0[0]; s0[1] = last ? nA0[1] : cA0[1]; s1[0] = last ? nA1[0] : cA1[0]; s1[1] = last ? nA1[1] : cA1[1]; }
            PG_LDB(B0, 0, 0); PG_LDB(B1, 0, 1); PG_SCHED; PG_LDA(At, 0, 0); PG_STAGE_A(PG_SA(1, 1), a1, 0, 1, cA0, cA1);
            PG_WAIT_V(8); PG_WAIT_L(0); PG_BAR; PG_MMA(0, 0, At, B0); PG_MMA(0, 1, At, B1); PG_BAR; PG_SCHED;
            PG_LDA(At, 0, 1); PG_STAGE(PG_SB(0, 0), b2, voffB); PG_STAGE(PG_SB(0, 1), b2 + hstep, voffB); PG_STAGE_A(PG_SA(0, 0), a2, 0, 0, s0, s1);
            PG_WAIT_V(8); PG_WAIT_L(0); PG_BAR; PG_MMA(1, 0, At, B0); PG_MMA(1, 1, At, B1); PG_BAR; PG_SCHED;
            PG_LDB(B0, 1, 0); PG_LDB(B1, 1, 1); PG_SCHED; PG_LDA(At, 1, 0); PG_STAGE_A(PG_SA(0, 1), a2, 0, 1, s0, s1);
            PG_WAIT_V(8); PG_WAIT_L(0); PG_BAR; PG_MMA(0, 0, At, B0); PG_MMA(0, 1, At, B1); PG_BAR; PG_SCHED;
            PG_LDA(At, 1, 1); PG_STAGE(PG_SB(1, 0), b3, voffB); PG_STAGE(PG_SB(1, 1), b3 + hstep, voffB); PG_STAGE_A(PG_SA(1, 0), a2, kstep, 0, s0, s1);
            PG_WAIT_V(8); PG_WAIT_L(0); PG_BAR; PG_MMA(1, 0, At, B0); PG_MMA(1, 1, At, B1); PG_BAR; PG_SCHED;
        }
        if (wr == 0) PG_BAR;
        { int fr_ = fr, fq_ = fq; asm volatile("" : "+v"(fr_), "+v"(fq_));
          E(acc, cur, wr, wc, fr_, fq_, lane); }
        if (!has_next) break;
#pragma unroll
        for (int a = 0; a < 2; ++a)
#pragma unroll
            for (int b = 0; b < 2; ++b)
#pragma unroll
                for (int m = 0; m < 4; ++m)
#pragma unroll
                    for (int n = 0; n < 2; ++n) acc[a][b][m][n] = (f32x4){0.f, 0.f, 0.f, 0.f};
        cur = nxt; cA = nA; cB = nB; ++ui;
        if constexpr (GATHER) { cA0[0] = nA0[0]; cA0[1] = nA0[1]; cA1[0] = nA1[0]; cA1[1] = nA1[1]; }
        if (wr == 1) PG_BAR;
    }
    PG_WAIT_V(0);
    PG_BAR;
#undef PG_SA
#undef PG_SB
#undef PG_STAGE
#undef PG_STAGE_A
#undef PG_LDA
#undef PG_LDB
#undef PG_MMA
#undef PG_WAIT_V
#undef PG_WAIT_L
#undef PG_BAR
#undef PG_SCHED
#undef PG_AOFFS
}
template <class F> DI void for_each8(const f32x4 (&acc)[2][2][4][2], int wr, int wc, int fr, int fq, F&& f) {
#pragma unroll
    for (int ai = 0; ai < 2; ++ai)
#pragma unroll
        for (int m = 0; m < 4; ++m)
#pragma unroll
            for (int bj = 0; bj < 2; ++bj) { f(ai * HALF + wr * 64 + m * 16 + fr, bj * HALF + wc * 32 + 8 * fq, acc[ai][bj][m][0], acc[ai][bj][m][1]); asm volatile("" ::: "memory"); }
}
DI u32x4 pack8(const f32x4& a, const f32x4& b) { u32x4 w; w.x = pk_bf16(a[0], a[1]); w.y = pk_bf16(a[2], a[3]); w.z = pk_bf16(b[0], b[1]); w.w = pk_bf16(b[2], b[3]); return w; }
}

struct Args { const float* in[33]; float* out; unsigned char* ws; int ph_lo, ph_hi; };
typedef const Args __attribute__((address_space(4))) KArgs;
#define KA KArgs&
enum { I_X = 0, I_C, I_CTX, I_CCTX, I_WADA, I_BADA, I_GPRE1, I_GPOST1, I_GPRE2, I_GPOST2, I_WIN, I_LQ1, I_LK1, I_LQ2, I_LK2, I_GSUB, I_CONVW, I_CONVB, I_DTB, I_ALOG,
       I_DSKIP, I_GSSD, I_WBA, I_WBS, I_WOUT, I_WR, I_RB, I_WEG, I_WEU, I_WED, I_WSG, I_WSU, I_WSD };
constexpr int NT = 512;
constexpr int RING_BYTES = pg::STAGE_BYTES;
constexpr int EPI_OFF = RING_BYTES;
constexpr int MISC_OFF = EPI_OFF + 4096;
constexpr int LDS_BYTES = MISC_OFF + 256;

DI void cvt_seg(const float* src, int ld, int col0, bf16_t* dst, int ncols, int nvalid, int K, int mode, int rowoff, int bid, int nblk, int tid_in, LAS unsigned char* lds) {
    int tid_ = tid_in; asm volatile("" : "+v"(tid_)); const int tid = tid_, jl = tid & 63, kg = tid >> 6;
    const int njb = ncols / 64, nkb = K / 128, nitems = njb * nkb;
    for (int it = bid; it < nitems; it += nblk) {
        const int jb = it % njb, kb = it / njb;
        const int j = jb * 64 + jl, k0 = kb * 128 + kg * 16;
        float v[16];
#pragma unroll
        for (int i = 0; i < 16; ++i) v[i] = (j < nvalid) ? src[(size_t)(k0 + i) * ld + col0 + j] : 0.f;
        u32x4 w0, w1;
        w0.x = pk_bf16(v[0], v[1]); w0.y = pk_bf16(v[2], v[3]); w0.z = pk_bf16(v[4], v[5]); w0.w = pk_bf16(v[6], v[7]);
        w1.x = pk_bf16(v[8], v[9]); w1.y = pk_bf16(v[10], v[11]); w1.z = pk_bf16(v[12], v[13]); w1.w = pk_bf16(v[14], v[15]);
        __syncthreads();
        *(LAS u32x4*)(lds + jl * 272 + kg * 32) = w0; *(LAS u32x4*)(lds + jl * 272 + kg * 32 + 16) = w1;
        __syncthreads();
#pragma unroll
        for (int q = 0; q < 2; ++q) {
            const int idx = q * NT + tid, r = idx >> 4, ch = idx & 15, jj = jb * 64 + r;
            int row = jj;
            if (mode == 1) { const int blk = jj >> 6, d = jj & 63; row = blk * 64 + 2 * (d & 31) + (d >> 5); }
            else if (mode == 2) { row = (jj >> 7) * 256 + (jj & 127); }
            *(u32x4*)(dst + (size_t)(rowoff + row) * K + kb * 128 + ch * 8) = *(const LAS u32x4*)(lds + r * 272 + ch * 16);
        }
    }
    __syncthreads();
}
DI void p0_prologue(KA a, LAS unsigned char* lds, int bid, int nblk, int tid_in) {
    unsigned char* ws = a.ws;
    int tid_ = tid_in; asm volatile("" : "+v"(tid_)); const int tid = tid_;
    const float* w_in = a.in[I_WIN];
    bf16_t* WIN = (bf16_t*)(ws + WS_WIN);
    cvt_seg(w_in, IN_COLS, 0,    WIN, 1024, 1024, 1024, 1, 0,    bid, nblk, tid, lds);
    cvt_seg(w_in, IN_COLS, 1024, WIN, 1024, 1024, 1024, 1, 1024, bid, nblk, tid, lds);
    cvt_seg(w_in, IN_COLS, 4096, WIN, 2048, 2048, 1024, 0, 2048, bid, nblk, tid, lds);
    cvt_seg(w_in, IN_COLS, 6144, WIN, 256,  32,   1024, 0, 4096, bid, nblk, tid, lds);
    cvt_seg(w_in, IN_COLS, 2048, (bf16_t*)(ws + WS_WV),  1024, 1024, 1024, 0, 0,    bid, nblk, tid, lds);
    cvt_seg(w_in, IN_COLS, 3072, (bf16_t*)(ws + WS_WZG), 1024, 1024, 1024, 0, 0,    bid, nblk, tid, lds);
    cvt_seg(w_in, IN_COLS, 6176, (bf16_t*)(ws + WS_WZG), 2048, 2048, 1024, 0, 1024, bid, nblk, tid, lds);
    cvt_seg(a.in[I_WBA],  1024, 0, (bf16_t*)(ws + WS_WA), 1024, 1024, 1024, 0, 0, bid, nblk, tid, lds);
    cvt_seg(a.in[I_WBS],  1024, 0, (bf16_t*)(ws + WS_WS), 1024, 1024, 1024, 0, 0, bid, nblk, tid, lds);
    cvt_seg(a.in[I_WOUT], 1024, 0, (bf16_t*)(ws + WS_WO), 1024, 1024, 1024, 0, 0, bid, nblk, tid, lds);
    bf16_t* W1 = (bf16_t*)(ws + WS_W1); bf16_t* W2 = (bf16_t*)(ws + WS_W2);
    for (int e = 0; e < NEXP; ++e) {
        cvt_seg(a.in[I_WEG] + (size_t)e * 1024 * 256, 256, 0, W1 + (size_t)e * 512 * 1024, 256, 256, 1024, 2, 0,   bid, nblk, tid, lds);
        cvt_seg(a.in[I_WEU] + (size_t)e * 1024 * 256, 256, 0, W1 + (size_t)e * 512 * 1024, 256, 256, 1024, 2, 128, bid, nblk, tid, lds);
        cvt_seg(a.in[I_WED] + (size_t)e * 256 * 1024, 1024, 0, W2 + (size_t)e * 1024 * 256, 1024, 1024, 256, 0, 0, bid, nblk, tid, lds);
    }
    cvt_seg(a.in[I_WSG], 256, 0, W1 + (size_t)NEXP * 512 * 1024, 256, 256, 1024, 2, 0,   bid, nblk, tid, lds);
    cvt_seg(a.in[I_WSU], 256, 0, W1 + (size_t)NEXP * 512 * 1024, 256, 256, 1024, 2, 128, bid, nblk, tid, lds);
    cvt_seg(a.in[I_WSD], 1024, 0, W2 + (size_t)NEXP * 1024 * 256, 1024, 1024, 256, 0, 0, bid, nblk, tid, lds);
    cvt_seg(a.in[I_WR], 64, 0, W1 + (size_t)65 * 512 * 1024, 256, 64, 1024, 0, 0, bid, nblk, tid, lds);
    {
        float* rope = (float*)(ws + WS_ROPE);
        for (int idx = bid * NT + tid; idx < 2048 * 32; idx += nblk * NT) {
            const int n = idx >> 5, i = idx & 31, m = i & 15;
            const float inv = powf(10000.0f, -(float)(2 * m) / 32.0f);
            const float ang = (float)(i < 16 ? (n >> 6) : (n & 63)) * inv;
            float s, c; sincosf(ang, &s, &c);
            rope[idx * 2] = c; rope[idx * 2 + 1] = s;
        }
    }
    {
        LAS float* sc = (LAS float*)lds;
        LAS float* red = (LAS float*)(lds + 17 * 1024 * 4);
        float* MOD = (float*)(ws + WS_MOD);
        const float* w_ada = a.in[I_WADA];
        bool filled = false;
        for (int it = bid; it < 6144 / 64; it += nblk) {
            if (!filled) {
                for (int idx = tid; idx < 17 * 1024; idx += NT) { const int r = idx >> 10, k = idx & 1023; const float c = (r < 16) ? a.in[I_C][r * 1024 + k] : a.in[I_CCTX][k]; sc[idx] = siluf_(c); }
                filled = true;
            }
            __syncthreads();
            const int jl = tid & 63, kg = tid >> 6, j = it * 64 + jl;
            float acc[17];
#pragma unroll
            for (int r = 0; r < 17; ++r) acc[r] = 0.f;
            for (int k = kg * 128; k < kg * 128 + 128; ++k) {
                const float w = w_ada[(size_t)k * 6144 + j];
#pragma unroll
                for (int r = 0; r < 17; ++r) acc[r] += sc[r * 1024 + k] * w;
            }
#pragma unroll
            for (int r = 0; r < 17; ++r) red[(kg * 64 + jl) * 17 + r] = acc[r];
            __syncthreads();
            for (int idx = tid; idx < 64 * 17; idx += NT) {
                const int jj = idx / 17, r = idx % 17; float s = 0.f;
#pragma unroll
                for (int g = 0; g < 8; ++g) s += red[(g * 64 + jj) * 17 + r];
                MOD[r * 6144 + it * 64 + jj] = s + a.in[I_BADA][it * 64 + jj];
            }
            __syncthreads();
        }
    }
}

DI void p1_norm(KA a, int grp, int bid, int nblk, int tid_in) {
    int tid_ = tid_in; asm volatile("" : "+v"(tid_)); const int tid = tid_, wid = tid >> 6, lane = tid & 63;
    bf16_t* H = (bf16_t*)(a.ws + G_H);
    const float* MOD = (const float*)(a.ws + WS_MOD);
    const float* g = a.in[I_GPRE1];
    for (int row = bid * 8 + wid; row < HR; row += nblk * 8) {
        const float* src; int mrow;
        if (row < TG) { const int grow = grp * TG + row; src = a.in[I_X] + (size_t)grow * 1024; mrow = grow >> 11; }
        else { const int crow_ = grp * CG + (row - TG); src = a.in[I_CTX] + (size_t)crow_ * 1024; mrow = 16; }
        f32x4 v[4]; float ss = 0.f;
#pragma unroll
        for (int i = 0; i < 4; ++i) { v[i] = *(const f32x4*)(src + i * 256 + lane * 4); ss += v[i][0] * v[i][0] + v[i][1] * v[i][1] + v[i][2] * v[i][2] + v[i][3] * v[i][3]; }
        ss = wave_sum(ss, lane);
        const float rs = rsqrtf(ss * (1.0f / 1024.0f) + EPS);
        const float* sh = MOD + mrow * 6144; const float* scl = sh + 1024;
#pragma unroll
        for (int i = 0; i < 4; ++i) {
            const int c = i * 256 + lane * 4;
            const f32x4 gg = *(const f32x4*)(g + c), s1 = *(const f32x4*)(sh + c), s2 = *(const f32x4*)(scl + c);
            f32x4 y = v[i] * rs * gg * (s2 + 1.0f) + s1;
            u32x2 w; w.x = pk_bf16(y[0], y[1]); w.y = pk_bf16(y[2], y[3]);
            *(u32x2*)(H + (size_t)row * 1024 + c) = w;
        }
    }
}

struct SchedInproj {
    const bf16_t* H; const bf16_t* WIN; const bf16_t* WV; int G, c;
    static constexpr int NA = 72 * 17, NTOT = NA + 4 * 72;
    DI bool next(int i, pg::Unit& u) const {
        const int L = i * G + c; if (L >= NTOT) return false;
        if (L < NA) { pg::decode_tiles(L, 72, 17, u.pm, u.pn); u.kind = 0; }
        else { const int j = L - NA; u.pm = j & 3; u.pn = j >> 2; u.kind = 1; }
        u.aux = 0; return true;
    }
    static constexpr bool GATHER = false;
    DI const char* a_tile(const pg::Unit& u) const { return (const char*)((u.kind == 0 ? H : WV) + (size_t)u.pm * 256 * 1024); }
    DI int a_row(const pg::Unit&, int) const { return 0; }
    DI const char* b_base(const pg::Unit& u) const { return (const char*)((u.kind == 0 ? WIN : H) + (size_t)u.pn * 256 * 1024); }
};
struct EpiInproj {
    bf16_t* Q; bf16_t* Kb; bf16_t* VT; bf16_t* XBC; float* DT; const float* rope; const float* dtb;
    DI void operator()(const f32x4 (&acc)[2][2][4][2], const pg::Unit& u, int wr, int wc, int fr, int fq, int lane) const {
        if (u.kind == 1) {
            pg::for_each8(acc, wr, wc, fr, fq, [&](int r, int c, const f32x4& v0, const f32x4& v1) {
                const int vcol = u.pm * 256 + r, tok = u.pn * 256 + c; int b, pos;
                if (tok < TG) { b = tok >> 11; pos = CTXL + (tok & 2047); } else { const int t2 = tok - TG; b = t2 >> 8; pos = t2 & 255; }
                *(u32x4*)(VT + ((size_t)b * 1024 + vcol) * SALL + pos) = pg::pack8(v0, v1);
            });
            return;
        }
        const bool isctx = u.pm >= 64;
        if (u.pn < 8) {
            if (isctx && u.pn < 4) return;
            const bool isq = u.pn < 4;
            pg::for_each8(acc, wr, wc, fr, fq, [&](int r, int c, const f32x4& v0, const f32x4& v1) {
                const int R = u.pm * 256 + r, col = (u.pn & 3) * 256 + c;
                f32x4 o0 = v0, o1 = v1; size_t drow;
                if (!isctx) {
                    const int n = R & 2047, i0 = (col & 63) >> 1;
                    const f32x4 cs0 = *(const f32x4*)(rope + (size_t)(n * 32 + i0) * 2), cs1 = *(const f32x4*)(rope + (size_t)(n * 32 + i0 + 2) * 2);
                    o0[0] = v0[0] * cs0[0] - v0[1] * cs0[1]; o0[1] = v0[1] * cs0[0] + v0[0] * cs0[1];
                    o0[2] = v0[2] * cs0[2] - v0[3] * cs0[3]; o0[3] = v0[3] * cs0[2] + v0[2] * cs0[3];
                    o1[0] = v1[0] * cs1[0] - v1[1] * cs1[1]; o1[1] = v1[1] * cs1[0] + v1[0] * cs1[1];
                    o1[2] = v1[2] * cs1[2] - v1[3] * cs1[3]; o1[3] = v1[3] * cs1[2] + v1[2] * cs1[3];
                    drow = isq ? (size_t)R : (size_t)(R >> 11) * SALL + CTXL + n;
                } else { const int t2 = R - TG; drow = (size_t)(t2 >> 8) * SALL + (t2 & 255); }
                if (isq) { o0 = o0 * QSCALE; o1 = o1 * QSCALE; }
                *(u32x4*)((isq ? Q : Kb) + drow * 1024 + col) = pg::pack8(o0, o1);
            });
            return;
        }
        if (u.pn < 16) {
            pg::for_each8(acc, wr, wc, fr, fq, [&](int r, int c, const f32x4& v0, const f32x4& v1) {
                const int R = u.pm * 256 + r, col = (u.pn - 8) * 256 + c; size_t drow;
                if (!isctx) drow = (size_t)(R >> 11) * SALL + CTXL + (R & 2047); else { const int t2 = R - TG; drow = (size_t)(t2 >> 8) * SALL + (t2 & 255); }
                *(u32x4*)(XBC + drow * 2048 + col) = pg::pack8(v0, v1);
            });
            return;
        }
        pg::for_each8(acc, wr, wc, fr, fq, [&](int r, int c, const f32x4& v0, const f32x4& v1) {
            if (c >= 32) return;
            const int R = u.pm * 256 + r; size_t drow;
            if (!isctx) drow = (size_t)(R >> 11) * SALL + CTXL + (R & 2047); else { const int t2 = R - TG; drow = (size_t)(t2 >> 8) * SALL + (t2 & 255); }
            f32x4 o0, o1;
#pragma unroll
            for (int i = 0; i < 4; ++i) {
                const float x0 = v0[i] + dtb[c + i], x1 = v1[i] + dtb[c + 4 + i];
                o0[i] = fmaxf(x0, 0.f) + log1pf(__expf(-fabsf(x0))); o1[i] = fmaxf(x1, 0.f) + log1pf(__expf(-fabsf(x1)));
            }
            *(f32x4*)(DT + drow * 32 + c) = o0; *(f32x4*)(DT + drow * 32 + c + 4) = o1;
        });
    }
};

DI void attn_unit(KA a, LAS unsigned char* lds, int grp, int b, int head, int qb, int tid_in) {
    int tid = tid_in; asm volatile("" : "+v"(tid));
    const int wid = tid >> 6, lane = tid & 63, l31 = lane & 31, hh = lane >> 5;
    const bf16_t* Qg = (const bf16_t*)(a.ws + G_Q) + ((size_t)(b * SEQ + qb * 256 + wid * 32 + l31)) * 1024 + head * 128;
    const bf16_t* Kg = (const bf16_t*)(a.ws + G_K) + (size_t)b * SALL * 1024 + head * 128;
    const bf16_t* Vg = (const bf16_t*)(a.ws + G_VT) + ((size_t)b * 1024 + head * 128) * SALL;
    const int krow = tid >> 3, kch = tid & 7;
    const unsigned kst = (unsigned)(krow * 128 + ((kch ^ ((krow >> 1) & 7)) * 16));
    const unsigned vst0 = (unsigned)(krow * 128 + ((kch ^ ((krow >> 1) & 7)) * 16)), vst1 = vst0 + 64 * 128;
    const unsigned vst1b = (unsigned)((krow + 64) * 128 + ((kch ^ (((krow + 64) >> 1) & 7)) * 16));
    (void)vst1;
    const int kr0 = swap23(l31);
    LAS u32x4* o0s = (LAS u32x4*)(lds + 49152 + tid * 128);
    float lam;
    {
        const float p1 = wave_sum(a.in[I_LQ1][lane] * a.in[I_LK1][lane], lane), p2 = wave_sum(a.in[I_LQ2][lane] * a.in[I_LK2][lane], lane);
        lam = __expf(p1) - __expf(p2) + LAM_INIT;
    }
#pragma unroll 1
    for (int c = 0; c < 2; ++c) {
        bf16x8 qf[4];
#pragma unroll
        for (int s = 0; s < 4; ++s) qf[s] = *(const bf16x8*)(Qg + c * 64 + 16 * s + 8 * hh);
        f32x16 O[4];
#pragma unroll
        for (int d = 0; d < 4; ++d)
#pragma unroll
            for (int r = 0; r < 16; ++r) O[d][r] = 0.f;
        float mrun = -INFINITY, lrun = 0.f;
        {
            const u32x4 kx = *(const u32x4*)(Kg + (size_t)krow * 1024 + c * 64 + kch * 8);
            const u32x4 v0 = *(const u32x4*)(Vg + (size_t)krow * SALL + kch * 8), v1 = *(const u32x4*)(Vg + (size_t)(krow + 64) * SALL + kch * 8);
            __syncthreads();
            *(LAS u32x4*)(lds + kst) = kx; *(LAS u32x4*)(lds + 16384 + vst0) = v0; *(LAS u32x4*)(lds + 16384 + vst1b) = v1;
            __syncthreads();
        }
#pragma unroll 1
        for (int jt = 0; jt < SALL / 64; ++jt) {
            const int buf = jt & 1;
            const bool more = jt + 1 < SALL / 64;
            u32x4 kx, v0, v1;
            if (more) {
                const int key0 = (jt + 1) * 64;
                kx = *(const u32x4*)(Kg + (size_t)(key0 + krow) * 1024 + c * 64 + kch * 8);
                v0 = *(const u32x4*)(Vg + (size_t)krow * SALL + key0 + kch * 8); v1 = *(const u32x4*)(Vg + (size_t)(krow + 64) * SALL + key0 + kch * 8);
            }
            const LAS unsigned char* Kb = lds + buf * 8192; const LAS unsigned char* Vb = lds + 16384 + buf * 16384;
            f32x16 S[2];
#pragma unroll
            for (int kh = 0; kh < 2; ++kh) {
#pragma unroll
                for (int r = 0; r < 16; ++r) S[kh][r] = 0.f;
                const int row = kh * 32 + kr0;
#pragma unroll
                for (int s = 0; s < 4; ++s) {
                    const bf16x8 kf = *(const LAS bf16x8*)(Kb + row * 128 + (((2 * s + hh) ^ ((row >> 1) & 7)) * 16));
                    S[kh] = MFMA32(kf, qf[s], S[kh]);
                }
            }
            float mx = S[0][0];
#pragma unroll
            for (int r = 0; r < 16; ++r) { mx = fmaxf(mx, S[0][r]); mx = fmaxf(mx, S[1][r]); }
            mx = fmaxf(mx, shx(mx, 32, lane));
            const float mnew = fmaxf(mrun, mx);
            const float alpha = __builtin_amdgcn_exp2f(mrun - mnew);
            mrun = mnew;
            float ls = 0.f;
#pragma unroll
            for (int kh = 0; kh < 2; ++kh)
#pragma unroll
                for (int r = 0; r < 16; ++r) { const float pv = __builtin_amdgcn_exp2f(S[kh][r] - mnew); S[kh][r] = pv; ls += pv; }
            lrun = lrun * alpha + ls;
            if (__any(alpha != 1.0f)) {
#pragma unroll
                for (int d = 0; d < 4; ++d)
#pragma unroll
                    for (int r = 0; r < 16; ++r) O[d][r] *= alpha;
            }
            bf16x8 pf[2][2];
#pragma unroll
            for (int kh = 0; kh < 2; ++kh)
#pragma unroll
                for (int s2 = 0; s2 < 2; ++s2) pf[kh][s2] = pack_step(S[kh], s2);
#pragma unroll
            for (int d = 0; d < 4; ++d) {
                const int row = d * 32 + l31;
#pragma unroll
                for (int kh = 0; kh < 2; ++kh)
#pragma unroll
                    for (int s2 = 0; s2 < 2; ++s2) {
                        const bf16x8 vf = *(const LAS bf16x8*)(Vb + row * 128 + (((kh * 4 + s2 * 2 + hh) ^ ((row >> 1) & 7)) * 16));
                        O[d] = MFMA32(vf, pf[kh][s2], O[d]);
                    }
            }
            if (more) {
                LAS unsigned char* Kn = lds + (buf ^ 1) * 8192; LAS unsigned char* Vn = lds + 16384 + (buf ^ 1) * 16384;
                *(LAS u32x4*)(Kn + kst) = kx; *(LAS u32x4*)(Vn + vst0) = v0; *(LAS u32x4*)(Vn + vst1b) = v1;
            }
            __syncthreads();
        }
        const float ltot = lrun + shx(lrun, 32, lane);
        const float inv = 1.0f / ltot;
        if (c == 0) {
#pragma unroll
            for (int d = 0; d < 4; ++d)
#pragma unroll
                for (int rp = 0; rp < 2; ++rp) {
                    u32x4 w;
                    w.x = pk_bf16(O[d][rp * 8 + 0] * inv, O[d][rp * 8 + 1] * inv); w.y = pk_bf16(O[d][rp * 8 + 2] * inv, O[d][rp * 8 + 3] * inv);
                    w.z = pk_bf16(O[d][rp * 8 + 4] * inv, O[d][rp * 8 + 5] * inv); w.w = pk_bf16(O[d][rp * 8 + 6] * inv, O[d][rp * 8 + 7] * inv);
                    o0s[d * 2 + rp] = w;
                }
        } else {
            float ss = 0.f;
#pragma unroll
            for (int d = 0; d < 4; ++d)
#pragma unroll
                for (int rq = 0; rq < 4; ++rq) {
                    const u32x4 wq = o0s[d * 2 + (rq >> 1)];
                    const unsigned w0 = wq[(rq & 1) * 2 + 0], w1 = wq[(rq & 1) * 2 + 1];
                    const float a0 = bflo(w0) - lam * O[d][rq * 4 + 0] * inv, a1 = bfhi(w0) - lam * O[d][rq * 4 + 1] * inv;
                    const float a2 = bflo(w1) - lam * O[d][rq * 4 + 2] * inv, a3 = bfhi(w1) - lam * O[d][rq * 4 + 3] * inv;
                    O[d][rq * 4 + 0] = a0; O[d][rq * 4 + 1] = a1; O[d][rq * 4 + 2] = a2; O[d][rq * 4 + 3] = a3;
                    ss += a0 * a0 + a1 * a1 + a2 * a2 + a3 * a3;
                }
            ss += shx(ss, 32, lane);
            const float rs = rsqrtf(ss * (1.0f / 128.0f) + EPS) * (1.0f - LAM_INIT);
            bf16_t* Og = (bf16_t*)(a.ws + G_O) + ((size_t)(b * SEQ + qb * 256 + wid * 32 + l31)) * 1024 + head * 128;
            const float* gs = a.in[I_GSUB];
#pragma unroll
            for (int d = 0; d < 4; ++d)
#pragma unroll
                for (int rq = 0; rq < 4; ++rq) {
                    const int d0 = d * 32 + 8 * rq + 4 * hh;
                    const f32x4 g4 = *(const f32x4*)(gs + d0);
                    u32x2 w; w.x = pk_bf16(O[d][rq * 4 + 0] * rs * g4[0], O[d][rq * 4 + 1] * rs * g4[1]); w.y = pk_bf16(O[d][rq * 4 + 2] * rs * g4[2], O[d][rq * 4 + 3] * rs * g4[3]);
                    *(u32x2*)(Og + d0) = w;
                }
        }
    }
    (void)grp;
}

#ifndef SSD_NO_B
#define SSD_NO_B 0
#endif
constexpr int SS_C = 0, SS_B = 16384, SS_BT = 32768, SS_XT = 49152, SS_WXT = 81920, SS_SM = 114688;
DI void ssd_unit(KA a, LAS unsigned char* lds, int b, int g, int dir, int tid_in) {
    int tid = tid_in; asm volatile("" : "+v"(tid));
    const int wid = __builtin_amdgcn_readfirstlane(tid >> 6);
    const int hl = wid >> 1, pt = wid & 1, head = g * 4 + hl;
    const bf16_t* xbc = (const bf16_t*)(a.ws + G_XBC) + (size_t)b * SALL * 2048;
    const float* dtp = (const float*)(a.ws + G_DT) + (size_t)b * SALL * 32;
    bf16_t* Yout = (bf16_t*)(a.ws + (dir == 0 ? G_YF : G_YB)) + (size_t)b * SEQ * 1024 + head * 64 + pt * 32 + (tid & 31);
    const float dsk = (dir == 0) ? a.in[I_DSKIP][head] : 0.f;
    LAS float* sm_acum = (LAS float*)(lds + SS_SM);
    LAS float* sm_dt   = sm_acum + 256;
    LAS float* sm_w    = sm_acum + 512;
    LAS float* sm_ea   = sm_acum + 768;
    LAS float* sm_dec  = sm_acum + 1024;
    f32x16 hT[4];
#pragma unroll
    for (int n = 0; n < 4; ++n)
#pragma unroll
        for (int r = 0; r < 16; ++r) hT[n][r] = 0.f;
#pragma unroll 1
    for (int ci = 0; ci < 36; ++ci) {
        const bool isctx = ci < 4; const int cc = isctx ? ci : ci - 4;
        const int seg0 = isctx ? 0 : CTXL, seglen = isctx ? CTXL : SEQ;
        const int t0 = (dir == 0) ? cc * 64 : seglen - 64 * (cc + 1);
        int tidc = tid; asm volatile("" : "+v"(tidc));
        const int lane = tidc & 63;
        const int cg = tidc & 63, tg = tidc >> 6;
        int gcol;
        if (cg < 32) gcol = g * 256 + cg * 8; else if (cg < 48) gcol = 1024 + g * 128 + (cg - 32) * 8; else gcol = 1536 + g * 128 + (cg - 48) * 8;
        if (wid < 4) {
            const int tok = seg0 + (dir == 0 ? t0 + lane : t0 + 63 - lane);
            const float dtv = dtp[(size_t)tok * 32 + dir * 16 + g * 4 + wid];
            const float av = -__expf(a.in[I_ALOG][dir * 16 + g * 4 + wid]);
            float v = dtv * av;
#pragma unroll
            for (int o = 1; o < 64; o <<= 1) { const float n = shidx(v, lane - o); if (lane >= o) v += n; }
            const float tot = shidx(v, 63);
            sm_acum[wid * 64 + lane] = v; sm_dt[wid * 64 + lane] = dtv; sm_w[wid * 64 + lane] = __expf(tot - v) * dtv; sm_ea[wid * 64 + lane] = __expf(v);
            if (lane == 63) sm_dec[wid] = __expf(tot);
        }
        __syncthreads();
#pragma unroll 1
        for (int hf = 0; hf < (SSD_NO_B ? 0 : 2); ++hf) {
            const float* cw = a.in[I_CONVW]; const float* cb = a.in[I_CONVB];
            const int gc = gcol + hf * 4;
            const f32x4 w0 = *(const f32x4*)(cw + gc), w1 = *(const f32x4*)(cw + 2048 + gc), w2 = *(const f32x4*)(cw + 4096 + gc), bb = *(const f32x4*)(cb + gc);
            float raw[10][4];
#pragma unroll
            for (int k = 0; k < 10; ++k) {
                const int tt = t0 + tg * 8 + k - 1;
                u32x2 rv = (u32x2){0u, 0u};
                if (tt >= 0 && tt < seglen) rv = *(const u32x2*)(xbc + (size_t)(seg0 + tt) * 2048 + gc);
                raw[k][0] = bflo(rv.x); raw[k][1] = bfhi(rv.x); raw[k][2] = bflo(rv.y); raw[k][3] = bfhi(rv.y);
            }
            float val[8][4];
#pragma unroll
            for (int k = 0; k < 8; ++k)
#pragma unroll
                for (int i = 0; i < 4; ++i) val[k][i] = siluf_(bb[i] + w0[i] * raw[k][i] + w1[i] * raw[k + 1][i] + w2[i] * raw[k + 2][i]);
            const int sbase = (dir == 0) ? tg * 8 : 56 - tg * 8;
            if (cg >= 32) {
                const bool isC = cg >= 48; const int n0 = (isC ? cg - 48 : cg - 32) * 8;
                LAS unsigned char* rowimg = lds + (isC ? SS_C : SS_B);
#pragma unroll
                for (int k = 0; k < 8; ++k) {
                    const int sp = (dir == 0) ? tg * 8 + k : 63 - (tg * 8 + k);
                    u32x2 w; w.x = pk_bf16(val[k][0], val[k][1]); w.y = pk_bf16(val[k][2], val[k][3]);
                    *(LAS u32x2*)(rowimg + sp * 256 + ((((n0 >> 3)) ^ (sp & 15)) * 16) + hf * 8) = w;
                }
                if (!isC) {
#pragma unroll
                    for (int i = 0; i < 4; ++i) {
                        const int n = n0 + hf * 4 + i;
                        u32x4 w;
                        if (dir == 0) { w.x = pk_bf16(val[0][i], val[1][i]); w.y = pk_bf16(val[2][i], val[3][i]); w.z = pk_bf16(val[4][i], val[5][i]); w.w = pk_bf16(val[6][i], val[7][i]); }
                        else          { w.x = pk_bf16(val[7][i], val[6][i]); w.y = pk_bf16(val[5][i], val[4][i]); w.z = pk_bf16(val[3][i], val[2][i]); w.w = pk_bf16(val[1][i], val[0][i]); }
                        *(LAS u32x4*)(lds + SS_BT + n * 128 + (((sbase >> 3) ^ ((n >> 1) & 7)) * 16)) = w;
                    }
                }
            } else {
                const int xh = cg >> 3, p0 = (cg & 7) * 8 + hf * 4;
                float wv[8];
#pragma unroll
                for (int e = 0; e < 8; ++e) wv[e] = sm_w[xh * 64 + sbase + e];
#pragma unroll
                for (int i = 0; i < 4; ++i) {
                    const int p = p0 + i;
                    float x[8];
#pragma unroll
                    for (int e = 0; e < 8; ++e) x[e] = (dir == 0) ? val[e][i] : val[7 - e][i];
                    u32x4 w, ww;
                    w.x = pk_bf16(x[0], x[1]); w.y = pk_bf16(x[2], x[3]); w.z = pk_bf16(x[4], x[5]); w.w = pk_bf16(x[6], x[7]);
                    ww.x = pk_bf16(x[0] * wv[0], x[1] * wv[1]); ww.y = pk_bf16(x[2] * wv[2], x[3] * wv[3]); ww.z = pk_bf16(x[4] * wv[4], x[5] * wv[5]); ww.w = pk_bf16(x[6] * wv[6], x[7] * wv[7]);
                    const unsigned off = (unsigned)(xh * 8192 + p * 128 + (((sbase >> 3) ^ ((p >> 1) & 7)) * 16));
                    *(LAS u32x4*)(lds + SS_XT + off) = w; *(LAS u32x4*)(lds + SS_WXT + off) = ww;
                }
            }
        }
        __syncthreads();
        int lo_ = lane; asm volatile("" : "+v"(lo_));
        const int l31 = lo_ & 31, hh = lo_ >> 5;
        const LAS unsigned char* Ci = lds + SS_C; const LAS unsigned char* Bi = lds + SS_B; const LAS unsigned char* BTi = lds + SS_BT;
        const LAS unsigned char* XTi = lds + SS_XT + hl * 8192; const LAS unsigned char* WXTi = lds + SS_WXT + hl * 8192;
        const int prow = pt * 32 + l31;
        const LAS float* ea_c = sm_ea + hl * 64 + 4 * hh;
        const LAS float* ac_p = sm_acum + hl * 64 + 8 * hh;
        const LAS float* dt_p = sm_dt + hl * 64 + 8 * hh;
        if (!isctx) {
#pragma unroll
            for (int it = 0; it < 2; ++it) {
                f32x16 acc;
#pragma unroll
                for (int r = 0; r < 16; ++r) acc[r] = 0.f;
                const int irow = it * 32 + l31;
#pragma unroll
                for (int nt = 0; nt < 4; ++nt)
#pragma unroll
                    for (int s = 0; s < 2; ++s) {
                        const bf16x8 cf = *(const LAS bf16x8*)(Ci + irow * 256 + (((nt * 4 + 2 * s + hh) ^ (irow & 15)) * 16));
                        acc = MFMA32(cf, pack_step(hT[nt], s), acc);
                    }
                __builtin_amdgcn_sched_barrier(0);
#pragma unroll
                for (int r = 0; r < 16; ++r) acc[r] *= ea_c[it * 32 + 8 * (r >> 2) + (r & 3)];
                const float acum_i = sm_acum[hl * 64 + irow];
                __builtin_amdgcn_sched_barrier(0);
#pragma unroll
                for (int jt = 0; jt <= it; ++jt) {
                    f32x16 cb;
#pragma unroll
                    for (int r = 0; r < 16; ++r) cb[r] = 0.f;
                    const int jrow = jt * 32 + swap23(l31);
#pragma unroll
                    for (int ks = 0; ks < 8; ++ks) {
                        const bf16x8 bf = *(const LAS bf16x8*)(Bi + jrow * 256 + (((2 * ks + hh) ^ (jrow & 15)) * 16));
                        const bf16x8 cf = *(const LAS bf16x8*)(Ci + irow * 256 + (((2 * ks + hh) ^ (irow & 15)) * 16));
                        cb = MFMA32(bf, cf, cb);
                    }
                    __builtin_amdgcn_sched_barrier(0);
#pragma unroll
                    for (int r = 0; r < 16; ++r) {
                        const int jc = jt * 32 + 16 * (r >> 3) + 4 * ((r >> 2) & 1) + (r & 3);
                        const float dec = __expf(fminf(acum_i - ac_p[jc], 0.f)) * dt_p[jc];
                        cb[r] = (jc + 8 * hh <= irow) ? cb[r] * dec : 0.f;
                    }
#pragma unroll
                    for (int s = 0; s < 2; ++s) {
                        const bf16x8 xf = *(const LAS bf16x8*)(XTi + prow * 128 + (((jt * 4 + 2 * s + hh) ^ ((prow >> 1) & 7)) * 16));
                        acc = MFMA32(pack_step(cb, s), xf, acc);
                    }
                    __builtin_amdgcn_sched_barrier(0);
                }
#pragma unroll
                for (int rq = 0; rq < 4; ++rq) {
                    const u32x2 xs = *(const LAS u32x2*)(XTi + prow * 128 + (((it * 4 + rq) ^ ((prow >> 1) & 7)) * 16) + hh * 8);
                    const float xv[4] = {bflo(xs.x), bfhi(xs.x), bflo(xs.y), bfhi(xs.y)};
#pragma unroll
                    for (int j = 0; j < 4; ++j) {
                        const int i = it * 32 + 8 * rq + 4 * hh + j;
                        const int tnat = (dir == 0) ? t0 + i : t0 + 63 - i;
                        Yout[(size_t)tnat * 1024] = f2bf(acc[rq * 4 + j] + dsk * xv[j]);
                    }
                }
            }
        }
        {
            __builtin_amdgcn_sched_barrier(0);
            const float dec = sm_dec[hl];
#pragma unroll
            for (int nt = 0; nt < 4; ++nt) {
                __builtin_amdgcn_sched_barrier(0);
#pragma unroll
                for (int r = 0; r < 16; ++r) hT[nt][r] *= dec;
                const int nrow = nt * 32 + swap23(l31);
#pragma unroll
                for (int ks = 0; ks < 4; ++ks) {
                    const bf16x8 bf = *(const LAS bf16x8*)(BTi + nrow * 128 + (((2 * ks + hh) ^ ((nrow >> 1) & 7)) * 16));
                    const bf16x8 xf = *(const LAS bf16x8*)(WXTi + prow * 128 + (((2 * ks + hh) ^ ((prow >> 1) & 7)) * 16));
                    hT[nt] = MFMA32(bf, xf, hT[nt]);
                }
            }
        }
        __syncthreads();
    }
}

struct SchedPlain {
    const bf16_t* A; const bf16_t* Bt; int nM, nN, K, G, c;
    DI bool next(int i, pg::Unit& u) const {
        const int L = i * G + c; if (L >= nM * nN) return false;
        pg::decode_tiles(L, nM, nN, u.pm, u.pn); u.kind = 0; u.aux = 0; return true;
    }
    static constexpr bool GATHER = false;
    DI const char* a_tile(const pg::Unit& u) const { return (const char*)(A + (size_t)u.pm * 256 * K); }
    DI int a_row(const pg::Unit&, int) const { return 0; }
    DI const char* b_base(const pg::Unit& u) const { return (const char*)(Bt + (size_t)u.pn * 256 * K); }
};
struct EpiZG {
    const bf16_t* YF; const bf16_t* YB; bf16_t* YN; bf16_t* Gt; const float* gnorm; LAS float* scr;
    DI void operator()(const f32x4 (&acc)[2][2][4][2], const pg::Unit& u, int wr, int wc, int fr, int fq, int lane) const {
        if (u.pn >= 4) {
            pg::for_each8(acc, wr, wc, fr, fq, [&](int r, int c, const f32x4& v0, const f32x4& v1) {
                const int R = u.pm * 256 + r, col = (u.pn - 4) * 256 + c;
                f32x4 s0, s1;
#pragma unroll
                for (int i = 0; i < 4; ++i) { s0[i] = sigmoidf_(v0[i]); s1[i] = sigmoidf_(v1[i]); }
                *(u32x4*)(Gt + (size_t)R * 2048 + col) = pg::pack8(s0, s1);
            });
            return;
        }
        u32x4 yp[2][4][2];
#pragma unroll
        for (int ai = 0; ai < 2; ++ai)
#pragma unroll
            for (int m = 0; m < 4; ++m) {
                const int r = ai * 128 + wr * 64 + m * 16 + fr, R = u.pm * 256 + r; float ss = 0.f;
#pragma unroll
                for (int bj = 0; bj < 2; ++bj) {
                    const int col = u.pn * 256 + bj * 128 + wc * 32 + 8 * fq;
                    const u32x4 f = *(const u32x4*)(YF + (size_t)R * 1024 + col), bw = *(const u32x4*)(YB + (size_t)R * 1024 + col);
                    const float yv[8] = {bflo(f.x) + bflo(bw.x), bfhi(f.x) + bfhi(bw.x), bflo(f.y) + bflo(bw.y), bfhi(f.y) + bfhi(bw.y),
                                         bflo(f.z) + bflo(bw.z), bfhi(f.z) + bfhi(bw.z), bflo(f.w) + bflo(bw.w), bfhi(f.w) + bfhi(bw.w)};
                    float y[8];
#pragma unroll
                    for (int n = 0; n < 2; ++n)
#pragma unroll
                        for (int i = 0; i < 4; ++i) { const float z = acc[ai][bj][m][n][i]; y[n * 4 + i] = yv[n * 4 + i] * siluf_(z); ss += y[n * 4 + i] * y[n * 4 + i]; }
                    u32x4 w; w.x = pk_bf16(y[0], y[1]); w.y = pk_bf16(y[2], y[3]); w.z = pk_bf16(y[4], y[5]); w.w = pk_bf16(y[6], y[7]);
                    asm volatile("" : "+v"(w.x), "+v"(w.y), "+v"(w.z), "+v"(w.w));
                    yp[ai][m][bj] = w;
                }
                ss += shx(ss, 16, lane); ss += shx(ss, 32, lane);
                if (fq == 0) scr[r * 4 + wc] = ss;
                asm volatile("" ::: "memory");
            }
        asm volatile("s_waitcnt lgkmcnt(0)" ::: "memory"); __builtin_amdgcn_s_barrier(); asm volatile("" ::: "memory");
        asm volatile("" : "+v"(fr), "+v"(fq));
#pragma unroll
        for (int ai = 0; ai < 2; ++ai)
#pragma unroll
            for (int m = 0; m < 4; ++m) {
                const int r = ai * 128 + wr * 64 + m * 16 + fr, R = u.pm * 256 + r;
                const f32x4 ps = *(const LAS f32x4*)(scr + r * 4);
                const float rs = rsqrtf((ps[0] + ps[1] + ps[2] + ps[3]) * (1.0f / 256.0f) + EPS);
#pragma unroll
                for (int bj = 0; bj < 2; ++bj) {
                    const int col = u.pn * 256 + bj * 128 + wc * 32 + 8 * fq;
                    const f32x4 g0 = *(const f32x4*)(gnorm + col), g1 = *(const f32x4*)(gnorm + col + 4);
                    const u32x4 w = yp[ai][m][bj];
                    const f32x4 y0 = {bflo(w.x), bfhi(w.x), bflo(w.y), bfhi(w.y)}, y1 = {bflo(w.z), bfhi(w.z), bflo(w.w), bfhi(w.w)};
                    *(u32x4*)(YN + (size_t)R * 1024 + col) = pg::pack8(y0 * rs * g0, y1 * rs * g1);
                }
                asm volatile("" ::: "memory");
            }
        asm volatile("s_waitcnt lgkmcnt(0)" ::: "memory"); __builtin_amdgcn_s_barrier(); asm volatile("" ::: "memory");
        (void)lane;
    }
};
struct EpiBranchA {
    const bf16_t* Gt; bf16_t* P;
    DI void operator()(const f32x4 (&acc)[2][2][4][2], const pg::Unit& u, int wr, int wc, int fr, int fq, int) const {
        pg::for_each8(acc, wr, wc, fr, fq, [&](int r, int c, const f32x4& v0, const f32x4& v1) {
            const int R = u.pm * 256 + r, col = u.pn * 256 + c;
            const u32x4 gw = *(const u32x4*)(Gt + (size_t)R * 2048 + col);
            const f32x4 g0 = {bflo(gw.x), bfhi(gw.x), bflo(gw.y), bfhi(gw.y)}, g1 = {bflo(gw.z), bfhi(gw.z), bflo(gw.w), bfhi(gw.w)};
            *(u32x4*)(P + (size_t)R * 1024 + col) = pg::pack8(v0 * g0, v1 * g1);
        });
    }
};
struct EpiBranchS {
    const bf16_t* Gt; const bf16_t* P; bf16_t* U;
    DI void operator()(const f32x4 (&acc)[2][2][4][2], const pg::Unit& u, int wr, int wc, int fr, int fq, int) const {
        pg::for_each8(acc, wr, wc, fr, fq, [&](int r, int c, const f32x4& v0, const f32x4& v1) {
            const int R = u.pm * 256 + r, col = u.pn * 256 + c;
            const u32x4 gw = *(const u32x4*)(Gt + (size_t)R * 2048 + 1024 + col), pw = *(const u32x4*)(P + (size_t)R * 1024 + col);
            const f32x4 g0 = {bflo(gw.x), bfhi(gw.x), bflo(gw.y), bfhi(gw.y)}, g1 = {bflo(gw.z), bfhi(gw.z), bflo(gw.w), bfhi(gw.w)};
            const f32x4 p0 = {bflo(pw.x), bfhi(pw.x), bflo(pw.y), bfhi(pw.y)}, p1 = {bflo(pw.z), bfhi(pw.z), bflo(pw.w), bfhi(pw.w)};
            *(u32x4*)(U + (size_t)R * 1024 + col) = pg::pack8(p0 + v0 * g0, p1 + v1 * g1);
        });
    }
};
struct EpiF32 {
    float* O; int ldc;
    DI void operator()(const f32x4 (&acc)[2][2][4][2], const pg::Unit& u, int wr, int wc, int fr, int fq, int) const {
        pg::for_each8(acc, wr, wc, fr, fq, [&](int r, int c, const f32x4& v0, const f32x4& v1) {
            float* o = O + (size_t)(u.pm * 256 + r) * ldc + u.pn * 256 + c;
            *(f32x4*)o = v0; *(f32x4*)(o + 4) = v1;
        });
    }
};

DI void p8_post(KA a, int grp, int bid, int nblk, int tid_in) {
    int tid_ = tid_in; asm volatile("" : "+v"(tid_)); const int tid = tid_, wid = tid >> 6, lane = tid & 63;
    const float* MIX = (const float*)(a.ws + G_MIX); bf16_t* H2 = (bf16_t*)(a.ws + G_H2);
    const float* MOD = (const float*)(a.ws + WS_MOD);
    const float* g1 = a.in[I_GPOST1]; const float* g2 = a.in[I_GPRE2];
    for (int row = bid * 8 + wid; row < TG; row += nblk * 8) {
        const int grow = grp * TG + row; const float* md = MOD + (grow >> 11) * 6144;
        const float* xs = a.in[I_X] + (size_t)grow * 1024; const float* ms = MIX + (size_t)row * 1024; float* od = a.out + (size_t)grow * 1024;
        f32x4 mv[4], xv[4]; float ss = 0.f;
#pragma unroll
        for (int i = 0; i < 4; ++i) { mv[i] = *(const f32x4*)(ms + i * 256 + lane * 4); xv[i] = *(const f32x4*)(xs + i * 256 + lane * 4); ss += mv[i][0] * mv[i][0] + mv[i][1] * mv[i][1] + mv[i][2] * mv[i][2] + mv[i][3] * mv[i][3]; }
        ss = wave_sum(ss, lane);
        const float rs = rsqrtf(ss * (1.0f / 1024.0f) + EPS);
        float s2 = 0.f;
#pragma unroll
        for (int i = 0; i < 4; ++i) {
            const int c = i * 256 + lane * 4;
            const f32x4 gg = *(const f32x4*)(g1 + c), gt = *(const f32x4*)(md + 2048 + c);
            xv[i] = xv[i] + gt * (mv[i] * rs * gg);
            *(f32x4*)(od + c) = xv[i];
            s2 += xv[i][0] * xv[i][0] + xv[i][1] * xv[i][1] + xv[i][2] * xv[i][2] + xv[i][3] * xv[i][3];
        }
        s2 = wave_sum(s2, lane);
        const float rs2 = rsqrtf(s2 * (1.0f / 1024.0f) + EPS);
#pragma unroll
        for (int i = 0; i < 4; ++i) {
            const int c = i * 256 + lane * 4;
            const f32x4 gg = *(const f32x4*)(g2 + c), sh = *(const f32x4*)(md + 3072 + c), sc = *(const f32x4*)(md + 4096 + c);
            const f32x4 y = xv[i] * rs2 * gg * (sc + 1.0f) + sh;
            u32x2 w; w.x = pk_bf16(y[0], y[1]); w.y = pk_bf16(y[2], y[3]);
            *(u32x2*)(H2 + (size_t)row * 1024 + c) = w;
        }
    }
}

struct EpiQ1 {
    bf16_t* HID; float* LOG;
    DI void operator()(const f32x4 (&acc)[2][2][4][2], const pg::Unit& u, int wr, int wc, int fr, int fq, int) const {
        if (u.pn == 2) {
            pg::for_each8(acc, wr, wc, fr, fq, [&](int r, int c, const f32x4& v0, const f32x4& v1) {
                if (c >= 64) return;
                float* o = LOG + (size_t)(u.pm * 256 + r) * 64 + c; *(f32x4*)o = v0; *(f32x4*)(o + 4) = v1;
            });
            return;
        }
#pragma unroll
        for (int ai = 0; ai < 2; ++ai)
#pragma unroll
            for (int m = 0; m < 4; ++m) {
                const int r = ai * 128 + wr * 64 + m * 16 + fr, c = wc * 32 + 8 * fq;
                f32x4 h0, h1;
#pragma unroll
                for (int i = 0; i < 4; ++i) { h0[i] = siluf_(acc[ai][0][m][0][i]) * acc[ai][1][m][0][i]; h1[i] = siluf_(acc[ai][0][m][1][i]) * acc[ai][1][m][1][i]; }
                *(u32x4*)(HID + (size_t)(SH_ROW0 + u.pm * 256 + r) * 256 + u.pn * 128 + c) = pg::pack8(h0, h1);
            }
    }
};
DI void q2_route(KA a, LAS unsigned char* lds, int bid, int nblk, int tid_in) {
    int tid_ = tid_in; asm volatile("" : "+v"(tid_)); const int tid = tid_, wid = tid >> 6, lane = tid & 63;
    const float* LOG = (const float*)(a.ws + M_LOG); int* TOPE = (int*)(a.ws + M_TOPE); float* TOPW = (float*)(a.ws + M_TOPW); int* TPOS = (int*)(a.ws + M_TPOS);
    int* BCNT = (int*)(a.ws + M_BCNT);
    LAS int* hist = (LAS int*)lds;
    if (tid < NEXP) hist[tid] = 0;
    __syncthreads();
    const float bias = a.in[I_RB][lane];
    for (int t = bid * 8 + wid; t < QT; t += nblk * 8) {
        const float score = sigmoidf_(LOG[(size_t)t * 64 + lane]);
        const float sel = score + bias;
        float m1 = sel;
        m1 = fmaxf(m1, shx(m1, 1, lane)); m1 = fmaxf(m1, shx(m1, 2, lane)); m1 = fmaxf(m1, shx(m1, 4, lane));
        int i1 = (sel == m1) ? lane : 64;
        i1 = min(i1, shxi(i1, 1, lane)); i1 = min(i1, shxi(i1, 2, lane)); i1 = min(i1, shxi(i1, 4, lane));
        float m2 = (lane == i1) ? -INFINITY : sel;
        m2 = fmaxf(m2, shx(m2, 1, lane)); m2 = fmaxf(m2, shx(m2, 2, lane)); m2 = fmaxf(m2, shx(m2, 4, lane));
        const float gs = m1 + m2; const int myg = lane >> 3;
        int grank = 0;
#pragma unroll
        for (int g2 = 0; g2 < 8; ++g2) { const float o = __int_as_float(__builtin_amdgcn_readlane(__float_as_int(gs), g2 * 8)); grank += (o > gs || (o == gs && g2 < myg)) ? 1 : 0; }
        const float v = (grank < 4) ? sel : -INFINITY;
        int rank = 0;
#pragma unroll 4
        for (int e2 = 0; e2 < 64; ++e2) { const float o = __int_as_float(__builtin_amdgcn_readlane(__float_as_int(v), e2)); rank += (o > v || (o == v && e2 < lane)) ? 1 : 0; }
        const bool chosen = (rank < 8) && (grank < 4);
        const float wsum = wave_sum(chosen ? score : 0.f, lane);
        if (chosen) {
            const int pos = __hip_atomic_fetch_add(&hist[lane], 1, __ATOMIC_RELAXED, __HIP_MEMORY_SCOPE_WORKGROUP);
            TOPE[t * 8 + rank] = lane; TOPW[t * 8 + rank] = score / wsum * 2.5f; TPOS[t * 8 + rank] = pos;
        }
    }
    __syncthreads();
    if (tid < NEXP) BCNT[bid * NEXP + tid] = hist[tid];
}
DI void q3_scatter(KA a, LAS unsigned char* lds, int bid, int nblk, int tid_in) {
    int tid_ = tid_in; asm volatile("" : "+v"(tid_)); const int tid = tid_, wid = tid >> 6, lane = tid & 63;
    LAS int* tot = (LAS int*)lds; LAS int* base = tot + 64; LAS int* offs = base + 64;
    const int* BCNT = (const int*)(a.ws + M_BCNT);
    if (tid < NEXP) { int t_ = 0, p_ = 0; for (int b = 0; b < nblk; ++b) { const int c = BCNT[b * NEXP + tid]; t_ += c; p_ += (b < bid) ? c : 0; } tot[tid] = t_; base[tid] = p_; }
    __syncthreads();
    if (tid == 0) { int o = 0; for (int e = 0; e < NEXP; ++e) { offs[e] = o; o += (tot[e] + 255) & ~255; } offs[64] = o; offs[65] = o >> 8; }
    __syncthreads();
    if (tid < NEXP) base[tid] += offs[tid];
    if (bid == 0 && tid < 66) ((int*)(a.ws + M_OFFS))[tid] = offs[tid];
    __syncthreads();
    const int* TOPE = (const int*)(a.ws + M_TOPE); const int* TPOS = (const int*)(a.ws + M_TPOS); int* ROWL = (int*)(a.ws + M_ROWL);
    for (int t = bid * 8 + wid; t < QT; t += nblk * 8)
        if (lane < 8) { const int idx = t * 8 + lane; ROWL[base[TOPE[idx]] + TPOS[idx]] = idx; }
    for (int idx = bid * NT + tid; idx < NEXP * 256; idx += nblk * NT) {
        const int e = idx >> 8, k = idx & 255, c = tot[e], pad = ((c + 255) & ~255) - c;
        if (k < pad) ROWL[offs[e] + c + k] = -1;
    }
    __syncthreads();
}
DI void moe_offsets(KA a, LAS int* offs  , int tid) {
    if (tid < 66) offs[tid] = ((const int*)(a.ws + M_OFFS))[tid];
    __syncthreads();
}
struct SchedQ4 {
    const bf16_t* H2q; const bf16_t* W1; const int* ROWL; const LAS int* offs; int G, c;
    DI bool next(int i, pg::Unit& u) const {
        const int L = i * G + c; const int ntiles = offs[65]; if (L >= ntiles * 2) return false;
        u.pm = L >> 1; u.pn = L & 1; int e = 0;
#pragma unroll 1
        for (int k = 1; k < NEXP; ++k) e = (offs[k] <= u.pm * 256) ? k : e;
        u.kind = 0; u.aux = e; return true;
    }
    static constexpr bool GATHER = true;
    DI const char* a_tile(const pg::Unit&) const { return (const char*)H2q; }
    DI int a_row(const pg::Unit& u, int r) const { const int id = ROWL[u.pm * 256 + r]; return id < 0 ? 0 : (id >> 3); }
    DI const char* b_base(const pg::Unit& u) const { return (const char*)(W1 + ((size_t)u.aux * 512 + u.pn * 256) * 1024); }
};
struct EpiQ4 {
    bf16_t* HID;
    DI void operator()(const f32x4 (&acc)[2][2][4][2], const pg::Unit& u, int wr, int wc, int fr, int fq, int) const {
#pragma unroll
        for (int ai = 0; ai < 2; ++ai)
#pragma unroll
            for (int m = 0; m < 4; ++m) {
                const int r = ai * 128 + wr * 64 + m * 16 + fr, c = wc * 32 + 8 * fq;
                f32x4 h0, h1;
#pragma unroll
                for (int i = 0; i < 4; ++i) { h0[i] = siluf_(acc[ai][0][m][0][i]) * acc[ai][1][m][0][i]; h1[i] = siluf_(acc[ai][0][m][1][i]) * acc[ai][1][m][1][i]; }
                *(u32x4*)(HID + (size_t)(u.pm * 256 + r) * 256 + u.pn * 128 + c) = pg::pack8(h0, h1);
            }
    }
};
struct SchedQ5 {
    const bf16_t* HID; const bf16_t* W2; const LAS int* offs; int G, c;
    DI bool next(int i, pg::Unit& u) const {
        const int L = i * G + c; const int ne = offs[65] * 4; if (L >= ne + (QT / 256) * 4) return false;
        if (L < ne) { u.pm = L >> 2; u.pn = L & 3; int e = 0;
#pragma unroll 1
            for (int k = 1; k < NEXP; ++k) e = (offs[k] <= u.pm * 256) ? k : e;
            u.kind = 0; u.aux = e; }
        else { const int j = L - ne; u.pm = j >> 2; u.pn = j & 3; u.kind = 1; u.aux = NEXP; }
        return true;
    }
    static constexpr bool GATHER = false;
    DI const char* a_tile(const pg::Unit& u) const { return (const char*)(HID + (size_t)((u.kind == 0 ? 0 : SH_ROW0) + u.pm * 256) * 256); }
    DI int a_row(const pg::Unit&, int) const { return 0; }
    DI const char* b_base(const pg::Unit& u) const { return (const char*)(W2 + ((size_t)u.aux * 1024 + u.pn * 256) * 256); }
};
struct EpiQ5 {
    const int* ROWL; const float* TOPW; bf16_t* AOUT; bf16_t* SOUT;
    DI void operator()(const f32x4 (&acc)[2][2][4][2], const pg::Unit& u, int wr, int wc, int fr, int fq, int) const {
        pg::for_each8(acc, wr, wc, fr, fq, [&](int r, int c, const f32x4& v0, const f32x4& v1) {
            const int col = u.pn * 256 + c;
            if (u.kind == 1) { *(u32x4*)(SOUT + (size_t)(u.pm * 256 + r) * 1024 + col) = pg::pack8(v0, v1); return; }
            const int id = ROWL[u.pm * 256 + r]; if (id < 0) return;
            const float w = TOPW[id];
            *(u32x4*)(AOUT + (size_t)id * 1024 + col) = pg::pack8(v0 * w, v1 * w);
        });
    }
};
DI void q6_combine(KA a, int grp, int qi, int bid, int nblk, int tid_in) {
    int tid_ = tid_in; asm volatile("" : "+v"(tid_)); const int tid = tid_, wid = tid >> 6, lane = tid & 63;
    const bf16_t* AOUT = (const bf16_t*)(a.ws + M_AOUT); const bf16_t* SOUT = (const bf16_t*)(a.ws + M_SOUT);
    const float* MOD = (const float*)(a.ws + WS_MOD); const float* g = a.in[I_GPOST2];
    for (int t = bid * 8 + wid; t < QT; t += nblk * 8) {
        const int grow = grp * TG + qi * QT + t; const float* md = MOD + (grow >> 11) * 6144; float* od = a.out + (size_t)grow * 1024;
        float f[16];
        { const u32x4 s0 = *(const u32x4*)(SOUT + (size_t)t * 1024 + lane * 8), s1 = *(const u32x4*)(SOUT + (size_t)t * 1024 + 512 + lane * 8);
          f[0] = bflo(s0.x); f[1] = bfhi(s0.x); f[2] = bflo(s0.y); f[3] = bfhi(s0.y); f[4] = bflo(s0.z); f[5] = bfhi(s0.z); f[6] = bflo(s0.w); f[7] = bfhi(s0.w);
          f[8] = bflo(s1.x); f[9] = bfhi(s1.x); f[10] = bflo(s1.y); f[11] = bfhi(s1.y); f[12] = bflo(s1.z); f[13] = bfhi(s1.z); f[14] = bflo(s1.w); f[15] = bfhi(s1.w); }
#pragma unroll
        for (int s = 0; s < 8; ++s) {
            const bf16_t* rp = AOUT + ((size_t)t * 8 + s) * 1024;
            const u32x4 s0 = *(const u32x4*)(rp + lane * 8), s1 = *(const u32x4*)(rp + 512 + lane * 8);
            f[0] += bflo(s0.x); f[1] += bfhi(s0.x); f[2] += bflo(s0.y); f[3] += bfhi(s0.y); f[4] += bflo(s0.z); f[5] += bfhi(s0.z); f[6] += bflo(s0.w); f[7] += bfhi(s0.w);
            f[8] += bflo(s1.x); f[9] += bfhi(s1.x); f[10] += bflo(s1.y); f[11] += bfhi(s1.y); f[12] += bflo(s1.z); f[13] += bfhi(s1.z); f[14] += bflo(s1.w); f[15] += bfhi(s1.w);
        }
        float ss = 0.f;
#pragma unroll
        for (int i = 0; i < 16; ++i) ss += f[i] * f[i];
        ss = wave_sum(ss, lane);
        const float rs = rsqrtf(ss * (1.0f / 1024.0f) + EPS);
#pragma unroll
        for (int hf = 0; hf < 2; ++hf)
#pragma unroll
            for (int q4 = 0; q4 < 2; ++q4) {
                const int c = hf * 512 + lane * 8 + q4 * 4;
                const f32x4 gg = *(const f32x4*)(g + c), gt = *(const f32x4*)(md + 5120 + c), x1 = *(const f32x4*)(od + c);
                f32x4 fv = {f[hf * 8 + q4 * 4 + 0], f[hf * 8 + q4 * 4 + 1], f[hf * 8 + q4 * 4 + 2], f[hf * 8 + q4 * 4 + 3]};
                *(f32x4*)(od + c) = x1 + gt * (fv * rs * gg);
            }
    }
}

constexpr int STEPS_PER_GRP = 8 + NQ * 6;
constexpr int N_STEPS = 1 + NGRP * STEPS_PER_GRP;
template <unsigned PH_MASK>
__global__ void __launch_bounds__(NT, 2) fwd(Args a_) {
    extern __shared__ __attribute__((aligned(16))) unsigned char lds_raw[];
    LAS unsigned char* lds = (LAS unsigned char*)lds_raw;
    const int wave_id = __builtin_amdgcn_readfirstlane(threadIdx.x >> 6);
#define TID_NOW (wave_id * 64 + (int)__builtin_amdgcn_mbcnt_hi(~0u, __builtin_amdgcn_mbcnt_lo(~0u, 0u)))
    volatile LAS unsigned* misc = (volatile LAS unsigned*)(lds + MISC_OFF);
    { const int t = TID_NOW; if (t < 4) misc[t] = 0u; }
    __syncthreads();
    const int lo = a_.ph_lo, hi = a_.ph_hi;
    XcdBarrier bar; bar.bar = (unsigned*)(a_.ws + WS_CTL); bar.x = 0; bar.st = misc;
    if (hi - lo > 1) bar = xcd_barrier_post((unsigned*)(a_.ws + WS_CTL), misc, TID_NOW);
#define IN(k) (lo <= (k) && (k) < hi)
#define SEAM(k) do { if (IN(k) && IN((k) + 1)) xcd_barrier(bar, TID_NOW); } while (0)
#define FRESH_ARGS KArgs* ap_ = (KArgs*)__builtin_amdgcn_kernarg_segment_ptr(); asm volatile("" : "+s"(ap_)); KA a = *ap_; unsigned char* ws = a.ws; (void)ws; int bid = blockIdx.x, nblk = gridDim.x; asm volatile("" : "+s"(bid), "+s"(nblk)); int tid = TID_NOW; asm volatile("" : "+v"(tid))
    _Pragma("unroll 1") for (int rep_ = 0; rep_ < (((REPEAT_MASK >> 0) & 1u) ? 2 : 1); ++rep_) if (((PH_MASK >> 0) & 1) && IN(0)) { FRESH_ARGS; p0_prologue(a, lds, bid, nblk, tid); SEAM(0); }
#pragma unroll 1
    for (int grp = 0; grp < NGRP; ++grp) {
        const int base = 1 + grp * STEPS_PER_GRP;
        _Pragma("unroll 1") for (int rep_ = 0; rep_ < (((REPEAT_MASK >> 1) & 1u) ? 2 : 1); ++rep_) if (((PH_MASK >> 1) & 1) && IN(base + 0)) { FRESH_ARGS; p1_norm(a, grp, bid, nblk, tid); SEAM(base + 0); }
        _Pragma("unroll 1") for (int rep_ = 0; rep_ < (((REPEAT_MASK >> 2) & 1u) ? 2 : 1); ++rep_) if (((PH_MASK >> 2) & 1) && IN(base + 1)) { FRESH_ARGS;
            SchedInproj S{(const bf16_t*)(ws + G_H), (const bf16_t*)(ws + WS_WIN), (const bf16_t*)(ws + WS_WV), nblk, bid};
            EpiInproj E{(bf16_t*)(ws + G_Q), (bf16_t*)(ws + G_K), (bf16_t*)(ws + G_VT), (bf16_t*)(ws + G_XBC), (float*)(ws + G_DT), (const float*)(ws + WS_ROPE), a.in[I_DTB]};
            pg::gemm_phase(lds, 1024, S, E, tid);
            SEAM(base + 1);
        }
        _Pragma("unroll 1") for (int rep_ = 0; rep_ < (((REPEAT_MASK >> 3) & 1u) ? 2 : 1); ++rep_) if (((PH_MASK >> 3) & 1) && IN(base + 2)) { FRESH_ARGS;
            unsigned* qhead = (unsigned*)(ws + WS_CTL) + CW_Q3 + grp * 64;
            volatile LAS int* qslot = (volatile LAS int*)(lds + MISC_OFF + 64);
#pragma unroll 1
            for (;;) {
                if (tid == 0) qslot[0] = (int)__hip_atomic_fetch_add(qhead, 1u, __ATOMIC_RELAXED, __HIP_MEMORY_SCOPE_AGENT);
                __syncthreads();
                const int L = __builtin_amdgcn_readfirstlane(qslot[0]);
                __syncthreads();
                if (L >= 64 * (1 + SSD_REPEAT) + 512) break;
#ifndef NO_SSD
                if (L < 64 * (1 + SSD_REPEAT)) { const int u = L & 63; ssd_unit(a, lds, u >> 3, (u >> 1) & 3, u & 1, tid); }
#endif
#ifndef NO_ATTN
                if (L >= 64 * (1 + SSD_REPEAT) && L < 64 * (1 + SSD_REPEAT) + 512) { const int j = L - 64 * (1 + SSD_REPEAT); attn_unit(a, lds, grp, j >> 6, (j >> 3) & 7, j & 7, tid); }
#endif
                __syncthreads();
            }
            SEAM(base + 2);
        }
        _Pragma("unroll 1") for (int rep_ = 0; rep_ < (((REPEAT_MASK >> 4) & 1u) ? 2 : 1); ++rep_) if (((PH_MASK >> 4) & 1) && IN(base + 3)) { FRESH_ARGS;
            SchedPlain S{(const bf16_t*)(ws + G_H), (const bf16_t*)(ws + WS_WZG), TG / 256, 12, 1024, nblk, bid};
            EpiZG E{(const bf16_t*)(ws + G_YF), (const bf16_t*)(ws + G_YB), (bf16_t*)(ws + G_YN), (bf16_t*)(ws + G_G), a.in[I_GSSD], (LAS float*)(lds + EPI_OFF)};
            pg::gemm_phase(lds, 1024, S, E, tid);
            SEAM(base + 3);
        }
        _Pragma("unroll 1") for (int rep_ = 0; rep_ < (((REPEAT_MASK >> 5) & 1u) ? 2 : 1); ++rep_) if (((PH_MASK >> 5) & 1) && IN(base + 4)) { FRESH_ARGS;
            SchedPlain S{(const bf16_t*)(ws + G_O), (const bf16_t*)(ws + WS_WA), TG / 256, 4, 1024, nblk, bid};
            EpiBranchA E{(const bf16_t*)(ws + G_G), (bf16_t*)(ws + G_P)};
            pg::gemm_phase(lds, 1024, S, E, tid);
            SEAM(base + 4);
        }
        _Pragma("unroll 1") for (int rep_ = 0; rep_ < (((REPEAT_MASK >> 6) & 1u) ? 2 : 1); ++rep_) if (((PH_MASK >> 6) & 1) && IN(base + 5)) { FRESH_ARGS;
            SchedPlain S{(const bf16_t*)(ws + G_YN), (const bf16_t*)(ws + WS_WS), TG / 256, 4, 1024, nblk, bid};
            EpiBranchS E{(const bf16_t*)(ws + G_G), (const bf16_t*)(ws + G_P), (bf16_t*)(ws + G_U)};
            pg::gemm_phase(lds, 1024, S, E, tid);
            SEAM(base + 5);
        }
        _Pragma("unroll 1") for (int rep_ = 0; rep_ < (((REPEAT_MASK >> 7) & 1u) ? 2 : 1); ++rep_) if (((PH_MASK >> 7) & 1) && IN(base + 6)) { FRESH_ARGS;
            SchedPlain S{(const bf16_t*)(ws + G_U), (const bf16_t*)(ws + WS_WO), TG / 256, 4, 1024, nblk, bid};
            EpiF32 E{(float*)(ws + G_MIX), 1024};
            pg::gemm_phase(lds, 1024, S, E, tid);
            SEAM(base + 6);
        }
        _Pragma("unroll 1") for (int rep_ = 0; rep_ < (((REPEAT_MASK >> 8) & 1u) ? 2 : 1); ++rep_) if (((PH_MASK >> 8) & 1) && IN(base + 7)) { FRESH_ARGS; p8_post(a, grp, bid, nblk, tid); SEAM(base + 7); }
#pragma unroll 1
        for (int qi = 0; qi < NQ; ++qi) {
            const int qb = base + 8 + qi * 6;
            _Pragma("unroll 1") for (int rep_ = 0; rep_ < (((REPEAT_MASK >> 9) & 1u) ? 2 : 1); ++rep_) if (((PH_MASK >> 9) & 1) && IN(qb + 0)) { FRESH_ARGS;
                const bf16_t* H2q = (const bf16_t*)(ws + G_H2) + (size_t)qi * QT * 1024;
                SchedPlain S{H2q, (const bf16_t*)(ws + WS_W1) + (size_t)NEXP * 512 * 1024, QT / 256, 3, 1024, nblk, bid};
                EpiQ1 E{(bf16_t*)(ws + M_HID), (float*)(ws + M_LOG)};
                pg::gemm_phase(lds, 1024, S, E, tid);
                SEAM(qb + 0);
            }
            _Pragma("unroll 1") for (int rep_ = 0; rep_ < (((REPEAT_MASK >> 10) & 1u) ? 2 : 1); ++rep_) if (((PH_MASK >> 10) & 1) && IN(qb + 1)) { FRESH_ARGS; q2_route(a, lds, bid, nblk, tid); SEAM(qb + 1); }
            _Pragma("unroll 1") for (int rep_ = 0; rep_ < (((REPEAT_MASK >> 11) & 1u) ? 2 : 1); ++rep_) if (((PH_MASK >> 11) & 1) && IN(qb + 2)) { FRESH_ARGS; q3_scatter(a, lds, bid, nblk, tid); SEAM(qb + 2); }
            _Pragma("unroll 1") for (int rep_ = 0; rep_ < (((REPEAT_MASK >> 12) & 1u) ? 2 : 1); ++rep_) if (((PH_MASK >> 12) & 1) && IN(qb + 3)) { FRESH_ARGS;
                LAS int* offs = (LAS int*)(lds + EPI_OFF); moe_offsets(a, offs, tid);
                const bf16_t* H2q = (const bf16_t*)(ws + G_H2) + (size_t)qi * QT * 1024;
                SchedQ4 S{H2q, (const bf16_t*)(ws + WS_W1), (const int*)(ws + M_ROWL), offs, nblk, bid};
                EpiQ4 E{(bf16_t*)(ws + M_HID)};
                pg::gemm_phase(lds, 1024, S, E, tid);
                SEAM(qb + 3);
            }
            _Pragma("unroll 1") for (int rep_ = 0; rep_ < (((REPEAT_MASK >> 13) & 1u) ? 2 : 1); ++rep_) if (((PH_MASK >> 13) & 1) && IN(qb + 4)) { FRESH_ARGS;
                LAS int* offs = (LAS int*)(lds + EPI_OFF); moe_offsets(a, offs, tid);
                SchedQ5 S{(const bf16_t*)(ws + M_HID), (const bf16_t*)(ws + WS_W2), offs, nblk, bid};
                EpiQ5 E{(const int*)(ws + M_ROWL), (const float*)(ws + M_TOPW), (bf16_t*)(ws + M_AOUT), (bf16_t*)(ws + M_SOUT)};
                pg::gemm_phase(lds, 256, S, E, tid);
                SEAM(qb + 4);
            }
            _Pragma("unroll 1") for (int rep_ = 0; rep_ < (((REPEAT_MASK >> 14) & 1u) ? 2 : 1); ++rep_) if (((PH_MASK >> 14) & 1) && IN(qb + 5)) { FRESH_ARGS; q6_combine(a, grp, qi, bid, nblk, tid); SEAM(qb + 5); }
        }
    }
#undef IN
#undef SEAM
}

typedef void (*KernFn)(Args);
template <unsigned M> static KernFn kern() { return fwd<M>; }
static KernFn phase_kernel(int bit) {
    switch (bit) {
        case 0: return kern<1u << 0>(); case 1: return kern<1u << 1>(); case 2: return kern<1u << 2>(); case 3: return kern<1u << 3>(); case 4: return kern<1u << 4>();
        case 5: return kern<1u << 5>(); case 6: return kern<1u << 6>(); case 7: return kern<1u << 7>(); case 8: return kern<1u << 8>(); case 9: return kern<1u << 9>();
        case 10: return kern<1u << 10>(); case 11: return kern<1u << 11>(); case 12: return kern<1u << 12>(); case 13: return kern<1u << 13>(); default: return kern<1u << 14>();
    }
}
static int step_bit(int s) { if (s == 0) return 0; const int r = (s - 1) % STEPS_PER_GRP; return r < 8 ? 1 + r : 9 + (r - 8) % 6; }
extern "C" void kernel_launch(void* const* d_in, const int* in_sizes, int n_in, void* d_out, int out_size, void* d_ws, size_t ws_size, hipStream_t stream) {
    static int grid = 0;
    if (grid == 0) {
        if (n_in != 33 || ws_size < WS_NEED) { fprintf(stderr, "kernel_launch: need 33 inputs and %zu bytes of workspace (got %d, %zu)\n", (size_t)WS_NEED, n_in, ws_size); grid = -1; return; }
        int dev = 0, cus = 0;
        if (hipGetDevice(&dev) != hipSuccess || hipDeviceGetAttribute(&cus, hipDeviceAttributeMultiprocessorCount, dev) != hipSuccess) { grid = -1; return; }
#if N_LAUNCH_MODE == 1
        if (hipFuncSetAttribute((const void*)kern<0x7FFFu>(), hipFuncAttributeMaxDynamicSharedMemorySize, LDS_BYTES) != hipSuccess) { fprintf(stderr, "kernel_launch: hipFuncSetAttribute failed\n"); grid = -1; return; }
        int per_cu = 0;
        if (hipOccupancyMaxActiveBlocksPerMultiprocessor(&per_cu, (const void*)kern<0x7FFFu>(), NT, LDS_BYTES) != hipSuccess || per_cu < 1) fprintf(stderr, "kernel_launch: occupancy query reports %d\n", per_cu);
#else
        for (int b = 0; b < 15; ++b) if (hipFuncSetAttribute((const void*)phase_kernel(b), hipFuncAttributeMaxDynamicSharedMemorySize, LDS_BYTES) != hipSuccess) { fprintf(stderr, "kernel_launch: hipFuncSetAttribute failed\n"); grid = -1; return; }
#endif
        (void)hipGetLastError();
        grid = cus;
    }
    if (grid < 0) return;
    (void)in_sizes; (void)out_size;
    (void)hipMemsetAsync((char*)d_ws + WS_CTL, 0, CTL_BYTES, stream);
    Args a{};
    for (int i = 0; i < 33; ++i) a.in[i] = (const float*)d_in[i];
    a.out = (float*)d_out; a.ws = (unsigned char*)d_ws;
#if N_LAUNCH_MODE == 1
    a.ph_lo = 0; a.ph_hi = N_STEPS;
    hipLaunchKernelGGL(kern<0x7FFFu>(), dim3(grid), dim3(NT), LDS_BYTES, stream, a);
#else
    for (int s = 0; s < N_STEPS; ++s) { a.ph_lo = s; a.ph_hi = s + 1; hipLaunchKernelGGL(phase_kernel(step_bit(s)), dim3(grid), dim3(NT), LDS_BYTES, stream, a); }
#endif
}
```

```cpp
#include <hip/hip_runtime.h>
#include <stdint.h>
#include <stdio.h>

#ifndef REPEAT_MASK
#define REPEAT_N 2
#define REPEAT_MASK 0u
#endif
#ifndef N_LAUNCH_MODE
#define N_LAUNCH_MODE 1
#endif

#define LAS __attribute__((address_space(3)))
#define DI __device__ __forceinline__
typedef unsigned short bf16_t;
typedef short bf16x8 __attribute__((ext_vector_type(8)));
typedef float f32x4 __attribute__((ext_vector_type(4)));
typedef float f32x2 __attribute__((ext_vector_type(2)));
typedef float f32x16 __attribute__((ext_vector_type(16)));
typedef unsigned u32x4 __attribute__((ext_vector_type(4)));
typedef unsigned u32x2 __attribute__((ext_vector_type(2)));
typedef __bf16 bf16v2 __attribute__((ext_vector_type(2)));

DI unsigned pk_bf16(float lo, float hi) { f32x2 v = {lo, hi}; bf16v2 b = __builtin_convertvector(v, bf16v2); return __builtin_bit_cast(unsigned, b); }
DI bf16_t f2bf(float x) { return (bf16_t)(pk_bf16(x, 0.f) & 0xffffu); }
DI float bflo(unsigned u) { return __uint_as_float(u << 16); }
DI float bfhi(unsigned u) { return __uint_as_float(u & 0xffff0000u); }
DI float bf2f(bf16_t x) { return __uint_as_float(((unsigned)x) << 16); }
DI float sigmoidf_(float x) { return __builtin_amdgcn_rcpf(1.0f + __expf(-x)); }
DI float siluf_(float x) { return x * __builtin_amdgcn_rcpf(1.0f + __expf(-x)); }
DI int swap23(int i) { return (i & ~12) | ((i & 4) << 1) | ((i & 8) >> 1); }
DI int crow(int reg, int h) { return (reg & 3) + 8 * (reg >> 2) + 4 * h; }
#define MFMA32(a, b, c) __builtin_amdgcn_mfma_f32_32x32x16_bf16((a), (b), (c), 0, 0, 0)
DI bf16x8 pack_step(const f32x16& x, int s) {
    u32x4 p;
    p[0] = pk_bf16(x[8 * s + 0], x[8 * s + 1]); p[1] = pk_bf16(x[8 * s + 2], x[8 * s + 3]);
    p[2] = pk_bf16(x[8 * s + 4], x[8 * s + 5]); p[3] = pk_bf16(x[8 * s + 6], x[8 * s + 7]);
    return __builtin_bit_cast(bf16x8, p);
}
DI float shx(float v, int o, int lane) { return __int_as_float(__builtin_amdgcn_ds_bpermute((lane ^ o) << 2, __float_as_int(v))); }
DI int shxi(int v, int o, int lane) { return __builtin_amdgcn_ds_bpermute((lane ^ o) << 2, v); }
DI float shidx(float v, int src) { return __int_as_float(__builtin_amdgcn_ds_bpermute(src << 2, __float_as_int(v))); }
DI int lane_now() { int l; asm volatile("v_mbcnt_lo_u32_b32 %0, -1, 0\n\tv_mbcnt_hi_u32_b32 %0, -1, %0" : "=v"(l)); return l; }
DI float wave_sum(float v, int lane) {
#pragma unroll
    for (int o = 32; o >= 1; o >>= 1) v += shx(v, o, lane);
    return v;
}

constexpr int NB = 16, SEQ = 2048, DM = 1024, CTXL = 256, SALL = SEQ + CTXL;
constexpr int GB = 8;
constexpr int NGRP = NB / GB;
constexpr int TG = GB * SEQ;
constexpr int CG = GB * CTXL;
constexpr int HR = TG + CG;
constexpr int QT = TG;
constexpr int NQ = TG / QT;
constexpr int IN_COLS = 8224;
constexpr float EPS = 1e-6f;
constexpr float LAM_INIT = 0.2f;
constexpr float QSCALE = 0.125f * 1.4426950408889634f;
constexpr int NEXP = 64;
constexpr int MAXROWS = QT * 8 + NEXP * 256;

constexpr size_t AL(size_t x) { return (x + 255) & ~(size_t)255; }
constexpr size_t WS_CTL   = 0;
constexpr size_t CTL_BYTES = 16384;
constexpr size_t WS_MOD   = WS_CTL + CTL_BYTES;
constexpr size_t WS_ROPE  = WS_MOD + AL(17 * 6144 * 4);
constexpr size_t WS_WIN   = WS_ROPE + AL(2048 * 32 * 2 * 4);
constexpr size_t WS_WV    = WS_WIN + AL((size_t)4352 * 1024 * 2);
constexpr size_t WS_WZG   = WS_WV + AL((size_t)1024 * 1024 * 2);
constexpr size_t WS_WA    = WS_WZG + AL((size_t)3072 * 1024 * 2);
constexpr size_t WS_WS    = WS_WA + AL((size_t)1024 * 1024 * 2);
constexpr size_t WS_WO    = WS_WS + AL((size_t)1024 * 1024 * 2);
constexpr size_t WS_W1    = WS_WO + AL((size_t)1024 * 1024 * 2);
constexpr size_t WS_W2    = WS_W1 + AL(((size_t)65 * 512 + 256) * 1024 * 2);
constexpr size_t WS_GRP   = WS_W2 + AL((size_t)65 * 1024 * 256 * 2);
constexpr size_t G_H   = WS_GRP;
constexpr size_t G_Q   = G_H + AL((size_t)HR * 1024 * 2);
constexpr size_t G_K   = G_Q + AL((size_t)TG * 1024 * 2);
constexpr size_t G_VT  = G_K + AL((size_t)GB * SALL * 1024 * 2);
constexpr size_t G_XBC = G_VT + AL((size_t)GB * 1024 * SALL * 2);
constexpr size_t G_DT  = G_XBC + AL((size_t)GB * SALL * 2048 * 2);
constexpr size_t G_O   = G_DT + AL((size_t)GB * SALL * 32 * 4);
constexpr size_t G_YF  = G_O + AL((size_t)TG * 1024 * 2);
constexpr size_t G_YB  = G_YF + AL((size_t)TG * 1024 * 2);
constexpr size_t G_HALO = G_YB + AL((size_t)TG * 1024 * 2);
constexpr size_t G_END = G_HALO + AL((size_t)GB * 72 * 2 * 2048 * 2);
constexpr size_t G_YN  = G_Q;
constexpr size_t G_G   = G_XBC;
constexpr size_t G_P   = G_K;
constexpr size_t G_U   = G_VT;
constexpr size_t G_MIX = G_YF;
constexpr size_t G_H2  = G_O;
constexpr size_t G_X1  = G_YB;
constexpr size_t M_HID  = G_H;
constexpr size_t M_HIDS = M_HID + AL((size_t)NQ * MAXROWS * 256 * 2);
constexpr size_t M_OFFS = M_HIDS + AL((size_t)TG * 256 * 2);
constexpr size_t M_TILE = M_OFFS + AL((size_t)NQ * 128 * 4);
constexpr size_t M_ROWL = M_TILE + AL((size_t)NQ * 1024 * 4);
constexpr size_t M_ROWW = M_ROWL + AL((size_t)NQ * MAXROWS * 4);
constexpr size_t M_AOUT = M_ROWW + AL((size_t)NQ * MAXROWS * 4);
constexpr size_t M_SOUT = M_AOUT + AL((size_t)QT * 8 * 1024);
constexpr size_t M_ENDA = M_SOUT + AL((size_t)QT * 1024 * 2);
static_assert(M_AOUT <= G_O, "the tables that survive until Q5 must end before H2 / the routing scratch");
constexpr size_t M_LOG  = G_YF;
constexpr size_t M_TOPE = M_LOG + AL((size_t)TG * 64 * 4);
constexpr size_t M_TOPW = M_TOPE + AL((size_t)TG * 8 * 4);
constexpr size_t M_TPOS = M_TOPW + AL((size_t)TG * 8 * 4);
constexpr size_t M_BCNT = M_TPOS + AL((size_t)TG * 8 * 4);
constexpr size_t M_ENDB = M_BCNT + AL((size_t)NQ * 1024 * 64 * 4);
static_assert(M_ENDB <= G_END, "routing scratch must fit in the MIX region");
constexpr size_t G_O1 = G_END;
constexpr size_t WS_NEED = (G_O1 + AL((size_t)TG * 1024 * 2) > M_ENDA) ? G_O1 + AL((size_t)TG * 1024 * 2) : M_ENDA;
constexpr int CW_Q3 = 3584;
#ifndef PROBE_UNIT
#define PROBE_UNIT -1
#endif
#ifndef SSD_REPEAT
#define SSD_REPEAT 0
#endif

#define XB_TMO      128
#define XB_XCNT(j)  (256  + 64 * (j))
#define XB_XSUB(j)  (1280 + 64 * (j))
#define XB_XGEN(j)  (2304 + 64 * (j))
#define XB_TOP      3328
#define XB_TOPGEN   3392
#define XCD_BAR_WORDS 3456
#define XB_SPIN_CAP (1u << 18)
DI unsigned xb_ld(unsigned* p)              { return __hip_atomic_load(p, __ATOMIC_RELAXED, __HIP_MEMORY_SCOPE_AGENT); }
DI unsigned xb_add(unsigned* p, unsigned v) { return __hip_atomic_fetch_add(p, v, __ATOMIC_RELAXED, __HIP_MEMORY_SCOPE_AGENT); }
DI unsigned xb_xcc_id() { return (unsigned)__builtin_amdgcn_s_getreg((3 << 11) | 20) & 0xFu; }
#define XB_SPIN(cond, bar) do { unsigned _sp = 0; while (cond) { __builtin_amdgcn_s_sleep(1); \
    if ((++_sp & 255u) == 0u) { if (xb_ld(&(bar)[XB_TMO])) break; if (_sp > XB_SPIN_CAP) { atomicAdd(&(bar)[XB_TMO], 1u); break; } } } } while (0)
struct XcdBarrier { unsigned* bar; unsigned x; volatile LAS unsigned* st; };
DI XcdBarrier xcd_barrier_post(unsigned* bar, volatile LAS unsigned* st, int tid) {
    XcdBarrier b; b.bar = bar; b.x = xb_xcc_id(); b.st = st;
    if (tid == 0) (void)xb_add(&bar[XB_XCNT(b.x)], 1u);
    return b;
}
DI void xcd_barrier_complete(unsigned* bar, unsigned x, unsigned& nloc, unsigned& nx) {
    const unsigned G = gridDim.x * gridDim.y * gridDim.z;
    unsigned sum, cnt, mine, sp = 0u;
    for (;;) {
        sum = 0u; cnt = 0u; mine = 0u;
#pragma unroll 1
        for (unsigned j = 0; j < 16; ++j) { const unsigned c = xb_ld(&bar[XB_XCNT(j)]); sum += c; cnt += (c > 0u) ? 1u : 0u; mine = (j == x) ? c : mine; }
        if (sum == G) break;
        __builtin_amdgcn_s_sleep(1);
        if ((++sp & 255u) == 0u) { if (xb_ld(&bar[XB_TMO])) break; if (sp > XB_SPIN_CAP) { atomicAdd(&bar[XB_TMO], 1u); break; } }
    }
    nloc = mine > 0u ? mine : 1u; nx = cnt > 0u ? cnt : 1u;
}
DI void xcd_barrier(const XcdBarrier& b, int tid) {
    asm volatile("s_waitcnt vmcnt(0)" ::: "memory");
    __syncthreads();
    if (tid == 0) {
        unsigned* bar = b.bar;
        __builtin_amdgcn_s_waitcnt(0);
        unsigned nloc = b.st[0], nx = b.st[1];
        if (nloc == 0u) { xcd_barrier_complete(bar, b.x, nloc, nx); b.st[0] = nloc; b.st[1] = nx; }
        const unsigned old = xb_add(&bar[XB_XSUB(b.x)], 1u);
        const unsigned gen = old / nloc;
        if (old + 1u == (gen + 1u) * nloc) {
            __builtin_amdgcn_fence(__ATOMIC_RELEASE, "agent");
            asm volatile("s_waitcnt vmcnt(0)" ::: "memory");
            const unsigned og = xb_add(&bar[XB_TOP], 1u);
            const unsigned tg = og / nx;
            if (og + 1u == (tg + 1u) * nx) xb_add(&bar[XB_TOPGEN], 1u);
            else XB_SPIN(xb_ld(&bar[XB_TOPGEN]) == tg, bar);
            __builtin_amdgcn_fence(__ATOMIC_ACQUIRE, "agent");
            xb_add(&bar[XB_XGEN(b.x)], 1u);
            asm volatile("s_waitcnt vmcnt(0)" ::: "memory");
        } else {
            XB_SPIN(xb_ld(&bar[XB_XGEN(b.x)]) == gen, bar);
            __builtin_amdgcn_fence(__ATOMIC_ACQUIRE, "agent");
            asm volatile("s_waitcnt vmcnt(0)" ::: "memory");
        }
    }
    __syncthreads();
}

namespace pg {
constexpr int BM = 256, BK = 64, HALF = 128, HTB = HALF * BK * 2, STAGE_BYTES = 8 * HTB;
DI int lds_byte(int r, int c) { const int st = (r >> 4) * 2 + (c >> 5), rr = r & 15, cc = c & 31, ob = rr * 64 + cc * 2; return st * 1024 + (ob ^ (((ob >> 9) & 1) << 5)); }
DI void stage_rc(int b, int& R, int& C) { const int st = b / 1024, sb = b % 1024, swz = sb ^ (((sb >> 9) & 1) << 5); R = (st >> 1) * 16 + swz / 64; C = (st & 1) * 32 + (swz % 64) / 2; }
DI int perm32(int rho) { const int n = rho >> 4, i = rho & 15; return 8 * (i >> 2) + 4 * n + (i & 3); }
struct Unit { int pm, pn, kind, aux; };
DI void decode_tiles(int L, int nM, int nN, int& pm, int& pn) {
    const int nwg = nM * nN; int wgid = L;
    { const int q = nwg / 8, r = nwg % 8, xcd = wgid % 8, off = wgid / 8; wgid = (xcd < r ? xcd * (q + 1) : r * (q + 1) + (xcd - r) * q) + off; }
    const int nig = 8 * nN, gid = wgid / nig, fm = gid * 8, gsz = (nM - fm) < 8 ? (nM - fm) : 8;
    pm = fm + ((wgid % nig) % gsz); pn = (wgid % nig) / gsz;
}
template <class Epi, class Sched>
DI void gemm_phase(LAS unsigned char* lds, const int K, const Sched& S, const Epi& E, int tid_in) {
    constexpr bool GATHER = Sched::GATHER;
    int tid = tid_in; asm volatile("" : "+v"(tid));
    const int wid = __builtin_amdgcn_readfirstlane(tid >> 6), lane = tid & 63, wr = wid >> 2, wc = wid & 3, fr = lane & 15, fq = lane >> 4;
    const int nt = K / BK;
    unsigned voffA[2], voffB[2];
    int Rr[2], Cc[2];
#pragma unroll
    for (int i = 0; i < 2; ++i) { int R, C; stage_rc(tid * 16 + i * 8192, R, C); const int Rb = (R & ~31) + perm32(R & 31);
        Rr[i] = R; Cc[i] = C; voffA[i] = (unsigned)(R * K + C) * 2u; voffB[i] = (unsigned)(Rb * K + C) * 2u; }
    const size_t kstep = (size_t)(BK * 2);
    const size_t hstep = (size_t)HALF * K * 2;
    const unsigned ldsw = (unsigned)wid * 1024u;
    const int aoff = lds_byte(wr * 64 + fr, fq * 8), boff = lds_byte(wc * 32 + fr, fq * 8);
#define PG_SA(b, h) (((b) * 2 + (h)) * HTB)
#define PG_SB(b, h) ((4 + (b) * 2 + (h)) * HTB)
#define PG_STAGE(bufoff, gbase, voff) do { _Pragma("unroll") for (int _i = 0; _i < 2; ++_i) \
        __builtin_amdgcn_global_load_lds((const unsigned*)((const char*)(gbase) + (voff)[_i]), (LAS unsigned*)(lds + (bufoff) + ldsw + _i * 8192), 16, 0, 0); } while (0)
#define PG_STAGE_A(bufoff, gb, kofs, h, o0, o1) do { if constexpr (GATHER) { if ((h) == 0) PG_STAGE(bufoff, (gb) + (kofs), o0); else PG_STAGE(bufoff, (gb) + (kofs), o1); } \
        else { PG_STAGE(bufoff, (gb) + (kofs) + (h) * hstep, voffA); } } while (0)
#define PG_LDA(dst, b, h) do { _Pragma("unroll") for (int m = 0; m < 4; ++m) _Pragma("unroll") for (int k = 0; k < 2; ++k) dst[m][k] = *(const LAS bf16x8*)(lds + PG_SA(b, h) + aoff + m * 2048 + k * 1024); } while (0)
#define PG_LDB(dst, b, h) do { _Pragma("unroll") for (int n = 0; n < 2; ++n) _Pragma("unroll") for (int k = 0; k < 2; ++k) dst[n][k] = *(const LAS bf16x8*)(lds + PG_SB(b, h) + boff + n * 2048 + k * 1024); } while (0)
#define PG_MMA(ai, bj, At, Bt) do { __builtin_amdgcn_s_setprio(1); _Pragma("unroll") for (int m = 0; m < 4; ++m) _Pragma("unroll") for (int n = 0; n < 2; ++n) _Pragma("unroll") for (int k = 0; k < 2; ++k) \
        acc[ai][bj][m][n] = __builtin_amdgcn_mfma_f32_16x16x32_bf16(Bt[n][k], At[m][k], acc[ai][bj][m][n], 0, 0, 0); __builtin_amdgcn_s_setprio(0); } while (0)
#define PG_WAIT_V(n) asm volatile("s_waitcnt vmcnt(" #n ")" ::: "memory")
#define PG_WAIT_L(n) asm volatile("s_waitcnt lgkmcnt(" #n ")" ::: "memory")
#define PG_BAR __builtin_amdgcn_s_barrier()
#define PG_SCHED __builtin_amdgcn_sched_barrier(0)
#define PG_AOFFS(u, o0, o1) do { if constexpr (GATHER) { _Pragma("unroll") for (int _i = 0; _i < 2; ++_i) { \
        o0[_i] = (unsigned)(S.a_row(u, Rr[_i]) * K + Cc[_i]) * 2u; o1[_i] = (unsigned)(S.a_row(u, HALF + Rr[_i]) * K + Cc[_i]) * 2u; } } } while (0)
    Unit cur, nxt; int ui = 0;
    if (!S.next(0, cur)) return;
    f32x4 acc[2][2][4][2];
#pragma unroll
    for (int a = 0; a < 2; ++a)
#pragma unroll
        for (int b = 0; b < 2; ++b)
#pragma unroll
            for (int m = 0; m < 4; ++m)
#pragma unroll
                for (int n = 0; n < 2; ++n) acc[a][b][m][n] = (f32x4){0.f, 0.f, 0.f, 0.f};
    bf16x8 At[4][2], B0[2][2], B1[2][2];
    unsigned cA0[2] = {0u, 0u}, cA1[2] = {0u, 0u}, nA0[2] = {0u, 0u}, nA1[2] = {0u, 0u};
    const char* cA = S.a_tile(cur); const char* cB = S.b_base(cur);
    PG_AOFFS(cur, cA0, cA1);
    if constexpr (Sched::AUX) S.aux(cur, lds, wid, lane);
    PG_STAGE(PG_SB(0, 0), cB, voffB); PG_STAGE(PG_SB(0, 1), cB + hstep, voffB); PG_STAGE_A(PG_SA(0, 0), cA, 0, 0, cA0, cA1); PG_STAGE_A(PG_SA(0, 1), cA, 0, 1, cA0, cA1);
    if (wr == 1) PG_BAR;
    PG_WAIT_V(2); PG_BAR;
    PG_STAGE(PG_SB(1, 0), cB + kstep, voffB); PG_STAGE_A(PG_SA(1, 0), cA, kstep, 0, cA0, cA1); PG_STAGE(PG_SB(1, 1), cB + hstep + kstep, voffB);
    PG_WAIT_V(6); PG_BAR;
    for (;;) {
        const bool has_next = S.next(ui + 1, nxt);
        const char* nA = cA; const char* nB = cB;
        if (has_next) { nA = S.a_tile(nxt); nB = S.b_base(nxt); PG_AOFFS(nxt, nA0, nA1); if constexpr (Sched::AUX) S.aux(nxt, lds, wid, lane); }
        else if constexpr (GATHER) { nA0[0] = cA0[0]; nA0[1] = cA0[1]; nA1[0] = cA1[0]; nA1[1] = cA1[1]; }
        for (int t = 0; t < nt; t += 2) {
            const bool last = (t == nt - 2);
            const char* a1 = cA + (size_t)(t + 1) * kstep;
            const char* a2 = last ? nA : cA + (size_t)(t + 2) * kstep; const char* b2 = last ? nB : cB + (size_t)(t + 2) * kstep;
            const char* b3 = b2 + kstep;
            unsigned s0[2] = {0u, 0u}, s1[2] = {0u, 0u};
            if constexpr (GATHER) { s0[0] = last ? nA0[0] : cA0[0]; s0[1] = last ? nA0[1] : cA0[1]; s1[0] = last ? nA1[0] : cA1[0]; s1[1] = last ? nA1[1] : cA1[1]; }
            PG_LDB(B0, 0, 0); PG_LDB(B1, 0, 1); PG_SCHED; PG_LDA(At, 0, 0); PG_STAGE_A(PG_SA(1, 1), a1, 0, 1, cA0, cA1);
            PG_WAIT_V(8); PG_WAIT_L(0); PG_BAR; PG_MMA(0, 0, At, B0); PG_MMA(0, 1, At, B1); PG_BAR; PG_SCHED;
            PG_LDA(At, 0, 1); PG_STAGE(PG_SB(0, 0), b2, voffB); PG_STAGE(PG_SB(0, 1), b2 + hstep, voffB); PG_STAGE_A(PG_SA(0, 0), a2, 0, 0, s0, s1);
            PG_WAIT_V(8); PG_WAIT_L(0); PG_BAR; PG_MMA(1, 0, At, B0); PG_MMA(1, 1, At, B1); PG_BAR; PG_SCHED;
            PG_LDB(B0, 1, 0); PG_LDB(B1, 1, 1); PG_SCHED; PG_LDA(At, 1, 0); PG_STAGE_A(PG_SA(0, 1), a2, 0, 1, s0, s1);
            PG_WAIT_V(8); PG_WAIT_L(0); PG_BAR; PG_MMA(0, 0, At, B0); PG_MMA(0, 1, At, B1); PG_BAR; PG_SCHED;
            PG_LDA(At, 1, 1); PG_STAGE(PG_SB(1, 0), b3, voffB); PG_STAGE(PG_SB(1, 1), b3 + hstep, voffB); PG_STAGE_A(PG_SA(1, 0), a2, kstep, 0, s0, s1);
            PG_WAIT_V(8); PG_WAIT_L(0); PG_BAR; PG_MMA(1, 0, At, B0); PG_MMA(1, 1, At, B1); PG_BAR; PG_SCHED;
        }
        if (wr == 0) PG_BAR;
        { const int ln_ = lane_now(); const int fr_ = ln_ & 15, fq_ = ln_ >> 4;
          E(acc, cur, wr, wc, fr_, fq_, ln_); }
        if (!has_next) break;
#pragma unroll
        for (int a = 0; a < 2; ++a)
#pragma unroll
            for (int b = 0; b < 2; ++b)
#pragma unroll
                for (int m = 0; m < 4; ++m)
#pragma unroll
                    for (int n = 0; n < 2; ++n) acc[a][b][m][n] = (f32x4){0.f, 0.f, 0.f, 0.f};
        cur = nxt; cA = nA; cB = nB; ++ui;
        if constexpr (GATHER) { cA0[0] = nA0[0]; cA0[1] = nA0[1]; cA1[0] = nA1[0]; cA1[1] = nA1[1]; }
        if (wr == 1) PG_BAR;
    }
    PG_WAIT_V(0);
    PG_BAR;
#undef PG_SA
#undef PG_SB
#undef PG_STAGE
#undef PG_STAGE_A
#undef PG_LDA
#undef PG_LDB
#undef PG_MMA
#undef PG_WAIT_V
#undef PG_WAIT_L
#undef PG_BAR
#undef PG_SCHED
#undef PG_AOFFS
}
template <int FE = 8, class F> DI void for_each8(const f32x4 (&acc)[2][2][4][2], int wr, int wc, int fr, int fq, F&& f) {
#pragma unroll
    for (int ai = 0; ai < 2; ++ai)
#pragma unroll
        for (int m = 0; m < 4; ++m)
#pragma unroll
            for (int bj = 0; bj < 2; ++bj) { f(ai * HALF + wr * 64 + m * 16 + fr, bj * HALF + wc * 32 + 8 * fq, acc[ai][bj][m][0], acc[ai][bj][m][1]); if (((ai * 8 + m * 2 + bj) % FE) == FE - 1) asm volatile("" ::: "memory"); }
}
DI u32x4 pack8(const f32x4& a, const f32x4& b) { u32x4 w; w.x = pk_bf16(a[0], a[1]); w.y = pk_bf16(a[2], a[3]); w.z = pk_bf16(b[0], b[1]); w.w = pk_bf16(b[2], b[3]); return w; }
}

struct Args { const float* in[33]; float* out; unsigned char* ws; int ph_lo, ph_hi; };
typedef const Args __attribute__((address_space(4))) KArgs;
#define KA KArgs&
enum { I_X = 0, I_C, I_CTX, I_CCTX, I_WADA, I_BADA, I_GPRE1, I_GPOST1, I_GPRE2, I_GPOST2, I_WIN, I_LQ1, I_LK1, I_LQ2, I_LK2, I_GSUB, I_CONVW, I_CONVB, I_DTB, I_ALOG,
       I_DSKIP, I_GSSD, I_WBA, I_WBS, I_WOUT, I_WR, I_RB, I_WEG, I_WEU, I_WED, I_WSG, I_WSU, I_WSD };
constexpr int NT = 512;
constexpr int RING_BYTES = pg::STAGE_BYTES;
constexpr int EPI_OFF = RING_BYTES;
constexpr int YT_OFF = EPI_OFF + 9216;
constexpr int MISC_OFF = YT_OFF + 16384;
constexpr int LDS_BYTES = MISC_OFF + 256;

struct CvtSeg { int in_idx, ld, col0, ncols, nvalid, K, mode, rowoff, nbatch; size_t dst_off, sstride, dstride; };
constexpr int cvt_items(const CvtSeg& g) { return (g.ncols / 256) * (g.K / 64) * g.nbatch; }
constexpr int N_CVT = 20;
__device__ constexpr CvtSeg kCvt[N_CVT] = {
    {I_WEG, 256, 0, 256, 256, 1024, 2, 0,   NEXP, WS_W1, (size_t)1024 * 256, (size_t)512 * 1024},
    {I_WEU, 256, 0, 256, 256, 1024, 2, 128, NEXP, WS_W1, (size_t)1024 * 256, (size_t)512 * 1024},
    {I_WED, 1024, 0, 1024, 1024, 256, 0, 0, NEXP, WS_W2, (size_t)256 * 1024, (size_t)1024 * 256},
    {I_WIN, IN_COLS, 0,    1024, 1024, 1024, 1, 0,    1, WS_WIN, 0, 0},
    {I_WIN, IN_COLS, 1024, 1024, 1024, 1024, 1, 1024, 1, WS_WIN, 0, 0},
    {I_WIN, IN_COLS, 4096, 2048, 2048, 1024, 0, 2048, 1, WS_WIN, 0, 0},
    {I_WIN, IN_COLS, 6144, 256,  32,   1024, 0, 4096, 1, WS_WIN, 0, 0},
    {I_WIN, IN_COLS, 2048, 1024, 1024, 1024, 0, 0,    1, WS_WV, 0, 0},
    {I_WIN, IN_COLS, 3072, 1024, 1024, 1024, 0, 0,    1, WS_WZG, 0, 0},
    {I_WIN, IN_COLS, 6176, 2048, 2048, 1024, 0, 1024, 1, WS_WZG, 0, 0},
    {I_WBA,  1024, 0, 1024, 1024, 1024, 0, 0, 1, WS_WA, 0, 0},
    {I_WBS,  1024, 0, 1024, 1024, 1024, 0, 0, 1, WS_WS, 0, 0},
    {I_WOUT, 1024, 0, 1024, 1024, 1024, 0, 0, 1, WS_WO, 0, 0},
    {I_WSG, 256, 0, 256, 256, 1024, 2, 0,   1, WS_W1 + (size_t)NEXP * 512 * 1024 * 2, 0, 0},
    {I_WSU, 256, 0, 256, 256, 1024, 2, 128, 1, WS_W1 + (size_t)NEXP * 512 * 1024 * 2, 0, 0},
    {I_WSD, 1024, 0, 1024, 1024, 256, 0, 0, 1, WS_W2 + (size_t)NEXP * 1024 * 256 * 2, 0, 0},
    {I_WR, 64, 0, 256, 64, 1024, 0, 0, 1, WS_W1 + (size_t)65 * 512 * 1024 * 2, 0, 0},
    {0, 0, 0, 0, 0, 256, 0, 0, 0, 0, 0, 0}, {0, 0, 0, 0, 0, 256, 0, 0, 0, 0, 0, 0}, {0, 0, 0, 0, 0, 256, 0, 0, 0, 0, 0, 0}
};
constexpr int cvt_total() { int t = 0; for (int i = 0; i < N_CVT; ++i) t += cvt_items(kCvt[i]); return t; }
constexpr int CVT_EXPERT_ITEMS = 3 * NEXP * 16;
constexpr int CVT_ENTRY = 8, CVT_ENTRIES = CVT_EXPERT_ITEMS / CVT_ENTRY;
DI void cvt_all(KA a, int gfirst, int gend, int bid, int nblk, int tid_in, LAS unsigned char* lds) {
    int tid_ = tid_in; asm volatile("" : "+v"(tid_)); const int tid = tid_, jl = tid & 63, kg = tid >> 6;
    const int nitems = gend;
    auto locate = [&](int g, int& sg, int& bt, int& jb, int& kb) {
        sg = 0; int base = 0;
#pragma unroll 1
        for (int i = 0; i < N_CVT; ++i) { const int n = (kCvt[i].ncols / 256) * (kCvt[i].K / 64) * kCvt[i].nbatch; if (g >= base + n) { base += n; sg = i + 1; } else break; }
        const int it = g - base, njb = kCvt[sg].ncols / 256, nper = njb * (kCvt[sg].K / 64);
        bt = it / nper; const int r = it % nper; jb = r % njb; kb = r / njb;
    };
    f32x4 v[8];
    auto load_item = [&](int g) {
        int sg, bt, jb, kb; locate(g, sg, bt, jb, kb);
        const float* src = a.in[kCvt[sg].in_idx] + (size_t)bt * kCvt[sg].sstride;
        const int j = jb * 256 + jl * 4, k0 = kb * 64 + kg * 8, ld = kCvt[sg].ld, col0 = kCvt[sg].col0;
        const bool ok = j < kCvt[sg].nvalid;
#pragma unroll
        for (int i = 0; i < 8; ++i) v[i] = ok ? __builtin_nontemporal_load((const f32x4*)(src + (size_t)(k0 + i) * ld + col0 + j)) : (f32x4){0.f, 0.f, 0.f, 0.f};
    };
    if (gfirst + bid < nitems) load_item(gfirst + bid);
    for (int g = gfirst + bid; g < nitems; g += nblk) {
        int sg, bt, jb, kb; locate(g, sg, bt, jb, kb);
        bf16_t* dst = (bf16_t*)(a.ws + kCvt[sg].dst_off) + (size_t)bt * kCvt[sg].dstride;
        const int K = kCvt[sg].K, mode = kCvt[sg].mode, rowoff = kCvt[sg].rowoff;
        u32x4 w[4];
#pragma unroll
        for (int c = 0; c < 4; ++c) { w[c].x = pk_bf16(v[0][c], v[1][c]); w[c].y = pk_bf16(v[2][c], v[3][c]); w[c].z = pk_bf16(v[4][c], v[5][c]); w[c].w = pk_bf16(v[6][c], v[7][c]); }
        if (g + nblk < nitems) load_item(g + nblk);
        __syncthreads();
#pragma unroll
        for (int c = 0; c < 4; ++c) *(LAS u32x4*)(lds + (jl * 4 + c) * 144 + kg * 16) = w[c];
        __syncthreads();
#pragma unroll
        for (int q = 0; q < 4; ++q) {
            const int idx = q * NT + tid, r = idx >> 3, ch = idx & 7, jj = jb * 256 + r;
            int row = jj;
            if (mode == 1) { const int blk = jj >> 6, d = jj & 63; row = blk * 64 + 2 * (d & 31) + (d >> 5); }
            else if (mode == 2) { row = (jj >> 7) * 256 + (jj & 127); }
            *(u32x4*)(dst + (size_t)(rowoff + row) * K + kb * 64 + ch * 8) = *(const LAS u32x4*)(lds + r * 144 + ch * 16);
        }
    }
    __syncthreads();
}
DI void p0_prologue(KA a, LAS unsigned char* lds, int bid, int nblk, int tid_in) {
    unsigned char* ws = a.ws;
    int tid_ = tid_in; asm volatile("" : "+v"(tid_)); const int tid = tid_;
    cvt_all(a, CVT_EXPERT_ITEMS, cvt_total(), bid, nblk, tid, lds);
    {
        float* rope = (float*)(ws + WS_ROPE);
        for (int idx = bid * NT + tid; idx < 2048 * 32; idx += nblk * NT) {
            const int n = idx >> 5, i = idx & 31, m = i & 15;
            const float inv = powf(10000.0f, -(float)(2 * m) / 32.0f);
            const float ang = (float)(i < 16 ? (n >> 6) : (n & 63)) * inv;
            float s, c; sincosf(ang, &s, &c);
            rope[idx * 2] = c; rope[idx * 2 + 1] = s;
        }
    }
    {
        LAS float* sc = (LAS float*)lds;
        LAS float* red = (LAS float*)(lds + 17 * 1024 * 4);
        float* MOD = (float*)(ws + WS_MOD);
        const float* w_ada = a.in[I_WADA];
        bool filled = false;
        for (int it = bid; it < 6144 / 32; it += nblk) {
            if (!filled) {
                for (int idx = tid; idx < 17 * 1024; idx += NT) { const int r = idx >> 10, k = idx & 1023; const float c = (r < 16) ? a.in[I_C][r * 1024 + k] : a.in[I_CCTX][k]; sc[idx] = siluf_(c); }
                filled = true;
            }
            __syncthreads();
            const int jl = tid & 31, kg = tid >> 5, j = it * 32 + jl;
            float acc[17];
#pragma unroll
            for (int r = 0; r < 17; ++r) acc[r] = 0.f;
#pragma unroll 8
            for (int k = kg * 64; k < kg * 64 + 64; ++k) {
                const float w = w_ada[(size_t)k * 6144 + j];
#pragma unroll
                for (int r = 0; r < 17; ++r) acc[r] += sc[r * 1024 + k] * w;
            }
#pragma unroll
            for (int r = 0; r < 17; ++r) red[(kg * 32 + jl) * 17 + r] = acc[r];
            __syncthreads();
            for (int idx = tid; idx < 32 * 17; idx += NT) {
                const int jj = idx / 17, r = idx % 17; float sum = 0.f;
#pragma unroll
                for (int g = 0; g < 16; ++g) sum += red[(g * 32 + jj) * 17 + r];
                MOD[r * 6144 + it * 32 + jj] = sum + a.in[I_BADA][it * 32 + jj];
            }
            __syncthreads();
        }
    }
}

DI void p1_norm(KA a, int grp, int bid, int nblk, int tid_in) {
    int tid_ = tid_in; asm volatile("" : "+v"(tid_)); const int tid = tid_, wid = tid >> 6, lane = tid & 63;
    bf16_t* H = (bf16_t*)(a.ws + G_H);
    const float* MOD = (const float*)(a.ws + WS_MOD);
    const float* g = a.in[I_GPRE1];
    const int stride = nblk * 8;
    for (int row0 = bid * 8 + wid; row0 < HR; row0 += 3 * stride) {
        f32x4 v[3][4]; int mrow[3];
#pragma unroll
        for (int j = 0; j < 3; ++j) {
            const int row = row0 + j * stride; const float* src = a.in[I_X]; mrow[j] = 0;
            if (row < TG) { const int grow = grp * TG + row; src = a.in[I_X] + (size_t)grow * 1024; mrow[j] = grow >> 11; }
            else if (row < HR) { const int crow_ = grp * CG + (row - TG); src = a.in[I_CTX] + (size_t)crow_ * 1024; mrow[j] = 16; }
#pragma unroll
            for (int i = 0; i < 4; ++i) v[j][i] = __builtin_nontemporal_load((const f32x4*)(src + i * 256 + lane * 4));
        }
#pragma unroll
        for (int j = 0; j < 3; ++j) {
            const int row = row0 + j * stride;
            if (row >= HR) break;
            float ss = 0.f;
#pragma unroll
            for (int i = 0; i < 4; ++i) ss += v[j][i][0] * v[j][i][0] + v[j][i][1] * v[j][i][1] + v[j][i][2] * v[j][i][2] + v[j][i][3] * v[j][i][3];
            ss = wave_sum(ss, lane);
            const float rs = rsqrtf(ss * (1.0f / 1024.0f) + EPS);
            const float* sh = MOD + mrow[j] * 6144; const float* scl = sh + 1024;
#pragma unroll
            for (int i = 0; i < 4; ++i) {
                const int c = i * 256 + lane * 4;
                const f32x4 gg = *(const f32x4*)(g + c), s1 = *(const f32x4*)(sh + c), s2 = *(const f32x4*)(scl + c);
                f32x4 y = v[j][i] * rs * gg * (s2 + 1.0f) + s1;
                u32x2 w; w.x = pk_bf16(y[0], y[1]); w.y = pk_bf16(y[2], y[3]);
                *(u32x2*)(H + (size_t)row * 1024 + c) = w;
            }
        }
    }
}

struct SchedInproj {
    const bf16_t* H; const bf16_t* WIN; const bf16_t* WV; int G, c;
    static constexpr int NL = 64 * 17, NA = NL + 8 * 13, NTOT = NA + 4 * 72;
    DI bool next(int i, pg::Unit& u) const {
        const int L = i * G + c; if (L >= NTOT) return false;
        if (L < NL) { pg::decode_tiles(L, 64, 17, u.pm, u.pn); u.kind = 0; }
        else if (L < NA) { pg::decode_tiles(L - NL, 8, 13, u.pm, u.pn); u.pm += 64; u.pn += 4; u.kind = 0; }
        else { const int j = L - NA; u.pm = j & 3; u.pn = j >> 2; u.kind = 1; }
        u.aux = 0; return true;
    }
    static constexpr bool GATHER = false; static constexpr bool AUX = false;
    DI const char* a_tile(const pg::Unit& u) const { return (const char*)((u.kind == 0 ? H : WV) + (size_t)u.pm * 256 * 1024); }
    DI int a_row(const pg::Unit&, int) const { return 0; }
    DI const char* b_base(const pg::Unit& u) const { return (const char*)((u.kind == 0 ? WIN : H) + (size_t)u.pn * 256 * 1024); }
};
struct EpiInproj {
    bf16_t* Q; bf16_t* Kb; bf16_t* VT; bf16_t* XBC; float* DT; const float* rope; const float* dtb; bf16_t* HALO;
    DI void operator()(const f32x4 (&acc)[2][2][4][2], const pg::Unit& u, int wr, int wc, int fr, int fq, int lane) const {
        const int rl = wr * 64 + fr, cl = wc * 32 + 8 * fq;
        if (u.kind == 1) {
            const int b = (u.pn < 64) ? (u.pn >> 3) : (u.pn - 64), pos0 = (u.pn < 64) ? (CTXL + (u.pn & 7) * 256) : 0;
            bf16_t* base = VT + ((size_t)b * 1024 + u.pm * 256 + rl) * SALL + pos0 + cl;
#pragma unroll
            for (int ai = 0; ai < 2; ++ai)
#pragma unroll
                for (int m = 0; m < 4; ++m)
#pragma unroll
                    for (int bj = 0; bj < 2; ++bj) *(u32x4*)(base + (size_t)(ai * 128 + m * 16) * SALL + bj * 128) = pg::pack8(acc[ai][bj][m][0], acc[ai][bj][m][1]);
            return;
        }
        const bool isctx = u.pm >= 64;
        const int b = isctx ? (u.pm - 64) : (u.pm >> 3), pos0 = isctx ? 0 : (CTXL + (u.pm & 7) * 256);
        const size_t drow0 = (size_t)b * SALL + pos0 + rl;
        if (u.pn < 8) {
            if (isctx && u.pn < 4) return;
            const bool isq = u.pn < 4;
            const long qk = (const char*)Kb - (const char*)Q;
            bf16_t* base = (bf16_t*)((char*)Q + (isq ? 0L : qk)) + (isq ? ((size_t)u.pm * 256 + rl) : drow0) * 1024 + (u.pn & 3) * 256 + cl;
            if (isctx) {
#pragma unroll
                for (int ai = 0; ai < 2; ++ai)
#pragma unroll
                    for (int m = 0; m < 4; ++m)
#pragma unroll
                        for (int bj = 0; bj < 2; ++bj) *(u32x4*)(base + (size_t)(ai * 128 + m * 16) * 1024 + bj * 128) = pg::pack8(acc[ai][bj][m][0], acc[ai][bj][m][1]);
                return;
            }
            const float* rp = rope + ((size_t)((u.pm & 7) * 256 + rl) * 32 + ((cl & 63) >> 1)) * 2;
            const float qs = isq ? QSCALE : 1.0f;
#pragma unroll
            for (int ai = 0; ai < 2; ++ai) {
                f32x4 cs0[4], cs1[4];
#pragma unroll
                for (int m = 0; m < 4; ++m) { cs0[m] = *(const f32x4*)(rp + (ai * 128 + m * 16) * 64) * qs; cs1[m] = *(const f32x4*)(rp + (ai * 128 + m * 16) * 64 + 4) * qs; }
#pragma unroll
                for (int m = 0; m < 4; ++m)
#pragma unroll
                    for (int bj = 0; bj < 2; ++bj) {
                        const f32x4 v0 = acc[ai][bj][m][0], v1 = acc[ai][bj][m][1]; f32x4 o0, o1;
                        o0[0] = v0[0] * cs0[m][0] - v0[1] * cs0[m][1]; o0[1] = v0[1] * cs0[m][0] + v0[0] * cs0[m][1];
                        o0[2] = v0[2] * cs0[m][2] - v0[3] * cs0[m][3]; o0[3] = v0[3] * cs0[m][2] + v0[2] * cs0[m][3];
                        o1[0] = v1[0] * cs1[m][0] - v1[1] * cs1[m][1]; o1[1] = v1[1] * cs1[m][0] + v1[0] * cs1[m][1];
                        o1[2] = v1[2] * cs1[m][2] - v1[3] * cs1[m][3]; o1[3] = v1[3] * cs1[m][2] + v1[2] * cs1[m][3];
                        *(u32x4*)(base + (size_t)(ai * 128 + m * 16) * 1024 + bj * 128) = pg::pack8(o0, o1);
                    }
                asm volatile("" ::: "memory");
            }
            return;
        }
        if (u.pn < 16) {
            bf16_t* base = XBC + drow0 * 2048 + (u.pn - 8) * 256 + cl;
            bf16_t* hb = HALO + (((size_t)b * 72 + (pos0 >> 5) + wr * 2) * 2) * 2048 + (u.pn - 8) * 256 + cl;
#pragma unroll
            for (int ai = 0; ai < 2; ++ai)
#pragma unroll
                for (int m = 0; m < 4; ++m)
#pragma unroll
                    for (int bj = 0; bj < 2; ++bj) {
                        const u32x4 w = pg::pack8(acc[ai][bj][m][0], acc[ai][bj][m][1]);
                        *(u32x4*)(base + (size_t)(ai * 128 + m * 16) * 2048 + bj * 128) = w;
                        if ((m & 1) == 0) { if (fr == 0) *(u32x4*)(hb + (size_t)((ai * 4 + (m >> 1)) * 2 + 0) * 2048 + bj * 128) = w; }
                        else { if (fr == 15) *(u32x4*)(hb + (size_t)((ai * 4 + (m >> 1)) * 2 + 1) * 2048 + bj * 128) = w; }
                    }
            return;
        }
        if (wc != 0) return;
        float* base = DT + drow0 * 32 + cl;
        const f32x4 db0 = *(const f32x4*)(dtb + cl), db1 = *(const f32x4*)(dtb + cl + 4);
#pragma unroll
        for (int ai = 0; ai < 2; ++ai)
#pragma unroll
            for (int m = 0; m < 4; ++m) {
                f32x4 o0, o1;
#pragma unroll
                for (int i = 0; i < 4; ++i) {
                    const float x0 = acc[ai][0][m][0][i] + db0[i], x1 = acc[ai][0][m][1][i] + db1[i];
                    const float e0 = __expf(-fabsf(x0)), e1 = __expf(-fabsf(x1));
                    o0[i] = fmaxf(x0, 0.f) + (e0 < 0.004f ? e0 * (1.0f - 0.5f * e0) : __logf(1.0f + e0));
                    o1[i] = fmaxf(x1, 0.f) + (e1 < 0.004f ? e1 * (1.0f - 0.5f * e1) : __logf(1.0f + e1));
                }
                *(f32x4*)(base + (size_t)(ai * 128 + m * 16) * 32) = o0; *(f32x4*)(base + (size_t)(ai * 128 + m * 16) * 32 + 4) = o1;
            }
        (void)lane;
    }
};

constexpr int AT_K = 0, AT_V = 32768, AT_KB = 16384, AT_VB = 32768;
DI void attn_unit(KA a, LAS unsigned char* lds, int grp, int b, int head, int qb, int c, int tid_in) {
    int tid = tid_in; asm volatile("" : "+v"(tid));
    const int wid = __builtin_amdgcn_readfirstlane(tid >> 6), lane = tid & 63, l31 = lane & 31, hh = lane >> 5;
    const unsigned qoff = (unsigned)((b * SEQ + qb * 256 + wid * 32 + l31) * 1024 + head * 128);
#define Qg ((const bf16_t*)(a.ws + G_Q) + qoff)
#define Og ((bf16_t*)(a.ws + (c == 0 ? G_O : G_O1)) + qoff)
    const bf16_t* Kg = (const bf16_t*)(a.ws + G_K) + (size_t)b * SALL * 1024 + head * 128;
    const bf16_t* Vg = (const bf16_t*)(a.ws + G_VT) + ((size_t)b * 1024 + head * 128) * SALL;
    const int kr0 = swap23(l31);
    {
        bf16x8 qf[4];
#pragma unroll
        for (int s = 0; s < 4; ++s) qf[s] = *(const bf16x8*)(Qg + c * 64 + 16 * s + 8 * hh);
        f32x16 O[4];
#pragma unroll
        for (int d = 0; d < 4; ++d)
#pragma unroll
            for (int r = 0; r < 16; ++r) O[d][r] = 0.f;
        float mrun = 0.f, lrun = 0.f;
        f32x16 NM;
#pragma unroll
        for (int r = 0; r < 16; ++r) NM[r] = 0.f;
        auto dma_stage = [&](int st, int k) {
            const int key0 = st * 128;
            int lane_ = lane; asm volatile("" : "+v"(lane_));
#pragma unroll
            for (int q6 = 0; q6 < 6; ++q6) {
                const int q = wid * 6 + q6;
                if (q < 16) {
                    const int row = 8 * q + (lane_ >> 3), ch = (lane_ & 7) ^ ((row >> 1) & 7);
                    __builtin_amdgcn_global_load_lds((const unsigned*)(Kg + (size_t)(key0 + row) * 1024 + c * 64 + ch * 8), (LAS unsigned*)(lds + AT_K + k * AT_KB + q * 1024), 16, 0, 0);
                } else {
                    const int d = 4 * (q - 16) + (lane_ >> 4), ch = (lane_ & 15) ^ (d & 15);
                    __builtin_amdgcn_global_load_lds((const unsigned*)(Vg + (size_t)d * SALL + key0 + ch * 8), (LAS unsigned*)(lds + AT_V + k * AT_VB + (q - 16) * 1024), 16, 0, 0);
                }
            }
        };
        __syncthreads();
        dma_stage(0, 0);
        __syncthreads();
#pragma unroll 1
        for (int st = 0; st < SALL / 128; ++st) {
            const int k = st & 1;
            if (st + 1 < SALL / 128) dma_stage(st + 1, k ^ 1);
            const LAS unsigned char* Kb = lds + AT_K + k * AT_KB; const LAS unsigned char* Vb = lds + AT_V + k * AT_VB;
#define ATT_LDK(dst, t2, kh) do { const int row_ = (t2) * 64 + (kh) * 32 + kr0; _Pragma("unroll") for (int s = 0; s < 4; ++s) \
                dst[s] = *(const LAS bf16x8*)(Kb + row_ * 128 + (((2 * s + hh) ^ ((row_ >> 1) & 7)) * 16)); } while (0)
#define ATT_LDV(dst, t2, d) do { const int row_ = (d) * 32 + l31; _Pragma("unroll") for (int kh = 0; kh < 2; ++kh) _Pragma("unroll") for (int s2 = 0; s2 < 2; ++s2) \
                dst[kh * 2 + s2] = *(const LAS bf16x8*)(Vb + row_ * 256 + ((((t2) * 8 + kh * 4 + s2 * 2 + hh) ^ (row_ & 15)) * 16)); } while (0)
#define ATT_QK4(Sx, fr) do { Sx = MFMA32(fr[0], qf[0], NM); _Pragma("unroll") for (int s = 1; s < 4; ++s) Sx = MFMA32(fr[s], qf[s], Sx); } while (0)
#define ATT_PV4(Ox, fr) do { _Pragma("unroll") for (int kh = 0; kh < 2; ++kh) _Pragma("unroll") for (int s2 = 0; s2 < 2; ++s2) Ox = MFMA32(fr[kh * 2 + s2], pf[kh][s2], Ox); } while (0)
#define ATT_SG(mask, n) __builtin_amdgcn_sched_group_barrier(mask, n, 0)
#define ATT_PIPE4 do { _Pragma("unroll") for (int i_ = 0; i_ < 4; ++i_) { ATT_SG(0x008, 1); ATT_SG(0x100, 1); } } while (0)
            f32x16 S[2][2];
            {
                bf16x8 f0[4], f1[4];
                ATT_LDK(f0, 0, 0); ATT_LDK(f1, 0, 1);
                ATT_QK4(S[0][0], f0); ATT_LDK(f0, 1, 0);
                ATT_QK4(S[0][1], f1); ATT_LDK(f1, 1, 1);
                ATT_QK4(S[1][0], f0);
                ATT_QK4(S[1][1], f1);
                ATT_SG(0x100, 8); ATT_PIPE4; ATT_PIPE4; ATT_SG(0x008, 8);
            }
#pragma unroll
            for (int t2 = 0; t2 < 2; ++t2) {
                bf16x8 f0[4], f1[4];
                ATT_LDV(f0, t2, 0);
                float mx = S[t2][0][0];
#pragma unroll
                for (int r = 0; r < 16; ++r) { mx = fmaxf(mx, S[t2][0][r]); mx = fmaxf(mx, S[t2][1][r]); }
                { const auto rr = __builtin_amdgcn_permlane32_swap(__float_as_uint(mx), __float_as_uint(mx), false, false); mx = fmaxf(__uint_as_float(rr[0]), __uint_as_float(rr[1])); }
                const bool first = (st == 0 && t2 == 0);
                if (first || !__all(mx <= 8.0f)) {
                    const float delta = first ? mx : fmaxf(mx, 0.f);
                    if (!first) {
                        const float alpha = __builtin_amdgcn_exp2f(-delta);
                        lrun *= alpha;
#pragma unroll
                        for (int d = 0; d < 4; ++d)
#pragma unroll
                            for (int r = 0; r < 16; ++r) O[d][r] *= alpha;
                    }
                    mrun += delta;
#pragma unroll
                    for (int r = 0; r < 16; ++r) NM[r] = -mrun;
#pragma unroll
                    for (int kh = 0; kh < 2; ++kh)
#pragma unroll
                        for (int r = 0; r < 16; ++r) { S[t2][kh][r] -= delta; if (t2 == 0) S[1][kh][r] -= delta; }
                }
                float ls = 0.f;
#pragma unroll
                for (int kh = 0; kh < 2; ++kh)
#pragma unroll
                    for (int r = 0; r < 16; ++r) { const float pv = __builtin_amdgcn_exp2f(S[t2][kh][r]); S[t2][kh][r] = pv; ls += pv; }
                lrun += ls;
                bf16x8 pf[2][2];
#pragma unroll
                for (int kh = 0; kh < 2; ++kh)
#pragma unroll
                    for (int s2 = 0; s2 < 2; ++s2) pf[kh][s2] = pack_step(S[t2][kh], s2);
                ATT_LDV(f1, t2, 1);
                ATT_PV4(O[0], f0); ATT_LDV(f0, t2, 2);
                ATT_PV4(O[1], f1); ATT_LDV(f1, t2, 3);
                ATT_PV4(O[2], f0);
                ATT_PV4(O[3], f1);
                ATT_SG(0x100, 4); ATT_PIPE4; ATT_PIPE4; ATT_SG(0x008, 8);
            }
#undef ATT_LDK
#undef ATT_LDV
#undef ATT_QK4
#undef ATT_PV4
#undef ATT_SG
#undef ATT_PIPE4
            __syncthreads();
        }
        float ltot; { const auto rr = __builtin_amdgcn_permlane32_swap(__float_as_uint(lrun), __float_as_uint(lrun), false, false); ltot = __uint_as_float(rr[0]) + __uint_as_float(rr[1]); }
        const float inv = 1.0f / ltot;
#pragma unroll
        for (int d = 0; d < 4; ++d)
#pragma unroll
            for (int rq = 0; rq < 4; ++rq) {
                u32x2 w; w.x = pk_bf16(O[d][rq * 4 + 0] * inv, O[d][rq * 4 + 1] * inv); w.y = pk_bf16(O[d][rq * 4 + 2] * inv, O[d][rq * 4 + 3] * inv);
                *(u32x2*)(Og + d * 32 + 8 * rq + 4 * hh) = w;
            }
    }
    (void)grp;
#undef Qg
#undef Og
}

DI void p2b_conv(KA a, int bid, int nblk, int tid_in, int nostore) {
    int tid_ = tid_in; asm volatile("" : "+v"(tid_)); const int tid = tid_;
    bf16_t* XBC = (bf16_t*)(a.ws + G_XBC); const bf16_t* HALO = (const bf16_t*)(a.ws + G_HALO);
    const int cg = tid & 255, col = cg * 8;
    const float* cw = a.in[I_CONVW]; const float* cb = a.in[I_CONVB];
    float w0[8], w1[8], w2[8], bb[8];
#pragma unroll
    for (int i = 0; i < 8; ++i) { w0[i] = cw[col + i]; w1[i] = cw[2048 + col + i]; w2[i] = cw[4096 + col + i]; bb[i] = cb[col + i]; }
    for (int it = bid; it < GB * 36; it += nblk) {
        const int b = it / 36, blk = (it % 36) * 2 + (tid >> 8);
        const int pos0 = blk * 32;
        bf16_t* base = XBC + ((size_t)b * SALL + pos0) * 2048 + col;
        const bool first = (blk == 0 || blk == 8), last = (blk == 7 || blk == 71);
        u32x4 prev = (u32x4){0u, 0u, 0u, 0u}, nextblk = (u32x4){0u, 0u, 0u, 0u};
        if (!first) prev = *(const u32x4*)(HALO + (((size_t)b * 72 + blk - 1) * 2 + 1) * 2048 + col);
        if (!last) nextblk = *(const u32x4*)(HALO + (((size_t)b * 72 + blk + 1) * 2 + 0) * 2048 + col);
        u32x4 rows[32];
#pragma unroll
        for (int r = 0; r < 32; ++r) rows[r] = *(const u32x4*)(base + (size_t)r * 2048);
#pragma unroll
        for (int r = 0; r < 32; ++r) {
            const u32x4 pv = (r == 0) ? prev : rows[r - 1], cur = rows[r], nxt = (r < 31) ? rows[r + 1] : nextblk;
            const float p[8] = {bflo(pv.x), bfhi(pv.x), bflo(pv.y), bfhi(pv.y), bflo(pv.z), bfhi(pv.z), bflo(pv.w), bfhi(pv.w)};
            const float c[8] = {bflo(cur.x), bfhi(cur.x), bflo(cur.y), bfhi(cur.y), bflo(cur.z), bfhi(cur.z), bflo(cur.w), bfhi(cur.w)};
            const float n[8] = {bflo(nxt.x), bfhi(nxt.x), bflo(nxt.y), bfhi(nxt.y), bflo(nxt.z), bfhi(nxt.z), bflo(nxt.w), bfhi(nxt.w)};
            float v[8];
#pragma unroll
            for (int i = 0; i < 8; ++i) v[i] = siluf_(bb[i] + w0[i] * p[i] + w1[i] * c[i] + w2[i] * n[i]);
            u32x4 w; w.x = pk_bf16(v[0], v[1]); w.y = pk_bf16(v[2], v[3]); w.z = pk_bf16(v[4], v[5]); w.w = pk_bf16(v[6], v[7]);
            if (!nostore) *(u32x4*)(base + (size_t)r * 2048) = w; else asm volatile("" :: "v"(w.x), "v"(w.y), "v"(w.z), "v"(w.w));
        }
    }
}

constexpr int SS_BUF = 65536, SS_C = 0, SS_B = 16384, SS_X = 32768;
constexpr int SM_SET = 4352;
typedef short s16x4 __attribute__((ext_vector_type(4)));
DI int fsw(int r) { return ((r & 3) << 1) | ((r >> 2) & 1) | (r & 8); }
DI bf16x8 tr_frag(const LAS unsigned char* img, int rowb, int r0, int cblk, int lane) {
    const int i16 = lane & 15, q = i16 >> 2, p = i16 & 3;
    const int ra = r0 + q, rb = r0 + 4 + q, ch = (cblk >> 3) + (p >> 1);
    const s16x4 lo = __builtin_amdgcn_ds_read_tr16_b64_v4i16((LAS s16x4*)(img + ra * rowb + (((ch & 16) | ((ch & 15) ^ fsw(ra))) * 16) + 8 * (p & 1)));
    const s16x4 hi = __builtin_amdgcn_ds_read_tr16_b64_v4i16((LAS s16x4*)(img + rb * rowb + (((ch & 16) | ((ch & 15) ^ fsw(rb))) * 16) + 8 * (p & 1)));
    return __builtin_shufflevector(lo, hi, 0, 1, 2, 3, 4, 5, 6, 7);
}
DI void ssd_unit(KA a, LAS unsigned char* lds, int b, int g, int dir, int tid_in) {
    int tid = tid_in; asm volatile("" : "+v"(tid));
    const int wid = __builtin_amdgcn_readfirstlane(tid >> 6);
    const int hl = wid >> 1, pt = wid & 1, head = g * 4 + hl;
    const bf16_t* xa = (const bf16_t*)(a.ws + G_XBC) + (size_t)b * SALL * 2048;
    const float* dtp = (const float*)(a.ws + G_DT) + (size_t)b * SALL * 32;
    bf16_t* Ybase = (bf16_t*)(a.ws + (dir == 0 ? G_YF : G_YB)) + (size_t)b * SEQ * 1024 + head * 64 + pt * 32;
    const float dsk = (dir == 0) ? a.in[I_DSKIP][head] : 0.f;
    const float av = -__expf(a.in[I_ALOG][dir * 16 + g * 4 + (wid & 3)]);
#define SSD_GEOM(ci, seg0_, t0_) const int seg0_ = ((ci) < 4) ? 0 : CTXL; const int t0_ = (dir == 0) ? (((ci) < 4) ? (ci) : (ci) - 4) * 64 : (((ci) < 4) ? CTXL : SEQ) - 64 * ((((ci) < 4) ? (ci) : (ci) - 4) + 1)
    auto dma_chunk = [&](int ci, int k) {
        SSD_GEOM(ci, seg0, t0);
        const int lane = tid & 63;
#pragma unroll
        for (int q8 = 0; q8 < 8; ++q8) {
            const int q = wid * 8 + q8;
            int row, chp, colbase, imgoff;
            if (q < 32) { row = 4 * (q & 15) + (lane >> 4); chp = lane & 15; colbase = (q < 16) ? 1536 + g * 128 : 1024 + g * 128; imgoff = ((q < 16) ? SS_C : SS_B) + (q & 15) * 1024; }
            else { row = 2 * (q - 32) + (lane >> 5); chp = lane & 31; colbase = g * 256; imgoff = SS_X + (q - 32) * 1024; }
            const int ch = (chp & 16) | ((chp & 15) ^ fsw(row));
            const int tok = seg0 + ((dir == 0) ? t0 + row : t0 + 63 - row);
            __builtin_amdgcn_global_load_lds((const unsigned*)(xa + (size_t)tok * 2048 + colbase + ch * 8), (LAS unsigned*)(lds + k * SS_BUF + imgoff), 16, 0, 0);
        }
    };
    auto step_a = [&](int ci, int k, float dtv) {
        const int lane = tid & 63;
        LAS float* sm = (LAS float*)(lds + EPI_OFF + k * SM_SET);
        float v = dtv * av;
#pragma unroll
        for (int o = 1; o < 64; o <<= 1) { const float n = shidx(v, lane - o); if (lane >= o) v += n; }
        const float tot = shidx(v, 63);
        const int h4 = wid & 3;
        sm[h4 * 64 + lane] = v; sm[256 + h4 * 64 + lane] = dtv; sm[512 + h4 * 64 + lane] = __expf(tot - v) * dtv; sm[768 + h4 * 64 + lane] = __expf(v);
        if (lane == 63) sm[1024 + h4] = __expf(tot);
        (void)ci;
    };
    auto load_dt = [&](int ci) -> float {
        SSD_GEOM(ci, seg0, t0);
        const int lane = tid & 63;
        const int tok = seg0 + ((dir == 0) ? t0 + lane : t0 + 63 - lane);
        return dtp[(size_t)tok * 32 + dir * 16 + g * 4 + (wid & 3)];
    };
    f32x16 hT[4];
#pragma unroll
    for (int n = 0; n < 4; ++n)
#pragma unroll
        for (int r = 0; r < 16; ++r) hT[n][r] = 0.f;
    __syncthreads();
    dma_chunk(0, 0);
    if (wid < 4) step_a(0, 0, load_dt(0));
    __syncthreads();
#pragma unroll 1
    for (int ci = 0; ci < 36; ++ci) {
        const int k = ci & 1;
        const bool isctx = ci < 4;
        SSD_GEOM(ci, seg0_unused, t0); (void)seg0_unused;
        float dtn = 0.f;
        if (ci + 1 < 36) { dma_chunk(ci + 1, k ^ 1); if (wid < 4) dtn = load_dt(ci + 1); }
        int lo_ = tid & 63; asm volatile("" : "+v"(lo_));
        const int lane = lo_, l31 = lo_ & 31, hh = lo_ >> 5;
        const LAS unsigned char* Ci = lds + k * SS_BUF + SS_C; const LAS unsigned char* Bi = lds + k * SS_BUF + SS_B; const LAS unsigned char* Xi = lds + k * SS_BUF + SS_X;
        const LAS float* sm = (const LAS float*)(lds + EPI_OFF + k * SM_SET);
        const LAS float* sm_acum = sm + hl * 64; const LAS float* sm_dt = sm + 256 + hl * 64; const LAS float* sm_w = sm + 512 + hl * 64; const LAS float* sm_ea = sm + 768 + hl * 64;
        const int xcb = hl * 64 + pt * 32 + 16 * ((lane >> 4) & 1);
        if (!isctx) {
            f32x16 accs[2];
#pragma unroll
            for (int it = 0; it < 2; ++it)
#pragma unroll
                for (int r = 0; r < 16; ++r) accs[it][r] = 0.f;
#pragma unroll
            for (int nt = 0; nt < 4; ++nt)
#pragma unroll
                for (int s = 0; s < 2; ++s) {
                    const bf16x8 hb = pack_step(hT[nt], s);
                    const int c0 = nt * 4 + 2 * s;
#pragma unroll
                    for (int it = 0; it < 2; ++it) {
                        const int irow = it * 32 + l31;
                        const u32x2 f0 = *(const LAS u32x2*)(Ci + irow * 256 + ((c0 ^ fsw(irow)) * 16) + 8 * hh), f1 = *(const LAS u32x2*)(Ci + irow * 256 + (((c0 + 1) ^ fsw(irow)) * 16) + 8 * hh);
                        const u32x4 cfw = {f0.x, f0.y, f1.x, f1.y};
                        accs[it] = MFMA32(__builtin_bit_cast(bf16x8, cfw), hb, accs[it]);
                    }
                }
            __builtin_amdgcn_sched_barrier(0);
#pragma unroll
            for (int it = 0; it < 2; ++it) {
                f32x16 acc = accs[it];
                const int irow = it * 32 + l31;
#pragma unroll
                for (int a4 = 0; a4 < 4; ++a4) { const f32x4 e4 = *(const LAS f32x4*)(sm_ea + it * 32 + 8 * a4 + 4 * hh); acc[a4 * 4 + 0] *= e4[0]; acc[a4 * 4 + 1] *= e4[1]; acc[a4 * 4 + 2] *= e4[2]; acc[a4 * 4 + 3] *= e4[3]; }
                const float acum_i = sm_acum[irow];
                __builtin_amdgcn_sched_barrier(0);
#pragma unroll
                for (int jt = 0; jt <= it; ++jt) {
                    f32x16 cb;
#pragma unroll
                    for (int r = 0; r < 16; ++r) cb[r] = 0.f;
                    const int jrow = jt * 32 + l31;
#pragma unroll
                    for (int ks = 0; ks < 8; ++ks) {
                        const bf16x8 bf = *(const LAS bf16x8*)(Bi + jrow * 256 + (((2 * ks + hh) ^ fsw(jrow)) * 16));
                        const bf16x8 cf = *(const LAS bf16x8*)(Ci + irow * 256 + (((2 * ks + hh) ^ fsw(irow)) * 16));
                        cb = MFMA32(bf, cf, cb);
                    }
                    __builtin_amdgcn_sched_barrier(0);
#pragma unroll
                    for (int a4 = 0; a4 < 4; ++a4) {
                        const f32x4 aj = *(const LAS f32x4*)(sm_acum + jt * 32 + 8 * a4 + 4 * hh), dj = *(const LAS f32x4*)(sm_dt + jt * 32 + 8 * a4 + 4 * hh);
#pragma unroll
                        for (int b4 = 0; b4 < 4; ++b4) {
                            const float dec = __expf(fminf(acum_i - aj[b4], 0.f)) * dj[b4];
                            const int j = jt * 32 + 8 * a4 + 4 * hh + b4;
                            cb[a4 * 4 + b4] = (jt < it || j <= irow) ? cb[a4 * 4 + b4] * dec : 0.f;
                        }
                    }
#pragma unroll
                    for (int s = 0; s < 2; ++s) {
                        const int i16 = lane & 15, q = i16 >> 2, p = i16 & 3, ch = (xcb >> 3) + (p >> 1);
                        const int ra = jt * 32 + 16 * s + 4 * hh + q, rb = ra + 8;
                        const s16x4 lo = __builtin_amdgcn_ds_read_tr16_b64_v4i16((LAS s16x4*)(Xi + ra * 512 + (((ch & 16) | ((ch & 15) ^ fsw(ra))) * 16) + 8 * (p & 1)));
                        const s16x4 hi = __builtin_amdgcn_ds_read_tr16_b64_v4i16((LAS s16x4*)(Xi + rb * 512 + (((ch & 16) | ((ch & 15) ^ fsw(rb))) * 16) + 8 * (p & 1)));
                        acc = MFMA32(pack_step(cb, s), __builtin_shufflevector(lo, hi, 0, 1, 2, 3, 4, 5, 6, 7), acc);
                    }
                    __builtin_amdgcn_sched_barrier(0);
                }
                LAS unsigned char* yt = lds + YT_OFF + wid * 2048;
#pragma unroll
                for (int rq = 0; rq < 4; ++rq) {
                    const int i16 = lane & 15, q = i16 >> 2, p = i16 & 3, ch = (xcb >> 3) + (p >> 1);
                    const int ra = it * 32 + 8 * rq + 4 * hh + q;
                    const s16x4 xs = __builtin_amdgcn_ds_read_tr16_b64_v4i16((LAS s16x4*)(Xi + ra * 512 + (((ch & 16) | ((ch & 15) ^ fsw(ra))) * 16) + 8 * (p & 1)));
#pragma unroll
                    for (int j = 0; j < 4; ++j) *(LAS bf16_t*)(yt + (8 * rq + 4 * hh + j) * 64 + l31 * 2) = f2bf(acc[rq * 4 + j] + dsk * bf2f((bf16_t)xs[j]));
                }
                __builtin_amdgcn_sched_barrier(0);
#pragma unroll
                for (int q2 = 0; q2 < 2; ++q2) {
                    const int idx = q2 * 64 + lane, rw = idx >> 2, c4 = idx & 3;
                    const int i = it * 32 + rw, tnat = (dir == 0) ? t0 + i : t0 + 63 - i;
                    *(u32x4*)(Ybase + (size_t)tnat * 1024 + c4 * 8) = *(const LAS u32x4*)(yt + rw * 64 + c4 * 16);
                }
                __builtin_amdgcn_sched_barrier(0);
            }
        }
        {
            const float dec = sm[1024 + hl];
            bf16x8 wx[4];
#pragma unroll
            for (int ks = 0; ks < 4; ++ks) {
                const bf16x8 xf = tr_frag(Xi, 512, 16 * ks + 8 * hh, xcb, lane);
                const f32x4 wa = *(const LAS f32x4*)(sm_w + 16 * ks + 8 * hh), wb = *(const LAS f32x4*)(sm_w + 16 * ks + 8 * hh + 4);
                u32x4 o;
                o.x = pk_bf16(bf2f((bf16_t)xf[0]) * wa[0], bf2f((bf16_t)xf[1]) * wa[1]); o.y = pk_bf16(bf2f((bf16_t)xf[2]) * wa[2], bf2f((bf16_t)xf[3]) * wa[3]);
                o.z = pk_bf16(bf2f((bf16_t)xf[4]) * wb[0], bf2f((bf16_t)xf[5]) * wb[1]); o.w = pk_bf16(bf2f((bf16_t)xf[6]) * wb[2], bf2f((bf16_t)xf[7]) * wb[3]);
                wx[ks] = __builtin_bit_cast(bf16x8, o);
            }
            __builtin_amdgcn_sched_barrier(0);
#pragma unroll
            for (int nt = 0; nt < 4; ++nt) {
#pragma unroll
                for (int r = 0; r < 16; ++r) hT[nt][r] *= dec;
#pragma unroll
                for (int ks = 0; ks < 4; ++ks) {
                    const bf16x8 bt = tr_frag(Bi, 256, 16 * ks + 8 * hh, nt * 32 + 16 * ((lane >> 4) & 1), lane);
                    hT[nt] = MFMA32(bt, wx[ks], hT[nt]);
                }
                __builtin_amdgcn_sched_barrier(0);
            }
        }
        if (ci + 1 < 36 && wid < 4) step_a(ci + 1, k ^ 1, dtn);
        __syncthreads();
    }
#undef SSD_GEOM
}

DI void attn_finalize(KA a, int bid, int nblk, int tid_in) {
    int tid_ = tid_in; asm volatile("" : "+v"(tid_)); const int tid = tid_, wid = tid >> 6, lane = tid & 63;
    bf16_t* O0 = (bf16_t*)(a.ws + G_O); const bf16_t* O1 = (const bf16_t*)(a.ws + G_O1);
    float lam;
    { const float p1 = wave_sum(a.in[I_LQ1][lane] * a.in[I_LK1][lane], lane), p2 = wave_sum(a.in[I_LQ2][lane] * a.in[I_LK2][lane], lane); lam = __expf(p1) - __expf(p2) + LAM_INIT; }
    const float* gs = a.in[I_GSUB] + (lane & 7) * 16;
    float g[16];
#pragma unroll
    for (int i = 0; i < 16; ++i) g[i] = gs[i] * (1.0f - LAM_INIT);
    for (int row = bid * 8 + wid; row < TG; row += nblk * 8) {
        const size_t off = (size_t)row * 1024 + lane * 16;
        const u32x4 a0 = *(const u32x4*)(O0 + off), a1 = *(const u32x4*)(O0 + off + 8), b0 = *(const u32x4*)(O1 + off), b1 = *(const u32x4*)(O1 + off + 8);
        const unsigned aw[8] = {a0.x, a0.y, a0.z, a0.w, a1.x, a1.y, a1.z, a1.w}, bw[8] = {b0.x, b0.y, b0.z, b0.w, b1.x, b1.y, b1.z, b1.w};
        float o[16]; float ss = 0.f;
#pragma unroll
        for (int i = 0; i < 8; ++i) { o[2 * i] = bflo(aw[i]) - lam * bflo(bw[i]); o[2 * i + 1] = bfhi(aw[i]) - lam * bfhi(bw[i]); ss += o[2 * i] * o[2 * i] + o[2 * i + 1] * o[2 * i + 1]; }
        ss += shx(ss, 1, lane); ss += shx(ss, 2, lane); ss += shx(ss, 4, lane);
        const float rs = rsqrtf(ss * (1.0f / 128.0f) + EPS);
        u32x4 w0, w1;
        w0.x = pk_bf16(o[0] * rs * g[0], o[1] * rs * g[1]); w0.y = pk_bf16(o[2] * rs * g[2], o[3] * rs * g[3]); w0.z = pk_bf16(o[4] * rs * g[4], o[5] * rs * g[5]); w0.w = pk_bf16(o[6] * rs * g[6], o[7] * rs * g[7]);
        w1.x = pk_bf16(o[8] * rs * g[8], o[9] * rs * g[9]); w1.y = pk_bf16(o[10] * rs * g[10], o[11] * rs * g[11]); w1.z = pk_bf16(o[12] * rs * g[12], o[13] * rs * g[13]); w1.w = pk_bf16(o[14] * rs * g[14], o[15] * rs * g[15]);
        *(u32x4*)(O0 + off) = w0; *(u32x4*)(O0 + off + 8) = w1;
    }
}

struct SchedPlain {
    const bf16_t* A; const bf16_t* Bt; int nM, nN, K, G, c;
    DI bool next(int i, pg::Unit& u) const {
        const int L = i * G + c; if (L >= nM * nN) return false;
        pg::decode_tiles(L, nM, nN, u.pm, u.pn); u.kind = 0; u.aux = 0; return true;
    }
    static constexpr bool GATHER = false; static constexpr bool AUX = false;
    DI const char* a_tile(const pg::Unit& u) const { return (const char*)(A + (size_t)u.pm * 256 * K); }
    DI int a_row(const pg::Unit&, int) const { return 0; }
    DI const char* b_base(const pg::Unit& u) const { return (const char*)(Bt + (size_t)u.pn * 256 * K); }
};
struct EpiZG {
    const bf16_t* YF; const bf16_t* YB; bf16_t* YN; bf16_t* Gt; const float* gnorm; LAS float* scr;
    DI void operator()(const f32x4 (&acc)[2][2][4][2], const pg::Unit& u, int wr, int wc, int fr, int fq, int lane) const {
        const int rl = wr * 64 + fr, cl = wc * 32 + 8 * fq;
        const size_t row0 = (size_t)(u.pm * 256 + rl);
        if (u.pn >= 4) {
            bf16_t* gb = Gt + row0 * 2048 + (u.pn - 4) * 256 + cl;
#pragma unroll
            for (int ai = 0; ai < 2; ++ai)
#pragma unroll
                for (int m = 0; m < 4; ++m)
#pragma unroll
                    for (int bj = 0; bj < 2; ++bj) {
                        f32x4 s0, s1;
#pragma unroll
                        for (int i = 0; i < 4; ++i) { s0[i] = sigmoidf_(acc[ai][bj][m][0][i]); s1[i] = sigmoidf_(acc[ai][bj][m][1][i]); }
                        *(u32x4*)(gb + (size_t)(ai * 128 + m * 16) * 2048 + bj * 128) = pg::pack8(s0, s1);
                    }
            return;
        }
        const bf16_t* yfb = YF + row0 * 1024 + u.pn * 256 + cl; const bf16_t* ybb = YB + row0 * 1024 + u.pn * 256 + cl;
        u32x4 yp[2][4][2];
#pragma unroll
        for (int ai = 0; ai < 2; ++ai)
#pragma unroll
            for (int mh = 0; mh < 2; ++mh) {
                u32x4 fw[2][2], bw[2][2];
#pragma unroll
                for (int mm = 0; mm < 2; ++mm)
#pragma unroll
                    for (int bj = 0; bj < 2; ++bj) { const size_t o = (size_t)(ai * 128 + (mh * 2 + mm) * 16) * 1024 + bj * 128; fw[mm][bj] = *(const u32x4*)(yfb + o); bw[mm][bj] = *(const u32x4*)(ybb + o); }
#pragma unroll
                for (int mm = 0; mm < 2; ++mm) {
                    const int m = mh * 2 + mm; float ss = 0.f;
#pragma unroll
                    for (int bj = 0; bj < 2; ++bj) {
                        const u32x4 f = fw[mm][bj], b2 = bw[mm][bj];
                        const float yv[8] = {bflo(f.x) + bflo(b2.x), bfhi(f.x) + bfhi(b2.x), bflo(f.y) + bflo(b2.y), bfhi(f.y) + bfhi(b2.y),
                                             bflo(f.z) + bflo(b2.z), bfhi(f.z) + bfhi(b2.z), bflo(f.w) + bflo(b2.w), bfhi(f.w) + bfhi(b2.w)};
                        float y[8];
#pragma unroll
                        for (int n = 0; n < 2; ++n)
#pragma unroll
                            for (int i = 0; i < 4; ++i) { const float z = acc[ai][bj][m][n][i]; y[n * 4 + i] = yv[n * 4 + i] * siluf_(z); ss += y[n * 4 + i] * y[n * 4 + i]; }
                        u32x4 w; w.x = pk_bf16(y[0], y[1]); w.y = pk_bf16(y[2], y[3]); w.z = pk_bf16(y[4], y[5]); w.w = pk_bf16(y[6], y[7]);
                        asm volatile("" : "+v"(w.x), "+v"(w.y), "+v"(w.z), "+v"(w.w));
                        yp[ai][m][bj] = w;
                    }
                    ss += shx(ss, 16, lane); ss += shx(ss, 32, lane);
                    if (fq == 0) scr[(ai * 128 + m * 16 + rl) * 4 + wc] = ss;
                }
                asm volatile("" ::: "memory");
            }
        asm volatile("s_waitcnt lgkmcnt(0)" ::: "memory"); __builtin_amdgcn_s_barrier(); asm volatile("" ::: "memory");
        bf16_t* ynb = YN + row0 * 1024 + u.pn * 256 + cl;
        f32x4 g0[2], g1[2];
#pragma unroll
        for (int bj = 0; bj < 2; ++bj) { g0[bj] = *(const f32x4*)(gnorm + u.pn * 256 + bj * 128 + cl); g1[bj] = *(const f32x4*)(gnorm + u.pn * 256 + bj * 128 + cl + 4); }
#pragma unroll
        for (int ai = 0; ai < 2; ++ai)
#pragma unroll
            for (int m = 0; m < 4; ++m) {
                const f32x4 ps = *(const LAS f32x4*)(scr + (ai * 128 + m * 16 + rl) * 4);
                const float rs = rsqrtf((ps[0] + ps[1] + ps[2] + ps[3]) * (1.0f / 256.0f) + EPS);
#pragma unroll
                for (int bj = 0; bj < 2; ++bj) {
                    const u32x4 w = yp[ai][m][bj];
                    const f32x4 y0 = {bflo(w.x), bfhi(w.x), bflo(w.y), bfhi(w.y)}, y1 = {bflo(w.z), bfhi(w.z), bflo(w.w), bfhi(w.w)};
                    *(u32x4*)(ynb + (size_t)(ai * 128 + m * 16) * 1024 + bj * 128) = pg::pack8(y0 * rs * g0[bj], y1 * rs * g1[bj]);
                }
            }
        asm volatile("s_waitcnt lgkmcnt(0)" ::: "memory"); __builtin_amdgcn_s_barrier(); asm volatile("" ::: "memory");
    }
};
struct EpiBranchA {
    const bf16_t* Gt; bf16_t* P;
    DI void operator()(const f32x4 (&acc)[2][2][4][2], const pg::Unit& u, int wr, int wc, int fr, int fq, int) const {
        pg::for_each8(acc, wr, wc, fr, fq, [&](int r, int c, const f32x4& v0, const f32x4& v1) {
            const int R = u.pm * 256 + r, col = u.pn * 256 + c;
            const u32x4 gw = *(const u32x4*)(Gt + (size_t)R * 2048 + col);
            const f32x4 g0 = {bflo(gw.x), bfhi(gw.x), bflo(gw.y), bfhi(gw.y)}, g1 = {bflo(gw.z), bfhi(gw.z), bflo(gw.w), bfhi(gw.w)};
            *(u32x4*)(P + (size_t)R * 1024 + col) = pg::pack8(v0 * g0, v1 * g1);
        });
    }
};
struct EpiBranchS {
    const bf16_t* Gt; const bf16_t* P; bf16_t* U;
    DI void operator()(const f32x4 (&acc)[2][2][4][2], const pg::Unit& u, int wr, int wc, int fr, int fq, int) const {
        pg::for_each8(acc, wr, wc, fr, fq, [&](int r, int c, const f32x4& v0, const f32x4& v1) {
            const int R = u.pm * 256 + r, col = u.pn * 256 + c;
            const u32x4 gw = *(const u32x4*)(Gt + (size_t)R * 2048 + 1024 + col), pw = *(const u32x4*)(P + (size_t)R * 1024 + col);
            const f32x4 g0 = {bflo(gw.x), bfhi(gw.x), bflo(gw.y), bfhi(gw.y)}, g1 = {bflo(gw.z), bfhi(gw.z), bflo(gw.w), bfhi(gw.w)};
            const f32x4 p0 = {bflo(pw.x), bfhi(pw.x), bflo(pw.y), bfhi(pw.y)}, p1 = {bflo(pw.z), bfhi(pw.z), bflo(pw.w), bfhi(pw.w)};
            *(u32x4*)(U + (size_t)R * 1024 + col) = pg::pack8(p0 + v0 * g0, p1 + v1 * g1);
        });
    }
};
struct SchedBranches {
    const bf16_t* O; const bf16_t* YN; const bf16_t* Wa; const bf16_t* Ws; int G, c;
    static constexpr bool GATHER = false; static constexpr bool AUX = false;
    DI bool next(int i, pg::Unit& u) const {
        const int L = i * G + c; if (i >= 2 || c >= (TG / 256) * 4) return false;
        pg::decode_tiles(c, TG / 256, 4, u.pm, u.pn); u.kind = i; u.aux = 0; (void)L; return true;
    }
    DI const char* a_tile(const pg::Unit& u) const { const long d = (const char*)YN - (const char*)O; return (const char*)O + (u.kind ? d : 0L) + (size_t)u.pm * 256 * 1024 * 2; }
    DI int a_row(const pg::Unit&, int) const { return 0; }
    DI const char* b_base(const pg::Unit& u) const { const long d = (const char*)Ws - (const char*)Wa; return (const char*)Wa + (u.kind ? d : 0L) + (size_t)u.pn * 256 * 1024 * 2; }
};
struct EpiBranches {
    const bf16_t* Gt; bf16_t* P; bf16_t* U;
    DI void operator()(const f32x4 (&acc)[2][2][4][2], const pg::Unit& u, int wr, int wc, int fr, int fq, int) const {
        const size_t row0 = (size_t)(u.pm * 256 + wr * 64 + fr); const int col0 = u.pn * 256 + wc * 32 + 8 * fq;
        const bf16_t* gb = Gt + row0 * 2048 + (u.kind == 0 ? 0 : 1024) + col0;
        bf16_t* pb = P + row0 * 1024 + col0; bf16_t* ub = U + row0 * 1024 + col0;
#pragma unroll
        for (int ai = 0; ai < 2; ++ai) {
            u32x4 gw[4][2], pw[4][2];
#pragma unroll
            for (int m = 0; m < 4; ++m)
#pragma unroll
                for (int bj = 0; bj < 2; ++bj) {
                    gw[m][bj] = *(const u32x4*)(gb + (size_t)(ai * 128 + m * 16) * 2048 + bj * 128);
                    if (u.kind != 0) pw[m][bj] = *(const u32x4*)(pb + (size_t)(ai * 128 + m * 16) * 1024 + bj * 128);
                }
#pragma unroll
            for (int m = 0; m < 4; ++m)
#pragma unroll
                for (int bj = 0; bj < 2; ++bj) {
                    const u32x4 g = gw[m][bj];
                    const f32x4 g0 = {bflo(g.x), bfhi(g.x), bflo(g.y), bfhi(g.y)}, g1 = {bflo(g.z), bfhi(g.z), bflo(g.w), bfhi(g.w)};
                    if (u.kind == 0) *(u32x4*)(pb + (size_t)(ai * 128 + m * 16) * 1024 + bj * 128) = pg::pack8(acc[ai][bj][m][0] * g0, acc[ai][bj][m][1] * g1);
                    else {
                        const u32x4 q = pw[m][bj];
                        const f32x4 p0 = {bflo(q.x), bfhi(q.x), bflo(q.y), bfhi(q.y)}, p1 = {bflo(q.z), bfhi(q.z), bflo(q.w), bfhi(q.w)};
                        *(u32x4*)(ub + (size_t)(ai * 128 + m * 16) * 1024 + bj * 128) = pg::pack8(p0 + acc[ai][bj][m][0] * g0, p1 + acc[ai][bj][m][1] * g1);
                    }
                }
            asm volatile("" ::: "memory");
        }
    }
};
struct EpiPlainBf16 {
    bf16_t* O; int ldc;
    DI void operator()(const f32x4 (&acc)[2][2][4][2], const pg::Unit& u, int wr, int wc, int fr, int fq, int) const {
        bf16_t* base = O + (size_t)(u.pm * 256 + wr * 64 + fr) * ldc + u.pn * 256 + wc * 32 + 8 * fq;
#pragma unroll
        for (int ai = 0; ai < 2; ++ai)
#pragma unroll
            for (int m = 0; m < 4; ++m)
#pragma unroll
                for (int bj = 0; bj < 2; ++bj) *(u32x4*)(base + (size_t)(ai * 128 + m * 16) * ldc + bj * 128) = pg::pack8(acc[ai][bj][m][0], acc[ai][bj][m][1]);
    }
};

DI void p8_post(KA a, int grp, int bid, int nblk, int tid_in) {
    int tid_ = tid_in; asm volatile("" : "+v"(tid_)); const int tid = tid_, wid = tid >> 6, lane = tid & 63;
    const bf16_t* MIX = (const bf16_t*)(a.ws + G_MIX); bf16_t* H2 = (bf16_t*)(a.ws + G_H2);
    const float* MOD = (const float*)(a.ws + WS_MOD);
    const float* g1 = a.in[I_GPOST1]; const float* g2 = a.in[I_GPRE2];
    const int stride = nblk * 8;
    for (int row0 = bid * 8 + wid; row0 < TG; row0 += 2 * stride) {
        f32x4 mvv[2][4], xvv[2][4];
#pragma unroll
        for (int j = 0; j < 2; ++j) {
            const int row = min(row0 + j * stride, TG - 1), grow = grp * TG + row;
            const float* xs = a.in[I_X] + (size_t)grow * 1024; const bf16_t* ms = MIX + (size_t)row * 1024;
#pragma unroll
            for (int i = 0; i < 4; ++i) { const u32x2 mw = *(const u32x2*)(ms + i * 256 + lane * 4); mvv[j][i] = (f32x4){bflo(mw.x), bfhi(mw.x), bflo(mw.y), bfhi(mw.y)}; xvv[j][i] = __builtin_nontemporal_load((const f32x4*)(xs + i * 256 + lane * 4)); }
        }
#pragma unroll
        for (int j = 0; j < 2; ++j) {
            const int row = row0 + j * stride;
            if (row >= TG) break;
            const int grow = grp * TG + row; const float* md = MOD + (grow >> 11) * 6144; bf16_t* od = (bf16_t*)(a.ws + G_X1) + (size_t)row * 1024;
            float ss = 0.f;
#pragma unroll
            for (int i = 0; i < 4; ++i) ss += mvv[j][i][0] * mvv[j][i][0] + mvv[j][i][1] * mvv[j][i][1] + mvv[j][i][2] * mvv[j][i][2] + mvv[j][i][3] * mvv[j][i][3];
            ss = wave_sum(ss, lane);
            const float rs = rsqrtf(ss * (1.0f / 1024.0f) + EPS);
            float s2 = 0.f;
#pragma unroll
            for (int i = 0; i < 4; ++i) {
                const int c = i * 256 + lane * 4;
                const f32x4 gg = *(const f32x4*)(g1 + c), gt = *(const f32x4*)(md + 2048 + c);
                xvv[j][i] = xvv[j][i] + gt * (mvv[j][i] * rs * gg);
                { u32x2 w; w.x = pk_bf16(xvv[j][i][0], xvv[j][i][1]); w.y = pk_bf16(xvv[j][i][2], xvv[j][i][3]); *(u32x2*)(od + c) = w; }
                s2 += xvv[j][i][0] * xvv[j][i][0] + xvv[j][i][1] * xvv[j][i][1] + xvv[j][i][2] * xvv[j][i][2] + xvv[j][i][3] * xvv[j][i][3];
            }
            s2 = wave_sum(s2, lane);
            const float rs2 = rsqrtf(s2 * (1.0f / 1024.0f) + EPS);
#pragma unroll
            for (int i = 0; i < 4; ++i) {
                const int c = i * 256 + lane * 4;
                const f32x4 gg = *(const f32x4*)(g2 + c), sh = *(const f32x4*)(md + 3072 + c), sc = *(const f32x4*)(md + 4096 + c);
                const f32x4 y = xvv[j][i] * rs2 * gg * (sc + 1.0f) + sh;
                u32x2 w; w.x = pk_bf16(y[0], y[1]); w.y = pk_bf16(y[2], y[3]);
                *(u32x2*)(H2 + (size_t)row * 1024 + c) = w;
            }
        }
    }
}

struct EpiQ1 {
    bf16_t* HID; float* LOG;
    DI void operator()(const f32x4 (&acc)[2][2][4][2], const pg::Unit& u, int wr, int wc, int fr, int fq, int) const {
        if (u.pn == 2) {
            pg::for_each8(acc, wr, wc, fr, fq, [&](int r, int c, const f32x4& v0, const f32x4& v1) {
                if (c >= 64) return;
                float* o = LOG + (size_t)(u.pm * 256 + r) * 64 + c; *(f32x4*)o = v0; *(f32x4*)(o + 4) = v1;
            });
            return;
        }
#pragma unroll
        for (int ai = 0; ai < 2; ++ai)
#pragma unroll
            for (int m = 0; m < 4; ++m) {
                f32x4 h0, h1;
#pragma unroll
                for (int i = 0; i < 4; ++i) { h0[i] = siluf_(acc[ai][0][m][0][i]) * acc[ai][1][m][0][i]; h1[i] = siluf_(acc[ai][0][m][1][i]) * acc[ai][1][m][1][i]; }
                *(u32x4*)(HID + (size_t)(u.pm * 256 + wr * 64 + fr) * 256 + u.pn * 128 + wc * 32 + 8 * fq + (size_t)(ai * 128 + m * 16) * 256) = pg::pack8(h0, h1);
            }
    }
};
DI void q2_route(KA a, LAS unsigned char* lds, int bid, int nblk, int tid_in) {
    int tid_ = tid_in; asm volatile("" : "+v"(tid_)); const int tid = tid_, wid = tid >> 6, lane = tid & 63;
    const float* LOG = (const float*)(a.ws + M_LOG); int* TOPE = (int*)(a.ws + M_TOPE); float* TOPW = (float*)(a.ws + M_TOPW); int* TPOS = (int*)(a.ws + M_TPOS);
    int* BCNT = (int*)(a.ws + M_BCNT);
    LAS int* hist = (LAS int*)lds;
    if (tid < NQ * NEXP) hist[tid] = 0;
    __syncthreads();
    const float bias = a.in[I_RB][lane];
    for (int t = bid * 8 + wid; t < TG; t += nblk * 8) {
        const int qq = t / QT;
        const float score = sigmoidf_(LOG[(size_t)t * 64 + lane]);
        const float sel = score + bias;
        float m1 = sel;
        m1 = fmaxf(m1, shx(m1, 1, lane)); m1 = fmaxf(m1, shx(m1, 2, lane)); m1 = fmaxf(m1, shx(m1, 4, lane));
        int i1 = (sel == m1) ? lane : 64;
        i1 = min(i1, shxi(i1, 1, lane)); i1 = min(i1, shxi(i1, 2, lane)); i1 = min(i1, shxi(i1, 4, lane));
        float m2 = (lane == i1) ? -INFINITY : sel;
        m2 = fmaxf(m2, shx(m2, 1, lane)); m2 = fmaxf(m2, shx(m2, 2, lane)); m2 = fmaxf(m2, shx(m2, 4, lane));
        const float gs = m1 + m2; const int myg = lane >> 3;
        int grank = 0;
#pragma unroll
        for (int g2 = 0; g2 < 8; ++g2) { const float o = __int_as_float(__builtin_amdgcn_readlane(__float_as_int(gs), g2 * 8)); grank += (o > gs || (o == gs && g2 < myg)) ? 1 : 0; }
        const float v = (grank < 4) ? sel : -INFINITY;
        int rank = 0;
#pragma unroll 4
        for (int e2 = 0; e2 < 64; ++e2) { const float o = __int_as_float(__builtin_amdgcn_readlane(__float_as_int(v), e2)); rank += (o > v || (o == v && e2 < lane)) ? 1 : 0; }
        const bool chosen = (rank < 8) && (grank < 4);
        const float wsum = wave_sum(chosen ? score : 0.f, lane);
        if (chosen) {
            const int pos = __hip_atomic_fetch_add(&hist[qq * NEXP + lane], 1, __ATOMIC_RELAXED, __HIP_MEMORY_SCOPE_WORKGROUP);
            TOPE[t * 8 + rank] = lane; TOPW[t * 8 + rank] = score / wsum * 2.5f; TPOS[t * 8 + rank] = pos;
        }
    }
    __syncthreads();
    if (tid < NQ * NEXP) BCNT[((tid >> 6) * 1024 + bid) * NEXP + (tid & 63)] = hist[tid];
}
DI void q3_scatter(KA a, LAS unsigned char* lds, int bid, int nblk, int tid_in) {
    int tid_ = tid_in; asm volatile("" : "+v"(tid_)); const int tid = tid_, wid = tid >> 6, lane = tid & 63;
    LAS int* tot = (LAS int*)lds; LAS int* base = tot + NQ * 64; LAS int* offs = base + NQ * 64;
    const int* BCNT = (const int*)(a.ws + M_BCNT);
    {
        const int ce = tid & 127, part = tid >> 7, qq = ce >> 6, e = ce & 63;
        int t_ = 0, p_ = 0;
        const int b0 = part * ((nblk + 3) >> 2), b1 = min(nblk, b0 + ((nblk + 3) >> 2));
#pragma unroll 8
        for (int b = b0; b < b1; ++b) { const int c = BCNT[(qq * 1024 + b) * NEXP + e]; t_ += c; p_ += (b < bid) ? c : 0; }
        LAS int* part_t = offs + NQ * 128; LAS int* part_p = part_t + 512;
        part_t[tid] = t_; part_p[tid] = p_;
        __syncthreads();
        if (tid < NQ * NEXP) { tot[tid] = part_t[tid] + part_t[tid + 128] + part_t[tid + 256] + part_t[tid + 384]; base[tid] = part_p[tid] + part_p[tid + 128] + part_p[tid + 256] + part_p[tid + 384]; }
    }
    __syncthreads();
    if (tid < NQ) { int o = 0; for (int e = 0; e < NEXP; ++e) { offs[tid * 128 + e] = o; o += (tot[tid * 64 + e] + 255) & ~255; } offs[tid * 128 + 64] = o; offs[tid * 128 + 65] = o >> 8; }
    __syncthreads();
    if (tid < NQ * NEXP) base[tid] += offs[(tid >> 6) * 128 + (tid & 63)];
    if (bid == 0 && tid < NQ * 128) ((int*)(a.ws + M_OFFS))[tid] = ((tid & 127) < 66) ? offs[tid] : 0;
    if (bid == 0 && tid < NQ * NEXP) { const int qq = tid >> 6, e = tid & 63; int* TILE = (int*)(a.ws + M_TILE) + qq * 1024; for (int tt = offs[qq * 128 + e] >> 8; tt < (offs[qq * 128 + e + 1] >> 8); ++tt) TILE[tt] = e; }
    __syncthreads();
    const int* TOPE = (const int*)(a.ws + M_TOPE); const int* TPOS = (const int*)(a.ws + M_TPOS); int* ROWL = (int*)(a.ws + M_ROWL);
    const float* TOPW = (const float*)(a.ws + M_TOPW); float* ROWW = (float*)(a.ws + M_ROWW);
    for (int t = bid * 8 + wid; t < TG; t += nblk * 8)
        if (lane < 8) { const int qq = t / QT, idx = t * 8 + lane; const size_t rp = (size_t)qq * MAXROWS + base[qq * 64 + TOPE[idx]] + TPOS[idx]; ROWL[rp] = idx - qq * QT * 8; ROWW[rp] = TOPW[idx]; }
    for (int idx = bid * NT + tid; idx < NQ * NEXP * 256; idx += nblk * NT) {
        const int qq = idx >> 14, e = (idx >> 8) & 63, k = idx & 255, c = tot[qq * 64 + e], pad = ((c + 255) & ~255) - c;
        if (k < pad) ROWL[(size_t)qq * MAXROWS + offs[qq * 128 + e] + c + k] = -1;
    }
    __syncthreads();
}
DI void moe_offsets(KA a, LAS int* offs, int tid) {
    if (tid < NQ * 128) offs[tid] = ((const int*)(a.ws + M_OFFS))[tid];
    __syncthreads();
}
struct SchedQ4 {
    const bf16_t* H2; const bf16_t* W1; const int* ROWL; const LAS int* offs; const int* TILE; int G, c;
    static constexpr bool GATHER = true; static constexpr bool AUX = false;
    DI bool next(int i, pg::Unit& u) const {
        const int L = i * G + c; const int t0 = __builtin_amdgcn_readfirstlane(offs[65]), t1 = (NQ > 1) ? __builtin_amdgcn_readfirstlane(offs[(NQ > 1 ? 128 : 0) + 65]) : 0; if (L >= (t0 + t1) * 2) return false;
        pg::decode_tiles(L, t0 + t1, 2, u.pm, u.pn);
        const int qq = (u.pm >= t0) ? 1 : 0; u.pm -= qq * t0;
        u.kind = qq; u.aux = __builtin_amdgcn_readfirstlane(TILE[qq * 1024 + u.pm]); return true;
    }
    DI const char* a_tile(const pg::Unit& u) const { return (const char*)(H2 + (size_t)u.kind * QT * 1024); }
    DI int a_row(const pg::Unit& u, int r) const { const int id = ROWL[(size_t)u.kind * MAXROWS + u.pm * 256 + r]; return id < 0 ? 0 : (id >> 3); }
    DI const char* b_base(const pg::Unit& u) const { return (const char*)(W1 + ((size_t)u.aux * 512 + u.pn * 256) * 1024); }
};
struct EpiQ4 {
    bf16_t* HID;
    DI void operator()(const f32x4 (&acc)[2][2][4][2], const pg::Unit& u, int wr, int wc, int fr, int fq, int) const {
        bf16_t* base = HID + ((size_t)u.kind * MAXROWS + u.pm * 256 + wr * 64 + fr) * 256 + u.pn * 128 + wc * 32 + 8 * fq;
#pragma unroll
        for (int ai = 0; ai < 2; ++ai)
#pragma unroll
            for (int m = 0; m < 4; ++m) {
                f32x4 h0, h1;
#pragma unroll
                for (int i = 0; i < 4; ++i) { h0[i] = siluf_(acc[ai][0][m][0][i]) * acc[ai][1][m][0][i]; h1[i] = siluf_(acc[ai][0][m][1][i]) * acc[ai][1][m][1][i]; }
                *(u32x4*)(base + (size_t)(ai * 128 + m * 16) * 256) = pg::pack8(h0, h1);
            }
    }
};
struct SchedQ5 {
    const bf16_t* HID; const bf16_t* HIDS; const bf16_t* W2; const LAS int* offs; const int* TILE; int G, c;
    static constexpr bool GATHER = false; static constexpr bool AUX = false;
    DI bool next(int i, pg::Unit& u) const {
        const int L = i * G + c; const int ne = __builtin_amdgcn_readfirstlane(offs[65]) * 4; if (L >= ne + (QT / 256) * 4) return false;
        if (L < ne) { pg::decode_tiles(L, ne >> 2, 4, u.pm, u.pn); u.kind = 0; u.aux = __builtin_amdgcn_readfirstlane(TILE[u.pm]); }
        else { pg::decode_tiles(L - ne, QT / 256, 4, u.pm, u.pn); u.kind = 1; u.aux = NEXP; }
        return true;
    }
    DI const char* a_tile(const pg::Unit& u) const { const long d = (const char*)HIDS - (const char*)HID; return (const char*)HID + (u.kind ? d : 0L) + (size_t)u.pm * 256 * 256 * 2; }
    DI int a_row(const pg::Unit&, int) const { return 0; }
    DI const char* b_base(const pg::Unit& u) const { return (const char*)(W2 + ((size_t)u.aux * 1024 + u.pn * 256) * 256); }
};
struct EpiQ5 {
    const int* ROWL; const float* ROWW; unsigned char* AOUT; bf16_t* SOUT;
    DI void operator()(const f32x4 (&acc)[2][2][4][2], const pg::Unit& u, int wr, int wc, int fr, int fq, int) const {
        if (u.kind == 1) {
            bf16_t* base = SOUT + (size_t)(u.pm * 256 + wr * 64 + fr) * 1024 + u.pn * 256 + wc * 32 + 8 * fq;
#pragma unroll
            for (int ai = 0; ai < 2; ++ai)
#pragma unroll
                for (int m = 0; m < 4; ++m)
#pragma unroll
                    for (int bj = 0; bj < 2; ++bj) *(u32x4*)(base + (size_t)(ai * 128 + m * 16) * 1024 + bj * 128) = pg::pack8(acc[ai][bj][m][0], acc[ai][bj][m][1]);
            return;
        }
        int ids[8]; float wts[8];
#pragma unroll
        for (int k = 0; k < 8; ++k) ids[k] = ROWL[u.pm * 256 + (k >> 2) * 128 + wr * 64 + (k & 3) * 16 + fr];
#pragma unroll
        for (int k = 0; k < 8; ++k) wts[k] = ROWW[u.pm * 256 + (k >> 2) * 128 + wr * 64 + (k & 3) * 16 + fr];
#pragma unroll
        for (int ai = 0; ai < 2; ++ai)
#pragma unroll
            for (int m = 0; m < 4; ++m) {
                const int id = ids[ai * 4 + m]; const float w = wts[ai * 4 + m];
                if (id >= 0) {
                    u32x4 pk;
                    { const f32x4 v0 = acc[ai][0][m][0] * w, v1 = acc[ai][0][m][1] * w;
                      int lo = __builtin_amdgcn_cvt_pk_fp8_f32(v0[0], v0[1], 0, false); lo = __builtin_amdgcn_cvt_pk_fp8_f32(v0[2], v0[3], lo, true);
                      int hi2 = __builtin_amdgcn_cvt_pk_fp8_f32(v1[0], v1[1], 0, false); hi2 = __builtin_amdgcn_cvt_pk_fp8_f32(v1[2], v1[3], hi2, true);
                      pk.x = (unsigned)lo; pk.y = (unsigned)hi2; }
                    { const f32x4 v0 = acc[ai][1][m][0] * w, v1 = acc[ai][1][m][1] * w;
                      int lo = __builtin_amdgcn_cvt_pk_fp8_f32(v0[0], v0[1], 0, false); lo = __builtin_amdgcn_cvt_pk_fp8_f32(v0[2], v0[3], lo, true);
                      int hi2 = __builtin_amdgcn_cvt_pk_fp8_f32(v1[0], v1[1], 0, false); hi2 = __builtin_amdgcn_cvt_pk_fp8_f32(v1[2], v1[3], hi2, true);
                      pk.z = (unsigned)lo; pk.w = (unsigned)hi2; }
                    __builtin_nontemporal_store(pk, (u32x4*)(AOUT + (size_t)id * 1024 + u.pn * 256 + wc * 64 + fq * 16));
                }
            }
    }
};
DI void q6_combine(KA a, int grp, int qi, int bid, int nblk, int tid_in, int nostore) {
    int tid_ = tid_in; asm volatile("" : "+v"(tid_)); const int tid = tid_, wid = tid >> 6, lane = tid & 63;
    const unsigned char* AOUT = (const unsigned char*)(a.ws + M_AOUT); const bf16_t* SOUT = (const bf16_t*)(a.ws + M_SOUT);
    const float* MOD = (const float*)(a.ws + WS_MOD); const float* g = a.in[I_GPOST2];
    for (int t = bid * 8 + wid; t < QT; t += nblk * 8) {
        const int grow = grp * TG + qi * QT + t; const float* md = MOD + (grow >> 11) * 6144; float* od = a.out + (size_t)grow * 1024;
        const bf16_t* x1p = (const bf16_t*)(a.ws + G_X1) + (size_t)(qi * QT + t) * 1024;
        const int cl = (lane >> 5) * 256 + (lane & 1) * 128 + ((lane >> 3) & 3) * 32 + ((lane >> 1) & 3) * 8;
        const u32x4 x1w0 = __builtin_nontemporal_load((const u32x4*)(x1p + cl)), x1w1 = __builtin_nontemporal_load((const u32x4*)(x1p + 512 + cl));
        float f[16];
        { const u32x4 s0 = *(const u32x4*)(SOUT + (size_t)t * 1024 + cl), s1 = *(const u32x4*)(SOUT + (size_t)t * 1024 + 512 + cl);
          f[0] = bflo(s0.x); f[1] = bfhi(s0.x); f[2] = bflo(s0.y); f[3] = bfhi(s0.y); f[4] = bflo(s0.z); f[5] = bfhi(s0.z); f[6] = bflo(s0.w); f[7] = bfhi(s0.w);
          f[8] = bflo(s1.x); f[9] = bfhi(s1.x); f[10] = bflo(s1.y); f[11] = bfhi(s1.y); f[12] = bflo(s1.z); f[13] = bfhi(s1.z); f[14] = bflo(s1.w); f[15] = bfhi(s1.w); }
#pragma unroll
        for (int s = 0; s < 8; ++s) {
            const unsigned char* rp = AOUT + ((size_t)t * 8 + s) * 1024;
            const u32x2 s0 = __builtin_nontemporal_load((const u32x2*)(rp + lane * 8)), s1 = __builtin_nontemporal_load((const u32x2*)(rp + 512 + lane * 8));
#define Q6_ADD4(base_, w_) do { f[(base_) + 0] += __builtin_amdgcn_cvt_f32_fp8((int)(w_), 0); f[(base_) + 1] += __builtin_amdgcn_cvt_f32_fp8((int)(w_), 1); \
                f[(base_) + 2] += __builtin_amdgcn_cvt_f32_fp8((int)(w_), 2); f[(base_) + 3] += __builtin_amdgcn_cvt_f32_fp8((int)(w_), 3); } while (0)
            Q6_ADD4(0, s0.x); Q6_ADD4(4, s0.y); Q6_ADD4(8, s1.x); Q6_ADD4(12, s1.y);
#undef Q6_ADD4
        }
        float ss = 0.f;
#pragma unroll
        for (int i = 0; i < 16; ++i) ss += f[i] * f[i];
        ss = wave_sum(ss, lane);
        const float rs = rsqrtf(ss * (1.0f / 1024.0f) + EPS);
#pragma unroll
        for (int hf = 0; hf < 2; ++hf)
#pragma unroll
            for (int q4 = 0; q4 < 2; ++q4) {
                const int c = hf * 512 + cl + q4 * 4;
                const f32x4 gg = *(const f32x4*)(g + c), gt = *(const f32x4*)(md + 5120 + c);
                const u32x4 xw = hf ? x1w1 : x1w0; const unsigned xa = q4 ? xw.z : xw.x, xb = q4 ? xw.w : xw.y;
                const f32x4 x1 = {bflo(xa), bfhi(xa), bflo(xb), bfhi(xb)};
                f32x4 fv = {f[hf * 8 + q4 * 4 + 0], f[hf * 8 + q4 * 4 + 1], f[hf * 8 + q4 * 4 + 2], f[hf * 8 + q4 * 4 + 3]};
                const f32x4 ov = x1 + gt * (fv * rs * gg);
                if (!nostore) __builtin_nontemporal_store(ov, (f32x4*)(od + c)); else asm volatile("" :: "v"(ov[0]), "v"(ov[1]), "v"(ov[2]), "v"(ov[3]));
            }
    }
}

constexpr int STEPS_PER_GRP = 13 + NQ * 2;
constexpr int N_STEPS = 1 + NGRP * STEPS_PER_GRP;
template <unsigned PH_MASK>
__global__ void __launch_bounds__(NT, 2) fwd(Args a_) {
    extern __shared__ __attribute__((aligned(16))) unsigned char lds_raw[];
    LAS unsigned char* lds = (LAS unsigned char*)lds_raw;
    const int wave_id = __builtin_amdgcn_readfirstlane(threadIdx.x >> 6);
#define TID_NOW (wave_id * 64 + lane_now())
    volatile LAS unsigned* misc = (volatile LAS unsigned*)(lds + MISC_OFF);
    { const int t = TID_NOW; if (t < 4) misc[t] = 0u; }
    __syncthreads();
    const int lo = a_.ph_lo, hi = a_.ph_hi;
    XcdBarrier bar; bar.bar = (unsigned*)(a_.ws + WS_CTL); bar.x = 0; bar.st = misc;
    if (hi - lo > 1) bar = xcd_barrier_post((unsigned*)(a_.ws + WS_CTL), misc, TID_NOW);
#define IN(k) (lo <= (k) && (k) < hi)
#define SEAM(k) do { if (IN(k) && IN((k) + 1)) xcd_barrier(bar, TID_NOW); } while (0)
#define FRESH_ARGS KArgs* ap_ = (KArgs*)__builtin_amdgcn_kernarg_segment_ptr(); asm volatile("" : "+s"(ap_)); KA a = *ap_; unsigned char* ws = a.ws; (void)ws; int bid = blockIdx.x, nblk = gridDim.x; asm volatile("" : "+s"(bid), "+s"(nblk)); int tid = TID_NOW; asm volatile("" : "+v"(tid))
    _Pragma("unroll 1") for (int rep_ = 0; rep_ < (((REPEAT_MASK >> 0) & 1u) ? REPEAT_N : 1); ++rep_) if (((PH_MASK >> 0) & 1) && IN(0)) { FRESH_ARGS; p0_prologue(a, lds, bid, nblk, tid); SEAM(0); }
#pragma unroll 1
    for (int grp = 0; grp < NGRP; ++grp) {
        const int base = 1 + grp * STEPS_PER_GRP;
        _Pragma("unroll 1") for (int rep_ = 0; rep_ < (((REPEAT_MASK >> 1) & 1u) ? REPEAT_N : 1); ++rep_) if (((PH_MASK >> 1) & 1) && IN(base + 0)) { FRESH_ARGS; p1_norm(a, grp, bid, nblk, tid); SEAM(base + 0); }
        _Pragma("unroll 1") for (int rep_ = 0; rep_ < (((REPEAT_MASK >> 2) & 1u) ? REPEAT_N : 1); ++rep_) if (((PH_MASK >> 2) & 1) && IN(base + 1)) { FRESH_ARGS;
            SchedInproj S{(const bf16_t*)(ws + G_H), (const bf16_t*)(ws + WS_WIN), (const bf16_t*)(ws + WS_WV), nblk, bid};
            EpiInproj E{(bf16_t*)(ws + G_Q), (bf16_t*)(ws + G_K), (bf16_t*)(ws + G_VT), (bf16_t*)(ws + G_XBC), (float*)(ws + G_DT), (const float*)(ws + WS_ROPE), a.in[I_DTB], (bf16_t*)(ws + G_HALO)};
            pg::gemm_phase(lds, 1024, S, E, tid);
            SEAM(base + 1);
        }
        _Pragma("unroll 1") for (int rep_ = 0; rep_ < (((REPEAT_MASK >> 15) & 1u) ? REPEAT_N : 1); ++rep_) if (((PH_MASK >> 15) & 1) && IN(base + 2)) { FRESH_ARGS; p2b_conv(a, bid, nblk, tid, rep_); SEAM(base + 2); }
        _Pragma("unroll 1") for (int rep_ = 0; rep_ < (((REPEAT_MASK >> 3) & 1u) ? REPEAT_N : 1); ++rep_) if (((PH_MASK >> 3) & 1) && IN(base + 3)) { FRESH_ARGS;
            unsigned* qhead = (unsigned*)(ws + WS_CTL) + CW_Q3 + grp * 64 + rep_ * 16;
            volatile LAS int* qslot = (volatile LAS int*)(lds + MISC_OFF + 64);
#pragma unroll 1
            for (;;) {
                if (tid == 0) qslot[0] = (int)__hip_atomic_fetch_add(qhead, 1u, __ATOMIC_RELAXED, __HIP_MEMORY_SCOPE_AGENT);
                __syncthreads();
                const int L = __builtin_amdgcn_readfirstlane(qslot[0]);
                __syncthreads();
                if (L >= 64 * (1 + SSD_REPEAT) + 1024 + ((grp == 0 && rep_ == 0) ? CVT_ENTRIES : 0)) break;
                unsigned long long t0_ = 0; if (PROBE_UNIT >= 0 && grp == 0 && L == PROBE_UNIT) t0_ = __builtin_amdgcn_s_memrealtime();
#ifndef NO_SSD
                if (L < 64 * (1 + SSD_REPEAT)) { const int u = L & 63; ssd_unit(a, lds, u >> 3, (u >> 1) & 3, u & 1, tid); }
#endif
#ifndef NO_ATTN
                if (L >= 64 * (1 + SSD_REPEAT) && L < 64 * (1 + SSD_REPEAT) + 1024) { const int j = L - 64 * (1 + SSD_REPEAT); attn_unit(a, lds, grp, j >> 7, (j >> 4) & 7, (j >> 1) & 7, j & 1, tid); }
                if (L >= 64 * (1 + SSD_REPEAT) + 1024) { const int e0 = (L - 64 * (1 + SSD_REPEAT) - 1024) * CVT_ENTRY; cvt_all(a, e0, e0 + CVT_ENTRY, 0, 1, tid, lds); }
#endif
                __syncthreads();
                if (PROBE_UNIT >= 0 && grp == 0 && L == PROBE_UNIT && tid == 0) *(float*)(ws + WS_CTL + 15360) = (float)(__builtin_amdgcn_s_memrealtime() - t0_) * 0.001f;
            }
            SEAM(base + 3);
        }
        _Pragma("unroll 1") for (int rep_ = 0; rep_ < (((REPEAT_MASK >> 4) & 1u) ? REPEAT_N : 1); ++rep_) if (((PH_MASK >> 4) & 1) && IN(base + 4)) { FRESH_ARGS;
            attn_finalize(a, bid, nblk, tid);
            SchedPlain S{(const bf16_t*)(ws + G_H), (const bf16_t*)(ws + WS_WZG), TG / 256, 12, 1024, nblk, bid};
            EpiZG E{(const bf16_t*)(ws + G_YF), (const bf16_t*)(ws + G_YB), (bf16_t*)(ws + G_YN), (bf16_t*)(ws + G_G), a.in[I_GSSD], (LAS float*)(lds + EPI_OFF)};
            pg::gemm_phase(lds, 1024, S, E, tid);
            SEAM(base + 4);
        }
        _Pragma("unroll 1") for (int rep_ = 0; rep_ < (((REPEAT_MASK >> 5) & 1u) ? REPEAT_N : 1); ++rep_) if (((PH_MASK >> 5) & 1) && IN(base + 5)) { FRESH_ARGS;
            SchedBranches S{(const bf16_t*)(ws + G_O), (const bf16_t*)(ws + G_YN), (const bf16_t*)(ws + WS_WA), (const bf16_t*)(ws + WS_WS), nblk, bid};
            EpiBranches E{(const bf16_t*)(ws + G_G), (bf16_t*)(ws + G_P), (bf16_t*)(ws + G_U)};
            pg::gemm_phase(lds, 1024, S, E, tid);
            SEAM(base + 5);
        }
        _Pragma("unroll 1") for (int rep_ = 0; rep_ < (((REPEAT_MASK >> 6) & 1u) ? REPEAT_N : 1); ++rep_) if (((PH_MASK >> 6) & 1) && IN(base + 6)) { FRESH_ARGS;

        }
        _Pragma("unroll 1") for (int rep_ = 0; rep_ < (((REPEAT_MASK >> 7) & 1u) ? REPEAT_N : 1); ++rep_) if (((PH_MASK >> 7) & 1) && IN(base + 7)) { FRESH_ARGS;
            SchedPlain S{(const bf16_t*)(ws + G_U), (const bf16_t*)(ws + WS_WO), TG / 256, 4, 1024, nblk, bid};
            EpiPlainBf16 E{(bf16_t*)(ws + G_MIX), 1024};
            pg::gemm_phase(lds, 1024, S, E, tid);
            SEAM(base + 7);
        }
        _Pragma("unroll 1") for (int rep_ = 0; rep_ < (((REPEAT_MASK >> 8) & 1u) ? REPEAT_N : 1); ++rep_) if (((PH_MASK >> 8) & 1) && IN(base + 8)) { FRESH_ARGS; p8_post(a, grp, bid, nblk, tid); SEAM(base + 8); }
        _Pragma("unroll 1") for (int rep_ = 0; rep_ < (((REPEAT_MASK >> 9) & 1u) ? REPEAT_N : 1); ++rep_) if (((PH_MASK >> 9) & 1) && IN(base + 9)) { FRESH_ARGS;
            SchedPlain S{(const bf16_t*)(ws + G_H2), (const bf16_t*)(ws + WS_W1) + (size_t)NEXP * 512 * 1024, TG / 256, 3, 1024, nblk, bid};
            EpiQ1 E{(bf16_t*)(ws + M_HIDS), (float*)(ws + M_LOG)};
            pg::gemm_phase(lds, 1024, S, E, tid);
            SEAM(base + 9);
        }
        _Pragma("unroll 1") for (int rep_ = 0; rep_ < (((REPEAT_MASK >> 10) & 1u) ? REPEAT_N : 1); ++rep_) if (((PH_MASK >> 10) & 1) && IN(base + 10)) { FRESH_ARGS; q2_route(a, lds, bid, nblk, tid); SEAM(base + 10); }
        _Pragma("unroll 1") for (int rep_ = 0; rep_ < (((REPEAT_MASK >> 11) & 1u) ? REPEAT_N : 1); ++rep_) if (((PH_MASK >> 11) & 1) && IN(base + 11)) { FRESH_ARGS; q3_scatter(a, lds, bid, nblk, tid); SEAM(base + 11); }
        _Pragma("unroll 1") for (int rep_ = 0; rep_ < (((REPEAT_MASK >> 12) & 1u) ? REPEAT_N : 1); ++rep_) if (((PH_MASK >> 12) & 1) && IN(base + 12)) { FRESH_ARGS;
            LAS int* offs = (LAS int*)(lds + EPI_OFF); moe_offsets(a, offs, tid);
            SchedQ4 S{(const bf16_t*)(ws + G_H2), (const bf16_t*)(ws + WS_W1), (const int*)(ws + M_ROWL), offs, (const int*)(ws + M_TILE), nblk, bid};
            EpiQ4 E{(bf16_t*)(ws + M_HID)};
            pg::gemm_phase(lds, 1024, S, E, tid);
            SEAM(base + 12);
        }
#pragma unroll 1
        for (int qi = 0; qi < NQ; ++qi) {
            const int qb = base + 13 + qi * 2;
            _Pragma("unroll 1") for (int rep_ = 0; rep_ < (((REPEAT_MASK >> 13) & 1u) ? REPEAT_N : 1); ++rep_) if (((PH_MASK >> 13) & 1) && IN(qb + 0)) { FRESH_ARGS;
                LAS int* offs = (LAS int*)(lds + EPI_OFF); moe_offsets(a, offs, tid);
                SchedQ5 S{(const bf16_t*)(ws + M_HID) + (size_t)qi * MAXROWS * 256, (const bf16_t*)(ws + M_HIDS) + (size_t)qi * QT * 256, (const bf16_t*)(ws + WS_W2), offs + qi * 128, (const int*)(ws + M_TILE) + qi * 1024, nblk, bid};
                EpiQ5 E{(const int*)(ws + M_ROWL) + (size_t)qi * MAXROWS, (const float*)(ws + M_ROWW) + (size_t)qi * MAXROWS, (unsigned char*)(ws + M_AOUT), (bf16_t*)(ws + M_SOUT)};
                pg::gemm_phase(lds, 256, S, E, tid);
                SEAM(qb + 0);
            }
            _Pragma("unroll 1") for (int rep_ = 0; rep_ < (((REPEAT_MASK >> 14) & 1u) ? REPEAT_N : 1); ++rep_) if (((PH_MASK >> 14) & 1) && IN(qb + 1)) { FRESH_ARGS; q6_combine(a, grp, qi, bid, nblk, tid, rep_); SEAM(qb + 1); }
        }
    }
    if (PROBE_UNIT >= 0 && hi == N_STEPS && blockIdx.x == 0 && TID_NOW == 0) { __builtin_amdgcn_fence(__ATOMIC_ACQUIRE, "agent"); a_.out[0] += *(volatile float*)(a_.ws + WS_CTL + 15360); }
#undef IN
#undef SEAM
}

typedef void (*KernFn)(Args);
template <unsigned M> static KernFn kern() { return fwd<M>; }
extern "C" void kernel_launch(void* const* d_in, const int* in_sizes, int n_in, void* d_out, int out_size, void* d_ws, size_t ws_size, hipStream_t stream) {
    static int grid = 0;
    if (grid == 0) {
        if (n_in != 33 || ws_size < WS_NEED) { fprintf(stderr, "kernel_launch: need 33 inputs and %zu bytes of workspace (got %d, %zu)\n", (size_t)WS_NEED, n_in, ws_size); grid = -1; return; }
        int dev = 0, cus = 0;
        if (hipGetDevice(&dev) != hipSuccess || hipDeviceGetAttribute(&cus, hipDeviceAttributeMultiprocessorCount, dev) != hipSuccess) { grid = -1; return; }
#if N_LAUNCH_MODE == 1
        if (hipFuncSetAttribute((const void*)kern<0xFFFFu>(), hipFuncAttributeMaxDynamicSharedMemorySize, LDS_BYTES) != hipSuccess) { fprintf(stderr, "kernel_launch: hipFuncSetAttribute failed\n"); grid = -1; return; }
        int per_cu = 0;
        if (hipOccupancyMaxActiveBlocksPerMultiprocessor(&per_cu, (const void*)kern<0xFFFFu>(), NT, LDS_BYTES) != hipSuccess || per_cu < 1) fprintf(stderr, "kernel_launch: occupancy query reports %d\n", per_cu);
#endif
        (void)hipGetLastError();
        grid = cus;
    }
    if (grid < 0) return;
    (void)in_sizes; (void)out_size;
    (void)hipMemsetAsync((char*)d_ws + WS_CTL, 0, CTL_BYTES, stream);
    Args a{};
    for (int i = 0; i < 33; ++i) a.in[i] = (const float*)d_in[i];
    a.out = (float*)d_out; a.ws = (unsigned char*)d_ws;
#if N_LAUNCH_MODE == 1
    a.ph_lo = 0; a.ph_hi = N_STEPS;
    hipLaunchKernelGGL(kern<0xFFFFu>(), dim3(grid), dim3(NT), LDS_BYTES, stream, a);
#endif
}
```

```cpp
#include <hip/hip_runtime.h>
#include <stdint.h>
#include <stdio.h>

#ifndef REPEAT_MASK
#define REPEAT_N 2
#define REPEAT_MASK 0u
#endif
#ifndef N_LAUNCH_MODE
#define N_LAUNCH_MODE 1
#endif

#define LAS __attribute__((address_space(3)))
#define DI __device__ __forceinline__
typedef unsigned short bf16_t;
typedef short bf16x8 __attribute__((ext_vector_type(8)));
typedef float f32x4 __attribute__((ext_vector_type(4)));
typedef float f32x2 __attribute__((ext_vector_type(2)));
typedef float f32x16 __attribute__((ext_vector_type(16)));
typedef unsigned u32x4 __attribute__((ext_vector_type(4)));
typedef unsigned u32x2 __attribute__((ext_vector_type(2)));
typedef __bf16 bf16v2 __attribute__((ext_vector_type(2)));

DI unsigned pk_bf16(float lo, float hi) { f32x2 v = {lo, hi}; bf16v2 b = __builtin_convertvector(v, bf16v2); return __builtin_bit_cast(unsigned, b); }
DI bf16_t f2bf(float x) { return (bf16_t)(pk_bf16(x, 0.f) & 0xffffu); }
DI float bflo(unsigned u) { return __uint_as_float(u << 16); }
DI float bfhi(unsigned u) { return __uint_as_float(u & 0xffff0000u); }
DI float bf2f(bf16_t x) { return __uint_as_float(((unsigned)x) << 16); }
DI float sigmoidf_(float x) { return __builtin_amdgcn_rcpf(1.0f + __expf(-x)); }
DI float siluf_(float x) { return x * __builtin_amdgcn_rcpf(1.0f + __expf(-x)); }
DI int swap23(int i) { return (i & ~12) | ((i & 4) << 1) | ((i & 8) >> 1); }
DI int crow(int reg, int h) { return (reg & 3) + 8 * (reg >> 2) + 4 * h; }
#define MFMA32(a, b, c) __builtin_amdgcn_mfma_f32_32x32x16_bf16((a), (b), (c), 0, 0, 0)
DI bf16x8 pack_step(const f32x16& x, int s) {
    u32x4 p;
    p[0] = pk_bf16(x[8 * s + 0], x[8 * s + 1]); p[1] = pk_bf16(x[8 * s + 2], x[8 * s + 3]);
    p[2] = pk_bf16(x[8 * s + 4], x[8 * s + 5]); p[3] = pk_bf16(x[8 * s + 6], x[8 * s + 7]);
    return __builtin_bit_cast(bf16x8, p);
}
DI float shx(float v, int o, int lane) { return __int_as_float(__builtin_amdgcn_ds_bpermute((lane ^ o) << 2, __float_as_int(v))); }
DI int shxi(int v, int o, int lane) { return __builtin_amdgcn_ds_bpermute((lane ^ o) << 2, v); }
DI float shidx(float v, int src) { return __int_as_float(__builtin_amdgcn_ds_bpermute(src << 2, __float_as_int(v))); }
DI int lane_now() { int l; asm volatile("v_mbcnt_lo_u32_b32 %0, -1, 0\n\tv_mbcnt_hi_u32_b32 %0, -1, %0" : "=v"(l)); return l; }
DI float wave_sum(float v, int lane) {
#pragma unroll
    for (int o = 32; o >= 1; o >>= 1) v += shx(v, o, lane);
    return v;
}

constexpr int NB = 16, SEQ = 2048, DM = 1024, CTXL = 256, SALL = SEQ + CTXL;
constexpr int GB = 8;
constexpr int NGRP = NB / GB;
constexpr int TG = GB * SEQ;
constexpr int CG = GB * CTXL;
constexpr int HR = TG + CG;
constexpr int QT = TG;
constexpr int NQ = TG / QT;
constexpr int IN_COLS = 8224;
constexpr float EPS = 1e-6f;
constexpr float LAM_INIT = 0.2f;
constexpr float QSCALE = 0.125f * 1.4426950408889634f;
constexpr int NEXP = 64;
constexpr int MAXROWS = QT * 8 + NEXP * 256;

constexpr size_t AL(size_t x) { return (x + 255) & ~(size_t)255; }
constexpr size_t WS_CTL   = 0;
constexpr size_t CTL_BYTES = 16384;
constexpr size_t WS_MOD   = WS_CTL + CTL_BYTES;
constexpr size_t WS_ROPE  = WS_MOD + AL(17 * 6144 * 4);
constexpr size_t WS_WIN   = WS_ROPE + AL(2048 * 32 * 2 * 4);
constexpr size_t WS_WV    = WS_WIN + AL((size_t)4352 * 1024 * 2);
constexpr size_t WS_WZG   = WS_WV + AL((size_t)1024 * 1024 * 2);
constexpr size_t WS_WA    = WS_WZG + AL((size_t)3072 * 1024 * 2);
constexpr size_t WS_WS    = WS_WA + AL((size_t)1024 * 1024 * 2);
constexpr size_t WS_WO    = WS_WS + AL((size_t)1024 * 1024 * 2);
constexpr size_t WS_W1    = WS_WO + AL((size_t)1024 * 1024 * 2);
constexpr size_t WS_W2    = WS_W1 + AL(((size_t)65 * 512 + 256) * 1024 * 2);
constexpr size_t WS_GRP   = WS_W2 + AL((size_t)65 * 1024 * 256 * 2);
constexpr size_t G_H   = WS_GRP;
constexpr size_t G_Q   = G_H + AL((size_t)HR * 1024 * 2);
constexpr size_t G_K   = G_Q + AL((size_t)TG * 1024 * 2);
constexpr size_t G_VT  = G_K + AL((size_t)GB * SALL * 1024 * 2);
constexpr size_t G_XBC = G_VT + AL((size_t)GB * 1024 * SALL * 2);
constexpr size_t G_DT  = G_XBC + AL((size_t)GB * SALL * 2048 * 2);
constexpr size_t G_O   = G_DT + AL((size_t)GB * SALL * 32 * 4);
constexpr size_t G_YF  = G_O + AL((size_t)TG * 1024 * 2);
constexpr size_t G_YB  = G_YF + AL((size_t)TG * 1024 * 2);
constexpr size_t G_HALO = G_YB + AL((size_t)TG * 1024 * 2);
constexpr size_t G_END = G_HALO + AL((size_t)GB * 72 * 2 * 2048 * 2);
constexpr size_t G_YN  = G_Q;
constexpr size_t G_G   = G_XBC;
constexpr size_t G_P   = G_K;
constexpr size_t G_U   = G_VT;
constexpr size_t G_MIX = G_YF;
constexpr size_t G_H2  = G_O;
constexpr size_t G_X1  = G_YB;
constexpr size_t M_HID  = G_H;
constexpr size_t M_HIDS = M_HID + AL((size_t)NQ * MAXROWS * 256 * 2);
constexpr size_t M_OFFS = M_HIDS + AL((size_t)TG * 256 * 2);
constexpr size_t M_TILE = M_OFFS + AL((size_t)NQ * 128 * 4);
constexpr size_t M_ROWL = M_TILE + AL((size_t)NQ * 1024 * 4);
constexpr size_t M_ROWW = M_ROWL + AL((size_t)NQ * MAXROWS * 4);
constexpr size_t M_AOUT = M_ROWW + AL((size_t)NQ * MAXROWS * 4);
constexpr size_t M_SOUT = M_AOUT + AL((size_t)QT * 8 * 1024);
constexpr size_t M_ENDA = M_SOUT + AL((size_t)QT * 1024 * 2);
static_assert(M_AOUT <= G_O, "the tables that survive until Q5 must end before H2 / the routing scratch");
constexpr size_t M_LOG  = G_YF;
constexpr size_t M_TOPE = M_LOG + AL((size_t)TG * 64 * 4);
constexpr size_t M_TOPW = M_TOPE + AL((size_t)TG * 8 * 4);
constexpr size_t M_TPOS = M_TOPW + AL((size_t)TG * 8 * 4);
constexpr size_t M_BCNT = M_TPOS + AL((size_t)TG * 8 * 4);
constexpr size_t M_ENDB = M_BCNT + AL((size_t)NQ * 1024 * 64 * 4);
static_assert(M_ENDB <= G_END, "routing scratch must fit in the MIX region");
constexpr size_t G_O1 = G_END;
constexpr size_t WS_NEED = (G_O1 + AL((size_t)TG * 1024 * 2) > M_ENDA) ? G_O1 + AL((size_t)TG * 1024 * 2) : M_ENDA;
constexpr int CW_Q3 = 3584;
#ifndef PROBE_UNIT
#define PROBE_UNIT -1
#endif
#ifndef SSD_REPEAT
#define SSD_REPEAT 0
#endif

#define XB_TMO      128
#define XB_XCNT(j)  (256  + 64 * (j))
#define XB_XSUB(j)  (1280 + 64 * (j))
#define XB_XGEN(j)  (2304 + 64 * (j))
#define XB_TOP      3328
#define XB_TOPGEN   3392
#define XCD_BAR_WORDS 3456
#define XB_SPIN_CAP (1u << 18)
DI unsigned xb_ld(unsigned* p)              { return __hip_atomic_load(p, __ATOMIC_RELAXED, __HIP_MEMORY_SCOPE_AGENT); }
DI unsigned xb_add(unsigned* p, unsigned v) { return __hip_atomic_fetch_add(p, v, __ATOMIC_RELAXED, __HIP_MEMORY_SCOPE_AGENT); }
DI unsigned xb_xcc_id() { return (unsigned)__builtin_amdgcn_s_getreg((3 << 11) | 20) & 0xFu; }
#define XB_SPIN(cond, bar) do { unsigned _sp = 0; while (cond) { __builtin_amdgcn_s_sleep(1); \
    if ((++_sp & 255u) == 0u) { if (xb_ld(&(bar)[XB_TMO])) break; if (_sp > XB_SPIN_CAP) { atomicAdd(&(bar)[XB_TMO], 1u); break; } } } } while (0)
struct XcdBarrier { unsigned* bar; unsigned x; volatile LAS unsigned* st; };
DI XcdBarrier xcd_barrier_post(unsigned* bar, volatile LAS unsigned* st, int tid) {
    XcdBarrier b; b.bar = bar; b.x = xb_xcc_id(); b.st = st;
    if (tid == 0) (void)xb_add(&bar[XB_XCNT(b.x)], 1u);
    return b;
}
DI void xcd_barrier_complete(unsigned* bar, unsigned x, unsigned& nloc, unsigned& nx) {
    const unsigned G = gridDim.x * gridDim.y * gridDim.z;
    unsigned sum, cnt, mine, sp = 0u;
    for (;;) {
        sum = 0u; cnt = 0u; mine = 0u;
#pragma unroll 1
        for (unsigned j = 0; j < 16; ++j) { const unsigned c = xb_ld(&bar[XB_XCNT(j)]); sum += c; cnt += (c > 0u) ? 1u : 0u; mine = (j == x) ? c : mine; }
        if (sum == G) break;
        __builtin_amdgcn_s_sleep(1);
        if ((++sp & 255u) == 0u) { if (xb_ld(&bar[XB_TMO])) break; if (sp > XB_SPIN_CAP) { atomicAdd(&bar[XB_TMO], 1u); break; } }
    }
    nloc = mine > 0u ? mine : 1u; nx = cnt > 0u ? cnt : 1u;
}
DI void xcd_barrier(const XcdBarrier& b, int tid) {
    asm volatile("s_waitcnt vmcnt(0)" ::: "memory");
    __syncthreads();
    if (tid == 0) {
        unsigned* bar = b.bar;
        __builtin_amdgcn_s_waitcnt(0);
        unsigned nloc = b.st[0], nx = b.st[1];
        if (nloc == 0u) { xcd_barrier_complete(bar, b.x, nloc, nx); b.st[0] = nloc; b.st[1] = nx; }
        const unsigned old = xb_add(&bar[XB_XSUB(b.x)], 1u);
        const unsigned gen = old / nloc;
        if (old + 1u == (gen + 1u) * nloc) {
            __builtin_amdgcn_fence(__ATOMIC_RELEASE, "agent");
            asm volatile("s_waitcnt vmcnt(0)" ::: "memory");
            const unsigned og = xb_add(&bar[XB_TOP], 1u);
            const unsigned tg = og / nx;
            if (og + 1u == (tg + 1u) * nx) xb_add(&bar[XB_TOPGEN], 1u);
            else XB_SPIN(xb_ld(&bar[XB_TOPGEN]) == tg, bar);
            __builtin_amdgcn_fence(__ATOMIC_ACQUIRE, "agent");
            xb_add(&bar[XB_XGEN(b.x)], 1u);
            asm volatile("s_waitcnt vmcnt(0)" ::: "memory");
        } else {
            XB_SPIN(xb_ld(&bar[XB_XGEN(b.x)]) == gen, bar);
            __builtin_amdgcn_fence(__ATOMIC_ACQUIRE, "agent");
            asm volatile("s_waitcnt vmcnt(0)" ::: "memory");
        }
    }
    __syncthreads();
}

namespace pg {
constexpr int BM = 256, BK = 64, HALF = 128, HTB = HALF * BK * 2, STAGE_BYTES = 8 * HTB;
DI int lds_byte(int r, int c) { const int st = (r >> 4) * 2 + (c >> 5), rr = r & 15, cc = c & 31, ob = rr * 64 + cc * 2; return st * 1024 + (ob ^ (((ob >> 9) & 1) << 5)); }
DI void stage_rc(int b, int& R, int& C) { const int st = b / 1024, sb = b % 1024, swz = sb ^ (((sb >> 9) & 1) << 5); R = (st >> 1) * 16 + swz / 64; C = (st & 1) * 32 + (swz % 64) / 2; }
DI int perm32(int rho) { const int n = rho >> 4, i = rho & 15; return 8 * (i >> 2) + 4 * n + (i & 3); }
struct Unit { int pm, pn, kind, aux; };
DI void decode_tiles(int L, int nM, int nN, int& pm, int& pn) {
    const int nwg = nM * nN; int wgid = L;
    { const int q = nwg / 8, r = nwg % 8, xcd = wgid % 8, off = wgid / 8; wgid = (xcd < r ? xcd * (q + 1) : r * (q + 1) + (xcd - r) * q) + off; }
    const int nig = 8 * nN, gid = wgid / nig, fm = gid * 8, gsz = (nM - fm) < 8 ? (nM - fm) : 8;
    pm = fm + ((wgid % nig) % gsz); pn = (wgid % nig) / gsz;
}
template <class Epi, class Sched>
DI void gemm_phase(LAS unsigned char* lds, const int K, const Sched& S, const Epi& E, int tid_in) {
    constexpr bool GATHER = Sched::GATHER;
    int tid = tid_in; asm volatile("" : "+v"(tid));
    const int wid = __builtin_amdgcn_readfirstlane(tid >> 6), lane = tid & 63, wr = wid >> 2, wc = wid & 3, fr = lane & 15, fq = lane >> 4;
    const int nt = K / BK;
    unsigned voffA[2], voffB[2];
    int Rr[2], Cc[2];
#pragma unroll
    for (int i = 0; i < 2; ++i) { int R, C; stage_rc(tid * 16 + i * 8192, R, C); const int Rb = (R & ~31) + perm32(R & 31);
        Rr[i] = R; Cc[i] = C; voffA[i] = (unsigned)(R * K + C) * 2u; voffB[i] = (unsigned)(Rb * K + C) * 2u; }
    const size_t kstep = (size_t)(BK * 2);
    const size_t hstep = (size_t)HALF * K * 2;
    const unsigned ldsw = (unsigned)wid * 1024u;
    const int aoff = lds_byte(wr * 64 + fr, fq * 8), boff = lds_byte(wc * 32 + fr, fq * 8);
#define PG_SA(b, h) (((b) * 2 + (h)) * HTB)
#define PG_SB(b, h) ((4 + (b) * 2 + (h)) * HTB)
#define PG_STAGE(bufoff, gbase, voff) do { _Pragma("unroll") for (int _i = 0; _i < 2; ++_i) \
        __builtin_amdgcn_global_load_lds((const unsigned*)((const char*)(gbase) + (voff)[_i]), (LAS unsigned*)(lds + (bufoff) + ldsw + _i * 8192), 16, 0, 0); } while (0)
#define PG_STAGE_A(bufoff, gb, kofs, h, o0, o1) do { if constexpr (GATHER) { if ((h) == 0) PG_STAGE(bufoff, (gb) + (kofs), o0); else PG_STAGE(bufoff, (gb) + (kofs), o1); } \
        else { PG_STAGE(bufoff, (gb) + (kofs) + (h) * hstep, voffA); } } while (0)
#define PG_LDA(dst, b, h) do { _Pragma("unroll") for (int m = 0; m < 4; ++m) _Pragma("unroll") for (int k = 0; k < 2; ++k) dst[m][k] = *(const LAS bf16x8*)(lds + PG_SA(b, h) + aoff + m * 2048 + k * 1024); } while (0)
#define PG_LDB(dst, b, h) do { _Pragma("unroll") for (int n = 0; n < 2; ++n) _Pragma("unroll") for (int k = 0; k < 2; ++k) dst[n][k] = *(const LAS bf16x8*)(lds + PG_SB(b, h) + boff + n * 2048 + k * 1024); } while (0)
#define PG_MMA(ai, bj, At, Bt) do { __builtin_amdgcn_s_setprio(1); _Pragma("unroll") for (int m = 0; m < 4; ++m) _Pragma("unroll") for (int n = 0; n < 2; ++n) _Pragma("unroll") for (int k = 0; k < 2; ++k) \
        acc[ai][bj][m][n] = __builtin_amdgcn_mfma_f32_16x16x32_bf16(Bt[n][k], At[m][k], acc[ai][bj][m][n], 0, 0, 0); __builtin_amdgcn_s_setprio(0); } while (0)
#define PG_WAIT_V(n) asm volatile("s_waitcnt vmcnt(" #n ")" ::: "memory")
#define PG_WAIT_L(n) asm volatile("s_waitcnt lgkmcnt(" #n ")" ::: "memory")
#define PG_BAR __builtin_amdgcn_s_barrier()
#define PG_SCHED __builtin_amdgcn_sched_barrier(0)
#define PG_AOFFS(u, o0, o1) do { if constexpr (GATHER) { _Pragma("unroll") for (int _i = 0; _i < 2; ++_i) { \
        o0[_i] = (unsigned)(S.a_row(u, Rr[_i]) * K + Cc[_i]) * 2u; o1[_i] = (unsigned)(S.a_row(u, HALF + Rr[_i]) * K + Cc[_i]) * 2u; } } } while (0)
    Unit cur, nxt; int ui = 0;
    if (!S.next(0, cur)) return;
    f32x4 acc[2][2][4][2];
#pragma unroll
    for (int a = 0; a < 2; ++a)
#pragma unroll
        for (int b = 0; b < 2; ++b)
#pragma unroll
            for (int m = 0; m < 4; ++m)
#pragma unroll
                for (int n = 0; n < 2; ++n) acc[a][b][m][n] = (f32x4){0.f, 0.f, 0.f, 0.f};
    bf16x8 At[4][2], B0[2][2], B1[2][2];
    unsigned cA0[2] = {0u, 0u}, cA1[2] = {0u, 0u}, nA0[2] = {0u, 0u}, nA1[2] = {0u, 0u};
    const char* cA = S.a_tile(cur); const char* cB = S.b_base(cur);
    PG_AOFFS(cur, cA0, cA1);
    if constexpr (Sched::AUX) S.aux(cur, lds, wid, lane);
    PG_STAGE(PG_SB(0, 0), cB, voffB); PG_STAGE(PG_SB(0, 1), cB + hstep, voffB); PG_STAGE_A(PG_SA(0, 0), cA, 0, 0, cA0, cA1); PG_STAGE_A(PG_SA(0, 1), cA, 0, 1, cA0, cA1);
    if (wr == 1) PG_BAR;
    PG_WAIT_V(2); PG_BAR;
    PG_STAGE(PG_SB(1, 0), cB + kstep, voffB); PG_STAGE_A(PG_SA(1, 0), cA, kstep, 0, cA0, cA1); PG_STAGE(PG_SB(1, 1), cB + hstep + kstep, voffB);
    PG_WAIT_V(6); PG_BAR;
    for (;;) {
        const bool has_next = S.next(ui + 1, nxt);
        const char* nA = cA; const char* nB = cB;
        if (has_next) { nA = S.a_tile(nxt); nB = S.b_base(nxt); PG_AOFFS(nxt, nA0, nA1); if constexpr (Sched::AUX) S.aux(nxt, lds, wid, lane); }
        else if constexpr (GATHER) { nA0[0] = cA0[0]; nA0[1] = cA0[1]; nA1[0] = cA1[0]; nA1[1] = cA1[1]; }
        for (int t = 0; t < nt; t += 2) {
            const bool last = (t == nt - 2);
            const char* a1 = cA + (size_t)(t + 1) * kstep;
            const char* a2 = last ? nA : cA + (size_t)(t + 2) * kstep; const char* b2 = last ? nB : cB + (size_t)(t + 2) * kstep;
            const char* b3 = b2 + kstep;
            unsigned s0[2] = {0u, 0u}, s1[2] = {0u, 0u};
            if constexpr (GATHER) { s0[0] = last ? nA0[0] : cA0[0]; s0[1] = last ? nA0[1] : cA0[1]; s1[0] = last ? nA1[0] : cA1[0]; s1[1] = last ? nA1[1] : cA1[1]; }
            PG_LDB(B0, 0, 0); PG_LDB(B1, 0, 1); PG_SCHED; PG_LDA(At, 0, 0); PG_STAGE_A(PG_SA(1, 1), a1, 0, 1, cA0, cA1);
            PG_WAIT_V(8); PG_WAIT_L(0); PG_BAR; PG_MMA(0, 0, At, B0); PG_MMA(0, 1, At, B1); PG_BAR; PG_SCHED;
            PG_LDA(At, 0, 1); PG_STAGE(PG_SB(0, 0), b2, voffB); PG_STAGE(PG_SB(0, 1), b2 + hstep, voffB); PG_STAGE_A(PG_SA(0, 0), a2, 0, 0, s0, s1);
            PG_WAIT_V(8); PG_WAIT_L(0); PG_BAR; PG_MMA(1, 0, At, B0); PG_MMA(1, 1, At, B1); PG_BAR; PG_SCHED;
            PG_LDB(B0, 1, 0); PG_LDB(B1, 1, 1); PG_SCHED; PG_LDA(At, 1, 0); PG_STAGE_A(PG_SA(0, 1), a2, 0, 1, s0, s1);
            PG_WAIT_V(8); PG_WAIT_L(0); PG_BAR; PG_MMA(0, 0, At, B0); PG_MMA(0, 1, At, B1); PG_BAR; PG_SCHED;
            PG_LDA(At, 1, 1); PG_STAGE(PG_SB(1, 0), b3, voffB); PG_STAGE(PG_SB(1, 1), b3 + hstep, voffB); PG_STAGE_A(PG_SA(1, 0), a2, kstep, 0, s0, s1);
            PG_WAIT_V(8); PG_WAIT_L(0); PG_BAR; PG_MMA(1, 0, At, B0); PG_MMA(1, 1, At, B1); PG_BAR; PG_SCHED;
        }
        if (wr == 0) PG_BAR;
        { const int ln_ = lane_now(); const int fr_ = ln_ & 15, fq_ = ln_ >> 4;
          E(acc, cur, wr, wc, fr_, fq_, ln_); }
        if (!has_next) break;
#pragma unroll
        for (int a = 0; a < 2; ++a)
#pragma unroll
            for (int b = 0; b < 2; ++b)
#pragma unroll
                for (int m = 0; m < 4; ++m)
#pragma unroll
                    for (int n = 0; n < 2; ++n) acc[a][b][m][n] = (f32x4){0.f, 0.f, 0.f, 0.f};
        cur = nxt; cA = nA; cB = nB; ++ui;
        if constexpr (GATHER) { cA0[0] = nA0[0]; cA0[1] = nA0[1]; cA1[0] = nA1[0]; cA1[1] = nA1[1]; }
        if (wr == 1) PG_BAR;
    }
    PG_WAIT_V(0);
    PG_BAR;
#undef PG_SA
#undef PG_SB
#undef PG_STAGE
#undef PG_STAGE_A
#undef PG_LDA
#undef PG_LDB
#undef PG_MMA
#undef PG_WAIT_V
#undef PG_WAIT_L
#undef PG_BAR
#undef PG_SCHED
#undef PG_AOFFS
}
template <int FE = 8, class F> DI void for_each8(const f32x4 (&acc)[2][2][4][2], int wr, int wc, int fr, int fq, F&& f) {
#pragma unroll
    for (int ai = 0; ai < 2; ++ai)
#pragma unroll
        for (int m = 0; m < 4; ++m)
#pragma unroll
            for (int bj = 0; bj < 2; ++bj) { f(ai * HALF + wr * 64 + m * 16 + fr, bj * HALF + wc * 32 + 8 * fq, acc[ai][bj][m][0], acc[ai][bj][m][1]); if (((ai * 8 + m * 2 + bj) % FE) == FE - 1) asm volatile("" ::: "memory"); }
}
DI u32x4 pack8(const f32x4& a, const f32x4& b) { u32x4 w; w.x = pk_bf16(a[0], a[1]); w.y = pk_bf16(a[2], a[3]); w.z = pk_bf16(b[0], b[1]); w.w = pk_bf16(b[2], b[3]); return w; }
}

struct Args { const float* in[33]; float* out; unsigned char* ws; int ph_lo, ph_hi; };
typedef const Args __attribute__((address_space(4))) KArgs;
#define KA KArgs&
enum { I_X = 0, I_C, I_CTX, I_CCTX, I_WADA, I_BADA, I_GPRE1, I_GPOST1, I_GPRE2, I_GPOST2, I_WIN, I_LQ1, I_LK1, I_LQ2, I_LK2, I_GSUB, I_CONVW, I_CONVB, I_DTB, I_ALOG,
       I_DSKIP, I_GSSD, I_WBA, I_WBS, I_WOUT, I_WR, I_RB, I_WEG, I_WEU, I_WED, I_WSG, I_WSU, I_WSD };
constexpr int NT = 512;
constexpr int RING_BYTES = pg::STAGE_BYTES;
constexpr int EPI_OFF = RING_BYTES;
constexpr int YT_OFF = EPI_OFF + 9216;
constexpr int MISC_OFF = YT_OFF + 16384;
constexpr int LDS_BYTES = MISC_OFF + 256;

struct CvtSeg { int in_idx, ld, col0, ncols, nvalid, K, mode, rowoff, nbatch; size_t dst_off, sstride, dstride; };
constexpr int cvt_items(const CvtSeg& g) { return (g.ncols / 256) * (g.K / 64) * g.nbatch; }
constexpr int N_CVT = 20;
__device__ constexpr CvtSeg kCvt[N_CVT] = {
    {I_WEG, 256, 0, 256, 256, 1024, 2, 0,   NEXP, WS_W1, (size_t)1024 * 256, (size_t)512 * 1024},
    {I_WEU, 256, 0, 256, 256, 1024, 2, 128, NEXP, WS_W1, (size_t)1024 * 256, (size_t)512 * 1024},
    {I_WED, 1024, 0, 1024, 1024, 256, 0, 0, NEXP, WS_W2, (size_t)256 * 1024, (size_t)1024 * 256},
    {I_WIN, IN_COLS, 0,    1024, 1024, 1024, 1, 0,    1, WS_WIN, 0, 0},
    {I_WIN, IN_COLS, 1024, 1024, 1024, 1024, 1, 1024, 1, WS_WIN, 0, 0},
    {I_WIN, IN_COLS, 4096, 2048, 2048, 1024, 0, 2048, 1, WS_WIN, 0, 0},
    {I_WIN, IN_COLS, 6144, 256,  32,   1024, 0, 4096, 1, WS_WIN, 0, 0},
    {I_WIN, IN_COLS, 2048, 1024, 1024, 1024, 0, 0,    1, WS_WV, 0, 0},
    {I_WIN, IN_COLS, 3072, 1024, 1024, 1024, 0, 0,    1, WS_WZG, 0, 0},
    {I_WIN, IN_COLS, 6176, 2048, 2048, 1024, 0, 1024, 1, WS_WZG, 0, 0},
    {I_WBA,  1024, 0, 1024, 1024, 1024, 0, 0, 1, WS_WA, 0, 0},
    {I_WBS,  1024, 0, 1024, 1024, 1024, 0, 0, 1, WS_WS, 0, 0},
    {I_WOUT, 1024, 0, 1024, 1024, 1024, 0, 0, 1, WS_WO, 0, 0},
    {I_WSG, 256, 0, 256, 256, 1024, 2, 0,   1, WS_W1 + (size_t)NEXP * 512 * 1024 * 2, 0, 0},
    {I_WSU, 256, 0, 256, 256, 1024, 2, 128, 1, WS_W1 + (size_t)NEXP * 512 * 1024 * 2, 0, 0},
    {I_WSD, 1024, 0, 1024, 1024, 256, 0, 0, 1, WS_W2 + (size_t)NEXP * 1024 * 256 * 2, 0, 0},
    {I_WR, 64, 0, 256, 64, 1024, 0, 0, 1, WS_W1 + (size_t)65 * 512 * 1024 * 2, 0, 0},
    {0, 0, 0, 0, 0, 256, 0, 0, 0, 0, 0, 0}, {0, 0, 0, 0, 0, 256, 0, 0, 0, 0, 0, 0}, {0, 0, 0, 0, 0, 256, 0, 0, 0, 0, 0, 0}
};
constexpr int cvt_total() { int t = 0; for (int i = 0; i < N_CVT; ++i) t += cvt_items(kCvt[i]); return t; }
constexpr int CVT_EXPERT_ITEMS = 3 * NEXP * 16;
constexpr int CVT_ENTRY = 8, CVT_ENTRIES = CVT_EXPERT_ITEMS / CVT_ENTRY;
DI void cvt_all(KA a, int gfirst, int gend, int bid, int nblk, int tid_in, LAS unsigned char* lds) {
    int tid_ = tid_in; asm volatile("" : "+v"(tid_)); const int tid = tid_, jl = tid & 63, kg = tid >> 6;
    const int nitems = gend;
    auto locate = [&](int g, int& sg, int& bt, int& jb, int& kb) {
        sg = 0; int base = 0;
#pragma unroll 1
        for (int i = 0; i < N_CVT; ++i) { const int n = (kCvt[i].ncols / 256) * (kCvt[i].K / 64) * kCvt[i].nbatch; if (g >= base + n) { base += n; sg = i + 1; } else break; }
        const int it = g - base, njb = kCvt[sg].ncols / 256, nper = njb * (kCvt[sg].K / 64);
        bt = it / nper; const int r = it % nper; jb = r % njb; kb = r / njb;
    };
    f32x4 v[8];
    auto load_item = [&](int g) {
        int sg, bt, jb, kb; locate(g, sg, bt, jb, kb);
        const float* src = a.in[kCvt[sg].in_idx] + (size_t)bt * kCvt[sg].sstride;
        const int j = jb * 256 + jl * 4, k0 = kb * 64 + kg * 8, ld = kCvt[sg].ld, col0 = kCvt[sg].col0;
        const bool ok = j < kCvt[sg].nvalid;
#pragma unroll
        for (int i = 0; i < 8; ++i) v[i] = ok ? __builtin_nontemporal_load((const f32x4*)(src + (size_t)(k0 + i) * ld + col0 + j)) : (f32x4){0.f, 0.f, 0.f, 0.f};
    };
    if (gfirst + bid < nitems) load_item(gfirst + bid);
    for (int g = gfirst + bid; g < nitems; g += nblk) {
        int sg, bt, jb, kb; locate(g, sg, bt, jb, kb);
        bf16_t* dst = (bf16_t*)(a.ws + kCvt[sg].dst_off) + (size_t)bt * kCvt[sg].dstride;
        const int K = kCvt[sg].K, mode = kCvt[sg].mode, rowoff = kCvt[sg].rowoff;
        u32x4 w[4];
#pragma unroll
        for (int c = 0; c < 4; ++c) { w[c].x = pk_bf16(v[0][c], v[1][c]); w[c].y = pk_bf16(v[2][c], v[3][c]); w[c].z = pk_bf16(v[4][c], v[5][c]); w[c].w = pk_bf16(v[6][c], v[7][c]); }
        if (g + nblk < nitems) load_item(g + nblk);
        __syncthreads();
#pragma unroll
        for (int c = 0; c < 4; ++c) *(LAS u32x4*)(lds + (jl * 4 + c) * 144 + kg * 16) = w[c];
        __syncthreads();
#pragma unroll
        for (int q = 0; q < 4; ++q) {
            const int idx = q * NT + tid, r = idx >> 3, ch = idx & 7, jj = jb * 256 + r;
            int row = jj;
            if (mode == 1) { const int blk = jj >> 6, d = jj & 63; row = blk * 64 + 2 * (d & 31) + (d >> 5); }
            else if (mode == 2) { row = (jj >> 7) * 256 + (jj & 127); }
            *(u32x4*)(dst + (size_t)(rowoff + row) * K + kb * 64 + ch * 8) = *(const LAS u32x4*)(lds + r * 144 + ch * 16);
        }
    }
    __syncthreads();
}
DI void p0_prologue(KA a, LAS unsigned char* lds, int bid, int nblk, int tid_in) {
    unsigned char* ws = a.ws;
    int tid_ = tid_in; asm volatile("" : "+v"(tid_)); const int tid = tid_;
    cvt_all(a, CVT_EXPERT_ITEMS, cvt_total(), bid, nblk, tid, lds);
    {
        float* rope = (float*)(ws + WS_ROPE);
        for (int idx = bid * NT + tid; idx < 2048 * 32; idx += nblk * NT) {
            const int n = idx >> 5, i = idx & 31, m = i & 15;
            const float inv = powf(10000.0f, -(float)(2 * m) / 32.0f);
            const float ang = (float)(i < 16 ? (n >> 6) : (n & 63)) * inv;
            float s, c; sincosf(ang, &s, &c);
            rope[idx * 2] = c; rope[idx * 2 + 1] = s;
        }
    }
    {
        LAS float* sc = (LAS float*)lds;
        LAS float* red = (LAS float*)(lds + 17 * 1024 * 4);
        float* MOD = (float*)(ws + WS_MOD);
        const float* w_ada = a.in[I_WADA];
        bool filled = false;
        for (int it = bid; it < 6144 / 32; it += nblk) {
            if (!filled) {
                for (int idx = tid; idx < 17 * 1024; idx += NT) { const int r = idx >> 10, k = idx & 1023; const float c = (r < 16) ? a.in[I_C][r * 1024 + k] : a.in[I_CCTX][k]; sc[idx] = siluf_(c); }
                filled = true;
            }
            __syncthreads();
            const int jl = tid & 31, kg = tid >> 5, j = it * 32 + jl;
            float acc[17];
#pragma unroll
            for (int r = 0; r < 17; ++r) acc[r] = 0.f;
#pragma unroll 8
            for (int k = kg * 64; k < kg * 64 + 64; ++k) {
                const float w = w_ada[(size_t)k * 6144 + j];
#pragma unroll
                for (int r = 0; r < 17; ++r) acc[r] += sc[r * 1024 + k] * w;
            }
#pragma unroll
            for (int r = 0; r < 17; ++r) red[(kg * 32 + jl) * 17 + r] = acc[r];
            __syncthreads();
            for (int idx = tid; idx < 32 * 17; idx += NT) {
                const int jj = idx / 17, r = idx % 17; float sum = 0.f;
#pragma unroll
                for (int g = 0; g < 16; ++g) sum += red[(g * 32 + jj) * 17 + r];
                MOD[r * 6144 + it * 32 + jj] = sum + a.in[I_BADA][it * 32 + jj];
            }
            __syncthreads();
        }
    }
}

DI void p1_norm(KA a, int grp, int bid, int nblk, int tid_in) {
    int tid_ = tid_in; asm volatile("" : "+v"(tid_)); const int tid = tid_, wid = tid >> 6, lane = tid & 63;
    bf16_t* H = (bf16_t*)(a.ws + G_H);
    const float* MOD = (const float*)(a.ws + WS_MOD);
    const float* g = a.in[I_GPRE1];
    const int stride = nblk * 8;
    for (int row0 = bid * 8 + wid; row0 < HR; row0 += 3 * stride) {
        f32x4 v[3][4]; int mrow[3];
#pragma unroll
        for (int j = 0; j < 3; ++j) {
            const int row = row0 + j * stride; const float* src = a.in[I_X]; mrow[j] = 0;
            if (row < TG) { const int grow = grp * TG + row; src = a.in[I_X] + (size_t)grow * 1024; mrow[j] = grow >> 11; }
            else if (row < HR) { const int crow_ = grp * CG + (row - TG); src = a.in[I_CTX] + (size_t)crow_ * 1024; mrow[j] = 16; }
#pragma unroll
            for (int i = 0; i < 4; ++i) v[j][i] = __builtin_nontemporal_load((const f32x4*)(src + i * 256 + lane * 4));
        }
#pragma unroll
        for (int j = 0; j < 3; ++j) {
            const int row = row0 + j * stride;
            if (row >= HR) break;
            float ss = 0.f;
#pragma unroll
            for (int i = 0; i < 4; ++i) ss += v[j][i][0] * v[j][i][0] + v[j][i][1] * v[j][i][1] + v[j][i][2] * v[j][i][2] + v[j][i][3] * v[j][i][3];
            ss = wave_sum(ss, lane);
            const float rs = rsqrtf(ss * (1.0f / 1024.0f) + EPS);
            const float* sh = MOD + mrow[j] * 6144; const float* scl = sh + 1024;
#pragma unroll
            for (int i = 0; i < 4; ++i) {
                const int c = i * 256 + lane * 4;
                const f32x4 gg = *(const f32x4*)(g + c), s1 = *(const f32x4*)(sh + c), s2 = *(const f32x4*)(scl + c);
                f32x4 y = v[j][i] * rs * gg * (s2 + 1.0f) + s1;
                u32x2 w; w.x = pk_bf16(y[0], y[1]); w.y = pk_bf16(y[2], y[3]);
                *(u32x2*)(H + (size_t)row * 1024 + c) = w;
            }
        }
    }
}

struct SchedInproj {
    const bf16_t* H; const bf16_t* WIN; const bf16_t* WV; int G, c;
    static constexpr int NL = 64 * 17, NA = NL + 8 * 13, NTOT = NA + 4 * 72;
    DI bool next(int i, pg::Unit& u) const {
        const int L = i * G + c; if (L >= NTOT) return false;
        if (L < NL) { pg::decode_tiles(L, 64, 17, u.pm, u.pn); u.kind = 0; }
        else if (L < NA) { pg::decode_tiles(L - NL, 8, 13, u.pm, u.pn); u.pm += 64; u.pn += 4; u.kind = 0; }
        else { const int j = L - NA; u.pm = j & 3; u.pn = j >> 2; u.kind = 1; }
        u.aux = 0; return true;
    }
    static constexpr bool GATHER = false; static constexpr bool AUX = false;
    DI const char* a_tile(const pg::Unit& u) const { return (const char*)((u.kind == 0 ? H : WV) + (size_t)u.pm * 256 * 1024); }
    DI int a_row(const pg::Unit&, int) const { return 0; }
    DI const char* b_base(const pg::Unit& u) const { return (const char*)((u.kind == 0 ? WIN : H) + (size_t)u.pn * 256 * 1024); }
};
struct EpiInproj {
    bf16_t* Q; bf16_t* Kb; bf16_t* VT; bf16_t* XBC; float* DT; const float* rope; const float* dtb; bf16_t* HALO;
    DI void operator()(const f32x4 (&acc)[2][2][4][2], const pg::Unit& u, int wr, int wc, int fr, int fq, int lane) const {
        const int rl = wr * 64 + fr, cl = wc * 32 + 8 * fq;
        if (u.kind == 1) {
            const int b = (u.pn < 64) ? (u.pn >> 3) : (u.pn - 64), pos0 = (u.pn < 64) ? (CTXL + (u.pn & 7) * 256) : 0;
            bf16_t* base = VT + ((size_t)b * 1024 + u.pm * 256 + rl) * SALL + pos0 + cl;
#pragma unroll
            for (int ai = 0; ai < 2; ++ai)
#pragma unroll
                for (int m = 0; m < 4; ++m)
#pragma unroll
                    for (int bj = 0; bj < 2; ++bj) *(u32x4*)(base + (size_t)(ai * 128 + m * 16) * SALL + bj * 128) = pg::pack8(acc[ai][bj][m][0], acc[ai][bj][m][1]);
            return;
        }
        const bool isctx = u.pm >= 64;
        const int b = isctx ? (u.pm - 64) : (u.pm >> 3), pos0 = isctx ? 0 : (CTXL + (u.pm & 7) * 256);
        const size_t drow0 = (size_t)b * SALL + pos0 + rl;
        if (u.pn < 8) {
            if (isctx && u.pn < 4) return;
            const bool isq = u.pn < 4;
            const long qk = (const char*)Kb - (const char*)Q;
            bf16_t* base = (bf16_t*)((char*)Q + (isq ? 0L : qk)) + (isq ? ((size_t)u.pm * 256 + rl) : drow0) * 1024 + (u.pn & 3) * 256 + cl;
            if (isctx) {
#pragma unroll
                for (int ai = 0; ai < 2; ++ai)
#pragma unroll
                    for (int m = 0; m < 4; ++m)
#pragma unroll
                        for (int bj = 0; bj < 2; ++bj) *(u32x4*)(base + (size_t)(ai * 128 + m * 16) * 1024 + bj * 128) = pg::pack8(acc[ai][bj][m][0], acc[ai][bj][m][1]);
                return;
            }
            const float* rp = rope + ((size_t)((u.pm & 7) * 256 + rl) * 32 + ((cl & 63) >> 1)) * 2;
            const float qs = isq ? QSCALE : 1.0f;
#pragma unroll
            for (int ai = 0; ai < 2; ++ai) {
                f32x4 cs0[4], cs1[4];
#pragma unroll
                for (int m = 0; m < 4; ++m) { cs0[m] = *(const f32x4*)(rp + (ai * 128 + m * 16) * 64) * qs; cs1[m] = *(const f32x4*)(rp + (ai * 128 + m * 16) * 64 + 4) * qs; }
#pragma unroll
                for (int m = 0; m < 4; ++m)
#pragma unroll
                    for (int bj = 0; bj < 2; ++bj) {
                        const f32x4 v0 = acc[ai][bj][m][0], v1 = acc[ai][bj][m][1]; f32x4 o0, o1;
                        o0[0] = v0[0] * cs0[m][0] - v0[1] * cs0[m][1]; o0[1] = v0[1] * cs0[m][0] + v0[0] * cs0[m][1];
                        o0[2] = v0[2] * cs0[m][2] - v0[3] * cs0[m][3]; o0[3] = v0[3] * cs0[m][2] + v0[2] * cs0[m][3];
                        o1[0] = v1[0] * cs1[m][0] - v1[1] * cs1[m][1]; o1[1] = v1[1] * cs1[m][0] + v1[0] * cs1[m][1];
                        o1[2] = v1[2] * cs1[m][2] - v1[3] * cs1[m][3]; o1[3] = v1[3] * cs1[m][2] + v1[2] * cs1[m][3];
                        *(u32x4*)(base + (size_t)(ai * 128 + m * 16) * 1024 + bj * 128) = pg::pack8(o0, o1);
                    }
                asm volatile("" ::: "memory");
            }
            return;
        }
        if (u.pn < 16) {
            bf16_t* base = XBC + drow0 * 2048 + (u.pn - 8) * 256 + cl;
            bf16_t* hb = HALO + (((size_t)b * 72 + (pos0 >> 5) + wr * 2) * 2) * 2048 + (u.pn - 8) * 256 + cl;
#pragma unroll
            for (int ai = 0; ai < 2; ++ai)
#pragma unroll
                for (int m = 0; m < 4; ++m)
#pragma unroll
                    for (int bj = 0; bj < 2; ++bj) {
                        const u32x4 w = pg::pack8(acc[ai][bj][m][0], acc[ai][bj][m][1]);
                        *(u32x4*)(base + (size_t)(ai * 128 + m * 16) * 2048 + bj * 128) = w;
                        if ((m & 1) == 0) { if (fr == 0) *(u32x4*)(hb + (size_t)((ai * 4 + (m >> 1)) * 2 + 0) * 2048 + bj * 128) = w; }
                        else { if (fr == 15) *(u32x4*)(hb + (size_t)((ai * 4 + (m >> 1)) * 2 + 1) * 2048 + bj * 128) = w; }
                    }
            return;
        }
        if (wc != 0) return;
        float* base = DT + drow0 * 32 + cl;
        const f32x4 db0 = *(const f32x4*)(dtb + cl), db1 = *(const f32x4*)(dtb + cl + 4);
#pragma unroll
        for (int ai = 0; ai < 2; ++ai)
#pragma unroll
            for (int m = 0; m < 4; ++m) {
                f32x4 o0, o1;
#pragma unroll
                for (int i = 0; i < 4; ++i) {
                    const float x0 = acc[ai][0][m][0][i] + db0[i], x1 = acc[ai][0][m][1][i] + db1[i];
                    const float e0 = __expf(-fabsf(x0)), e1 = __expf(-fabsf(x1));
                    o0[i] = fmaxf(x0, 0.f) + (e0 < 0.004f ? e0 * (1.0f - 0.5f * e0) : __logf(1.0f + e0));
                    o1[i] = fmaxf(x1, 0.f) + (e1 < 0.004f ? e1 * (1.0f - 0.5f * e1) : __logf(1.0f + e1));
                }
                *(f32x4*)(base + (size_t)(ai * 128 + m * 16) * 32) = o0; *(f32x4*)(base + (size_t)(ai * 128 + m * 16) * 32 + 4) = o1;
            }
        (void)lane;
    }
};

constexpr int AT_K = 0, AT_V = 32768, AT_KB = 16384, AT_VB = 32768;
DI void attn_unit(KA a, LAS unsigned char* lds, int grp, int b, int head, int qb, int c, int tid_in) {
    int tid = tid_in; asm volatile("" : "+v"(tid));
    const int wid = __builtin_amdgcn_readfirstlane(tid >> 6), lane = tid & 63, l31 = lane & 31, hh = lane >> 5;
    const unsigned qoff = (unsigned)((b * SEQ + qb * 256 + wid * 32 + l31) * 1024 + head * 128);
#define Qg ((const bf16_t*)(a.ws + G_Q) + qoff)
#define Og ((bf16_t*)(a.ws + (c == 0 ? G_O : G_O1)) + qoff)
    const bf16_t* Kg = (const bf16_t*)(a.ws + G_K) + (size_t)b * SALL * 1024 + head * 128;
    const bf16_t* Vg = (const bf16_t*)(a.ws + G_VT) + ((size_t)b * 1024 + head * 128) * SALL;
    const int kr0 = swap23(l31);
    {
        bf16x8 qf[4];
#pragma unroll
        for (int s = 0; s < 4; ++s) qf[s] = *(const bf16x8*)(Qg + c * 64 + 16 * s + 8 * hh);
        f32x16 O[4];
#pragma unroll
        for (int d = 0; d < 4; ++d)
#pragma unroll
            for (int r = 0; r < 16; ++r) O[d][r] = 0.f;
        float mrun = 0.f, lrun = 0.f;
        f32x16 NM;
#pragma unroll
        for (int r = 0; r < 16; ++r) NM[r] = 0.f;
        auto dma_stage = [&](int st, int k) {
            const int key0 = st * 128;
            int lane_ = lane; asm volatile("" : "+v"(lane_));
#pragma unroll
            for (int q6 = 0; q6 < 6; ++q6) {
                const int q = wid * 6 + q6;
                if (q < 16) {
                    const int row = 8 * q + (lane_ >> 3), ch = (lane_ & 7) ^ ((row >> 1) & 7);
                    __builtin_amdgcn_global_load_lds((const unsigned*)(Kg + (size_t)(key0 + row) * 1024 + c * 64 + ch * 8), (LAS unsigned*)(lds + AT_K + k * AT_KB + q * 1024), 16, 0, 0);
                } else {
                    const int d = 4 * (q - 16) + (lane_ >> 4), ch = (lane_ & 15) ^ (d & 15);
                    __builtin_amdgcn_global_load_lds((const unsigned*)(Vg + (size_t)d * SALL + key0 + ch * 8), (LAS unsigned*)(lds + AT_V + k * AT_VB + (q - 16) * 1024), 16, 0, 0);
                }
            }
        };
        __syncthreads();
        dma_stage(0, 0);
        __syncthreads();
#pragma unroll 1
        for (int st = 0; st < SALL / 128; ++st) {
            const int k = st & 1;
            if (st + 1 < SALL / 128) dma_stage(st + 1, k ^ 1);
            const LAS unsigned char* Kb = lds + AT_K + k * AT_KB; const LAS unsigned char* Vb = lds + AT_V + k * AT_VB;
#define ATT_LDK(dst, t2, kh) do { const int row_ = (t2) * 64 + (kh) * 32 + kr0; _Pragma("unroll") for (int s = 0; s < 4; ++s) \
                dst[s] = *(const LAS bf16x8*)(Kb + row_ * 128 + (((2 * s + hh) ^ ((row_ >> 1) & 7)) * 16)); } while (0)
#define ATT_LDV(dst, t2, d) do { const int row_ = (d) * 32 + l31; _Pragma("unroll") for (int kh = 0; kh < 2; ++kh) _Pragma("unroll") for (int s2 = 0; s2 < 2; ++s2) \
                dst[kh * 2 + s2] = *(const LAS bf16x8*)(Vb + row_ * 256 + ((((t2) * 8 + kh * 4 + s2 * 2 + hh) ^ (row_ & 15)) * 16)); } while (0)
#define ATT_QK4(Sx, fr) do { Sx = MFMA32(fr[0], qf[0], NM); _Pragma("unroll") for (int s = 1; s < 4; ++s) Sx = MFMA32(fr[s], qf[s], Sx); } while (0)
#define ATT_PV4(Ox, fr) do { _Pragma("unroll") for (int kh = 0; kh < 2; ++kh) _Pragma("unroll") for (int s2 = 0; s2 < 2; ++s2) Ox = MFMA32(fr[kh * 2 + s2], pf[kh][s2], Ox); } while (0)
#define ATT_SG(mask, n) __builtin_amdgcn_sched_group_barrier(mask, n, 0)
#define ATT_PIPE4 do { _Pragma("unroll") for (int i_ = 0; i_ < 4; ++i_) { ATT_SG(0x008, 1); ATT_SG(0x100, 1); } } while (0)
            f32x16 S[2][2];
            {
                bf16x8 f0[4], f1[4];
                ATT_LDK(f0, 0, 0); ATT_LDK(f1, 0, 1);
                ATT_QK4(S[0][0], f0); ATT_LDK(f0, 1, 0);
                ATT_QK4(S[0][1], f1); ATT_LDK(f1, 1, 1);
                ATT_QK4(S[1][0], f0);
                ATT_QK4(S[1][1], f1);
                ATT_SG(0x100, 8); ATT_PIPE4; ATT_PIPE4; ATT_SG(0x008, 8);
            }
#pragma unroll
            for (int t2 = 0; t2 < 2; ++t2) {
                bf16x8 f0[4], f1[4];
                ATT_LDV(f0, t2, 0);
                float mx = S[t2][0][0];
#pragma unroll
                for (int r = 0; r < 16; ++r) { mx = fmaxf(mx, S[t2][0][r]); mx = fmaxf(mx, S[t2][1][r]); }
                { const auto rr = __builtin_amdgcn_permlane32_swap(__float_as_uint(mx), __float_as_uint(mx), false, false); mx = fmaxf(__uint_as_float(rr[0]), __uint_as_float(rr[1])); }
                const bool first = (st == 0 && t2 == 0);
                if (first || !__all(mx <= 8.0f)) {
                    const float delta = first ? mx : fmaxf(mx, 0.f);
                    if (!first) {
                        const float alpha = __builtin_amdgcn_exp2f(-delta);
                        lrun *= alpha;
#pragma unroll
                        for (int d = 0; d < 4; ++d)
#pragma unroll
                            for (int r = 0; r < 16; ++r) O[d][r] *= alpha;
                    }
                    mrun += delta;
#pragma unroll
                    for (int r = 0; r < 16; ++r) NM[r] = -mrun;
#pragma unroll
                    for (int kh = 0; kh < 2; ++kh)
#pragma unroll
                        for (int r = 0; r < 16; ++r) { S[t2][kh][r] -= delta; if (t2 == 0) S[1][kh][r] -= delta; }
                }
                float ls = 0.f;
#pragma unroll
                for (int kh = 0; kh < 2; ++kh)
#pragma unroll
                    for (int r = 0; r < 16; ++r) { const float pv = __builtin_amdgcn_exp2f(S[t2][kh][r]); S[t2][kh][r] = pv; ls += pv; }
                lrun += ls;
                bf16x8 pf[2][2];
#pragma unroll
                for (int kh = 0; kh < 2; ++kh)
#pragma unroll
                    for (int s2 = 0; s2 < 2; ++s2) pf[kh][s2] = pack_step(S[t2][kh], s2);
                ATT_LDV(f1, t2, 1);
                ATT_PV4(O[0], f0); ATT_LDV(f0, t2, 2);
                ATT_PV4(O[1], f1); ATT_LDV(f1, t2, 3);
                ATT_PV4(O[2], f0);
                ATT_PV4(O[3], f1);
                ATT_SG(0x100, 4); ATT_PIPE4; ATT_PIPE4; ATT_SG(0x008, 8);
            }
#undef ATT_LDK
#undef ATT_LDV
#undef ATT_QK4
#undef ATT_PV4
#undef ATT_SG
#undef ATT_PIPE4
            __syncthreads();
        }
        float ltot; { const auto rr = __builtin_amdgcn_permlane32_swap(__float_as_uint(lrun), __float_as_uint(lrun), false, false); ltot = __uint_as_float(rr[0]) + __uint_as_float(rr[1]); }
        const float inv = 1.0f / ltot;
#pragma unroll
        for (int d = 0; d < 4; ++d)
#pragma unroll
            for (int rq = 0; rq < 4; ++rq) {
                u32x2 w; w.x = pk_bf16(O[d][rq * 4 + 0] * inv, O[d][rq * 4 + 1] * inv); w.y = pk_bf16(O[d][rq * 4 + 2] * inv, O[d][rq * 4 + 3] * inv);
                *(u32x2*)(Og + d * 32 + 8 * rq + 4 * hh) = w;
            }
    }
    (void)grp;
#undef Qg
#undef Og
}

DI void p2b_conv(KA a, int bid, int nblk, int tid_in, int nostore) {
    int tid_ = tid_in; asm volatile("" : "+v"(tid_)); const int tid = tid_;
    bf16_t* XBC = (bf16_t*)(a.ws + G_XBC); const bf16_t* HALO = (const bf16_t*)(a.ws + G_HALO);
    const int cg = tid & 255, col = cg * 8;
    const float* cw = a.in[I_CONVW]; const float* cb = a.in[I_CONVB];
    float w0[8], w1[8], w2[8], bb[8];
#pragma unroll
    for (int i = 0; i < 8; ++i) { w0[i] = cw[col + i]; w1[i] = cw[2048 + col + i]; w2[i] = cw[4096 + col + i]; bb[i] = cb[col + i]; }
    for (int it = bid; it < GB * 36; it += nblk) {
        const int b = it / 36, blk = (it % 36) * 2 + (tid >> 8);
        const int pos0 = blk * 32;
        bf16_t* base = XBC + ((size_t)b * SALL + pos0) * 2048 + col;
        const bool first = (blk == 0 || blk == 8), last = (blk == 7 || blk == 71);
        u32x4 prev = (u32x4){0u, 0u, 0u, 0u}, nextblk = (u32x4){0u, 0u, 0u, 0u};
        if (!first) prev = *(const u32x4*)(HALO + (((size_t)b * 72 + blk - 1) * 2 + 1) * 2048 + col);
        if (!last) nextblk = *(const u32x4*)(HALO + (((size_t)b * 72 + blk + 1) * 2 + 0) * 2048 + col);
        u32x4 rows[32];
#pragma unroll
        for (int r = 0; r < 32; ++r) rows[r] = *(const u32x4*)(base + (size_t)r * 2048);
#pragma unroll
        for (int r = 0; r < 32; ++r) {
            const u32x4 pv = (r == 0) ? prev : rows[r - 1], cur = rows[r], nxt = (r < 31) ? rows[r + 1] : nextblk;
            const float p[8] = {bflo(pv.x), bfhi(pv.x), bflo(pv.y), bfhi(pv.y), bflo(pv.z), bfhi(pv.z), bflo(pv.w), bfhi(pv.w)};
            const float c[8] = {bflo(cur.x), bfhi(cur.x), bflo(cur.y), bfhi(cur.y), bflo(cur.z), bfhi(cur.z), bflo(cur.w), bfhi(cur.w)};
            const float n[8] = {bflo(nxt.x), bfhi(nxt.x), bflo(nxt.y), bfhi(nxt.y), bflo(nxt.z), bfhi(nxt.z), bflo(nxt.w), bfhi(nxt.w)};
            float v[8];
#pragma unroll
            for (int i = 0; i < 8; ++i) v[i] = siluf_(bb[i] + w0[i] * p[i] + w1[i] * c[i] + w2[i] * n[i]);
            u32x4 w; w.x = pk_bf16(v[0], v[1]); w.y = pk_bf16(v[2], v[3]); w.z = pk_bf16(v[4], v[5]); w.w = pk_bf16(v[6], v[7]);
            if (!nostore) *(u32x4*)(base + (size_t)r * 2048) = w; else asm volatile("" :: "v"(w.x), "v"(w.y), "v"(w.z), "v"(w.w));
        }
    }
}

constexpr int SS_BUF = 65536, SS_C = 0, SS_B = 16384, SS_X = 32768;
constexpr int SM_SET = 4352;
typedef short s16x4 __attribute__((ext_vector_type(4)));
DI int fsw(int r) { return ((r & 3) << 1) | ((r >> 2) & 1) | (r & 8); }
DI bf16x8 tr_frag(const LAS unsigned char* img, int rowb, int r0, int cblk, int lane) {
    const int i16 = lane & 15, q = i16 >> 2, p = i16 & 3;
    const int ra = r0 + q, rb = r0 + 4 + q, ch = (cblk >> 3) + (p >> 1);
    const s16x4 lo = __builtin_amdgcn_ds_read_tr16_b64_v4i16((LAS s16x4*)(img + ra * rowb + (((ch & 16) | ((ch & 15) ^ fsw(ra))) * 16) + 8 * (p & 1)));
    const s16x4 hi = __builtin_amdgcn_ds_read_tr16_b64_v4i16((LAS s16x4*)(img + rb * rowb + (((ch & 16) | ((ch & 15) ^ fsw(rb))) * 16) + 8 * (p & 1)));
    return __builtin_shufflevector(lo, hi, 0, 1, 2, 3, 4, 5, 6, 7);
}
DI void ssd_unit(KA a, LAS unsigned char* lds, int b, int g, int dir, int tid_in) {
    int tid = tid_in; asm volatile("" : "+v"(tid));
    const int wid = __builtin_amdgcn_readfirstlane(tid >> 6);
    const int hl = wid >> 1, pt = wid & 1, head = g * 4 + hl;
    const bf16_t* xa = (const bf16_t*)(a.ws + G_XBC) + (size_t)b * SALL * 2048;
    const float* dtp = (const float*)(a.ws + G_DT) + (size_t)b * SALL * 32;
    bf16_t* Ybase = (bf16_t*)(a.ws + (dir == 0 ? G_YF : G_YB)) + (size_t)b * SEQ * 1024 + head * 64 + pt * 32;
    const float dsk = (dir == 0) ? a.in[I_DSKIP][head] : 0.f;
    const float av = -__expf(a.in[I_ALOG][dir * 16 + g * 4 + (wid & 3)]);
#define SSD_GEOM(ci, seg0_, t0_) const int seg0_ = ((ci) < 4) ? 0 : CTXL; const int t0_ = (dir == 0) ? (((ci) < 4) ? (ci) : (ci) - 4) * 64 : (((ci) < 4) ? CTXL : SEQ) - 64 * ((((ci) < 4) ? (ci) : (ci) - 4) + 1)
    auto dma_chunk = [&](int ci, int k) {
        SSD_GEOM(ci, seg0, t0);
        const int lane = tid & 63;
#pragma unroll
        for (int q8 = 0; q8 < 8; ++q8) {
            const int q = wid * 8 + q8;
            int row, chp, colbase, imgoff;
            if (q < 32) { row = 4 * (q & 15) + (lane >> 4); chp = lane & 15; colbase = (q < 16) ? 1536 + g * 128 : 1024 + g * 128; imgoff = ((q < 16) ? SS_C : SS_B) + (q & 15) * 1024; }
            else { row = 2 * (q - 32) + (lane >> 5); chp = lane & 31; colbase = g * 256; imgoff = SS_X + (q - 32) * 1024; }
            const int ch = (chp & 16) | ((chp & 15) ^ fsw(row));
            const int tok = seg0 + ((dir == 0) ? t0 + row : t0 + 63 - row);
            __builtin_amdgcn_global_load_lds((const unsigned*)(xa + (size_t)tok * 2048 + colbase + ch * 8), (LAS unsigned*)(lds + k * SS_BUF + imgoff), 16, 0, 0);
        }
    };
    auto step_a = [&](int ci, int k, float dtv) {
        const int lane = tid & 63;
        LAS float* sm = (LAS float*)(lds + EPI_OFF + k * SM_SET);
        float v = dtv * av;
#pragma unroll
        for (int o = 1; o < 64; o <<= 1) { const float n = shidx(v, lane - o); if (lane >= o) v += n; }
        const float tot = shidx(v, 63);
        const int h4 = wid & 3;
        sm[h4 * 64 + lane] = v; sm[256 + h4 * 64 + lane] = dtv; sm[512 + h4 * 64 + lane] = __expf(tot - v) * dtv; sm[768 + h4 * 64 + lane] = __expf(v);
        if (lane == 63) sm[1024 + h4] = __expf(tot);
        (void)ci;
    };
    auto load_dt = [&](int ci) -> float {
        SSD_GEOM(ci, seg0, t0);
        const int lane = tid & 63;
        const int tok = seg0 + ((dir == 0) ? t0 + lane : t0 + 63 - lane);
        return dtp[(size_t)tok * 32 + dir * 16 + g * 4 + (wid & 3)];
    };
    f32x16 hT[4];
#pragma unroll
    for (int n = 0; n < 4; ++n)
#pragma unroll
        for (int r = 0; r < 16; ++r) hT[n][r] = 0.f;
    __syncthreads();
    dma_chunk(0, 0);
    if (wid < 4) step_a(0, 0, load_dt(0));
    __syncthreads();
#pragma unroll 1
    for (int ci = 0; ci < 36; ++ci) {
        const int k = ci & 1;
        const bool isctx = ci < 4;
        SSD_GEOM(ci, seg0_unused, t0); (void)seg0_unused;
        float dtn = 0.f;
        if (ci + 1 < 36) { dma_chunk(ci + 1, k ^ 1); if (wid < 4) dtn = load_dt(ci + 1); }
        int lo_ = tid & 63; asm volatile("" : "+v"(lo_));
        const int lane = lo_, l31 = lo_ & 31, hh = lo_ >> 5;
        const LAS unsigned char* Ci = lds + k * SS_BUF + SS_C; const LAS unsigned char* Bi = lds + k * SS_BUF + SS_B; const LAS unsigned char* Xi = lds + k * SS_BUF + SS_X;
        const LAS float* sm = (const LAS float*)(lds + EPI_OFF + k * SM_SET);
        const LAS float* sm_acum = sm + hl * 64; const LAS float* sm_dt = sm + 256 + hl * 64; const LAS float* sm_w = sm + 512 + hl * 64; const LAS float* sm_ea = sm + 768 + hl * 64;
        const int xcb = hl * 64 + pt * 32 + 16 * ((lane >> 4) & 1);
        if (!isctx) {
            f32x16 accs[2];
#pragma unroll
            for (int it = 0; it < 2; ++it)
#pragma unroll
                for (int r = 0; r < 16; ++r) accs[it][r] = 0.f;
#pragma unroll
            for (int nt = 0; nt < 4; ++nt)
#pragma unroll
                for (int s = 0; s < 2; ++s) {
                    const bf16x8 hb = pack_step(hT[nt], s);
                    const int c0 = nt * 4 + 2 * s;
#pragma unroll
                    for (int it = 0; it < 2; ++it) {
                        const int irow = it * 32 + l31;
                        const u32x2 f0 = *(const LAS u32x2*)(Ci + irow * 256 + ((c0 ^ fsw(irow)) * 16) + 8 * hh), f1 = *(const LAS u32x2*)(Ci + irow * 256 + (((c0 + 1) ^ fsw(irow)) * 16) + 8 * hh);
                        const u32x4 cfw = {f0.x, f0.y, f1.x, f1.y};
                        accs[it] = MFMA32(__builtin_bit_cast(bf16x8, cfw), hb, accs[it]);
                    }
                }
            __builtin_amdgcn_sched_barrier(0);
#pragma unroll
            for (int it = 0; it < 2; ++it) {
                f32x16 acc = accs[it];
                const int irow = it * 32 + l31;
#pragma unroll
                for (int a4 = 0; a4 < 4; ++a4) { const f32x4 e4 = *(const LAS f32x4*)(sm_ea + it * 32 + 8 * a4 + 4 * hh); acc[a4 * 4 + 0] *= e4[0]; acc[a4 * 4 + 1] *= e4[1]; acc[a4 * 4 + 2] *= e4[2]; acc[a4 * 4 + 3] *= e4[3]; }
                const float acum_i = sm_acum[irow];
                __builtin_amdgcn_sched_barrier(0);
#pragma unroll
                for (int jt = 0; jt <= it; ++jt) {
                    f32x16 cb;
#pragma unroll
                    for (int r = 0; r < 16; ++r) cb[r] = 0.f;
                    const int jrow = jt * 32 + l31;
#pragma unroll
                    for (int ks = 0; ks < 8; ++ks) {
                        const bf16x8 bf = *(const LAS bf16x8*)(Bi + jrow * 256 + (((2 * ks + hh) ^ fsw(jrow)) * 16));
                        const bf16x8 cf = *(const LAS bf16x8*)(Ci + irow * 256 + (((2 * ks + hh) ^ fsw(irow)) * 16));
                        cb = MFMA32(bf, cf, cb);
                    }
                    __builtin_amdgcn_sched_barrier(0);
#pragma unroll
                    for (int a4 = 0; a4 < 4; ++a4) {
                        const f32x4 aj = *(const LAS f32x4*)(sm_acum + jt * 32 + 8 * a4 + 4 * hh), dj = *(const LAS f32x4*)(sm_dt + jt * 32 + 8 * a4 + 4 * hh);
#pragma unroll
                        for (int b4 = 0; b4 < 4; ++b4) {
                            const float dec = __expf(fminf(acum_i - aj[b4], 0.f)) * dj[b4];
                            const int j = jt * 32 + 8 * a4 + 4 * hh + b4;
                            cb[a4 * 4 + b4] = (jt < it || j <= irow) ? cb[a4 * 4 + b4] * dec : 0.f;
                        }
                    }
#pragma unroll
                    for (int s = 0; s < 2; ++s) {
                        const int i16 = lane & 15, q = i16 >> 2, p = i16 & 3, ch = (xcb >> 3) + (p >> 1);
                        const int ra = jt * 32 + 16 * s + 4 * hh + q, rb = ra + 8;
                        const s16x4 lo = __builtin_amdgcn_ds_read_tr16_b64_v4i16((LAS s16x4*)(Xi + ra * 512 + (((ch & 16) | ((ch & 15) ^ fsw(ra))) * 16) + 8 * (p & 1)));
                        const s16x4 hi = __builtin_amdgcn_ds_read_tr16_b64_v4i16((LAS s16x4*)(Xi + rb * 512 + (((ch & 16) | ((ch & 15) ^ fsw(rb))) * 16) + 8 * (p & 1)));
                        acc = MFMA32(pack_step(cb, s), __builtin_shufflevector(lo, hi, 0, 1, 2, 3, 4, 5, 6, 7), acc);
                    }
                    __builtin_amdgcn_sched_barrier(0);
                }
                LAS unsigned char* yt = lds + YT_OFF + wid * 2048;
#pragma unroll
                for (int rq = 0; rq < 4; ++rq) {
                    const int i16 = lane & 15, q = i16 >> 2, p = i16 & 3, ch = (xcb >> 3) + (p >> 1);
                    const int ra = it * 32 + 8 * rq + 4 * hh + q;
                    const s16x4 xs = __builtin_amdgcn_ds_read_tr16_b64_v4i16((LAS s16x4*)(Xi + ra * 512 + (((ch & 16) | ((ch & 15) ^ fsw(ra))) * 16) + 8 * (p & 1)));
#pragma unroll
                    for (int j = 0; j < 4; ++j) *(LAS bf16_t*)(yt + (8 * rq + 4 * hh + j) * 64 + l31 * 2) = f2bf(acc[rq * 4 + j] + dsk * bf2f((bf16_t)xs[j]));
                }
                __builtin_amdgcn_sched_barrier(0);
#pragma unroll
                for (int q2 = 0; q2 < 2; ++q2) {
                    const int idx = q2 * 64 + lane, rw = idx >> 2, c4 = idx & 3;
                    const int i = it * 32 + rw, tnat = (dir == 0) ? t0 + i : t0 + 63 - i;
                    *(u32x4*)(Ybase + (size_t)tnat * 1024 + c4 * 8) = *(const LAS u32x4*)(yt + rw * 64 + c4 * 16);
                }
                __builtin_amdgcn_sched_barrier(0);
            }
        }
        {
            const float dec = sm[1024 + hl];
            bf16x8 wx[4];
#pragma unroll
            for (int ks = 0; ks < 4; ++ks) {
                const bf16x8 xf = tr_frag(Xi, 512, 16 * ks + 8 * hh, xcb, lane);
                const f32x4 wa = *(const LAS f32x4*)(sm_w + 16 * ks + 8 * hh), wb = *(const LAS f32x4*)(sm_w + 16 * ks + 8 * hh + 4);
                u32x4 o;
                o.x = pk_bf16(bf2f((bf16_t)xf[0]) * wa[0], bf2f((bf16_t)xf[1]) * wa[1]); o.y = pk_bf16(bf2f((bf16_t)xf[2]) * wa[2], bf2f((bf16_t)xf[3]) * wa[3]);
                o.z = pk_bf16(bf2f((bf16_t)xf[4]) * wb[0], bf2f((bf16_t)xf[5]) * wb[1]); o.w = pk_bf16(bf2f((bf16_t)xf[6]) * wb[2], bf2f((bf16_t)xf[7]) * wb[3]);
                wx[ks] = __builtin_bit_cast(bf16x8, o);
            }
            __builtin_amdgcn_sched_barrier(0);
#pragma unroll
            for (int nt = 0; nt < 4; ++nt) {
#pragma unroll
                for (int r = 0; r < 16; ++r) hT[nt][r] *= dec;
#pragma unroll
                for (int ks = 0; ks < 4; ++ks) {
                    const bf16x8 bt = tr_frag(Bi, 256, 16 * ks + 8 * hh, nt * 32 + 16 * ((lane >> 4) & 1), lane);
                    hT[nt] = MFMA32(bt, wx[ks], hT[nt]);
                }
                __builtin_amdgcn_sched_barrier(0);
            }
        }
        if (ci + 1 < 36 && wid < 4) step_a(ci + 1, k ^ 1, dtn);
        __syncthreads();
    }
#undef SSD_GEOM
}

DI void attn_finalize(KA a, int bid, int nblk, int tid_in) {
    int tid_ = tid_in; asm volatile("" : "+v"(tid_)); const int tid = tid_, wid = tid >> 6, lane = tid & 63;
    bf16_t* O0 = (bf16_t*)(a.ws + G_O); const bf16_t* O1 = (const bf16_t*)(a.ws + G_O1);
    float lam;
    { const float p1 = wave_sum(a.in[I_LQ1][lane] * a.in[I_LK1][lane], lane), p2 = wave_sum(a.in[I_LQ2][lane] * a.in[I_LK2][lane], lane); lam = __expf(p1) - __expf(p2) + LAM_INIT; }
    const float* gs = a.in[I_GSUB] + (lane & 7) * 16;
    float g[16];
#pragma unroll
    for (int i = 0; i < 16; ++i) g[i] = gs[i] * (1.0f - LAM_INIT);
    for (int row = bid * 8 + wid; row < TG; row += nblk * 8) {
        const size_t off = (size_t)row * 1024 + lane * 16;
        const u32x4 a0 = *(const u32x4*)(O0 + off), a1 = *(const u32x4*)(O0 + off + 8), b0 = *(const u32x4*)(O1 + off), b1 = *(const u32x4*)(O1 + off + 8);
        const unsigned aw[8] = {a0.x, a0.y, a0.z, a0.w, a1.x, a1.y, a1.z, a1.w}, bw[8] = {b0.x, b0.y, b0.z, b0.w, b1.x, b1.y, b1.z, b1.w};
        float o[16]; float ss = 0.f;
#pragma unroll
        for (int i = 0; i < 8; ++i) { o[2 * i] = bflo(aw[i]) - lam * bflo(bw[i]); o[2 * i + 1] = bfhi(aw[i]) - lam * bfhi(bw[i]); ss += o[2 * i] * o[2 * i] + o[2 * i + 1] * o[2 * i + 1]; }
        ss += shx(ss, 1, lane); ss += shx(ss, 2, lane); ss += shx(ss, 4, lane);
        const float rs = rsqrtf(ss * (1.0f / 128.0f) + EPS);
        u32x4 w0, w1;
        w0.x = pk_bf16(o[0] * rs * g[0], o[1] * rs * g[1]); w0.y = pk_bf16(o[2] * rs * g[2], o[3] * rs * g[3]); w0.z = pk_bf16(o[4] * rs * g[4], o[5] * rs * g[5]); w0.w = pk_bf16(o[6] * rs * g[6], o[7] * rs * g[7]);
        w1.x = pk_bf16(o[8] * rs * g[8], o[9] * rs * g[9]); w1.y = pk_bf16(o[10] * rs * g[10], o[11] * rs * g[11]); w1.z = pk_bf16(o[12] * rs * g[12], o[13] * rs * g[13]); w1.w = pk_bf16(o[14] * rs * g[14], o[15] * rs * g[15]);
        *(u32x4*)(O0 + off) = w0; *(u32x4*)(O0 + off + 8) = w1;
    }
}

struct SchedPlain {
    const bf16_t* A; const bf16_t* Bt; int nM, nN, K, G, c;
    DI bool next(int i, pg::Unit& u) const {
        const int L = i * G + c; if (L >= nM * nN) return false;
        pg::decode_tiles(L, nM, nN, u.pm, u.pn); u.kind = 0; u.aux = 0; return true;
    }
    static constexpr bool GATHER = false; static constexpr bool AUX = false;
    DI const char* a_tile(const pg::Unit& u) const { return (const char*)(A + (size_t)u.pm * 256 * K); }
    DI int a_row(const pg::Unit&, int) const { return 0; }
    DI const char* b_base(const pg::Unit& u) const { return (const char*)(Bt + (size_t)u.pn * 256 * K); }
};
struct EpiZG {
    const bf16_t* YF; const bf16_t* YB; bf16_t* YN; bf16_t* Gt; const float* gnorm; LAS float* scr;
    DI void operator()(const f32x4 (&acc)[2][2][4][2], const pg::Unit& u, int wr, int wc, int fr, int fq, int lane) const {
        const int rl = wr * 64 + fr, cl = wc * 32 + 8 * fq;
        const size_t row0 = (size_t)(u.pm * 256 + rl);
        if (u.pn >= 4) {
            bf16_t* gb = Gt + row0 * 2048 + (u.pn - 4) * 256 + cl;
#pragma unroll
            for (int ai = 0; ai < 2; ++ai)
#pragma unroll
                for (int m = 0; m < 4; ++m)
#pragma unroll
                    for (int bj = 0; bj < 2; ++bj) {
                        f32x4 s0, s1;
#pragma unroll
                        for (int i = 0; i < 4; ++i) { s0[i] = sigmoidf_(acc[ai][bj][m][0][i]); s1[i] = sigmoidf_(acc[ai][bj][m][1][i]); }
                        *(u32x4*)(gb + (size_t)(ai * 128 + m * 16) * 2048 + bj * 128) = pg::pack8(s0, s1);
                    }
            return;
        }
        const bf16_t* yfb = YF + row0 * 1024 + u.pn * 256 + cl; const bf16_t* ybb = YB + row0 * 1024 + u.pn * 256 + cl;
        u32x4 yp[2][4][2];
#pragma unroll
        for (int ai = 0; ai < 2; ++ai)
#pragma unroll
            for (int mh = 0; mh < 2; ++mh) {
                u32x4 fw[2][2], bw[2][2];
#pragma unroll
                for (int mm = 0; mm < 2; ++mm)
#pragma unroll
                    for (int bj = 0; bj < 2; ++bj) { const size_t o = (size_t)(ai * 128 + (mh * 2 + mm) * 16) * 1024 + bj * 128; fw[mm][bj] = *(const u32x4*)(yfb + o); bw[mm][bj] = *(const u32x4*)(ybb + o); }
#pragma unroll
                for (int mm = 0; mm < 2; ++mm) {
                    const int m = mh * 2 + mm; float ss = 0.f;
#pragma unroll
                    for (int bj = 0; bj < 2; ++bj) {
                        const u32x4 f = fw[mm][bj], b2 = bw[mm][bj];
                        const float yv[8] = {bflo(f.x) + bflo(b2.x), bfhi(f.x) + bfhi(b2.x), bflo(f.y) + bflo(b2.y), bfhi(f.y) + bfhi(b2.y),
                                             bflo(f.z) + bflo(b2.z), bfhi(f.z) + bfhi(b2.z), bflo(f.w) + bflo(b2.w), bfhi(f.w) + bfhi(b2.w)};
                        float y[8];
#pragma unroll
                        for (int n = 0; n < 2; ++n)
#pragma unroll
                            for (int i = 0; i < 4; ++i) { const float z = acc[ai][bj][m][n][i]; y[n * 4 + i] = yv[n * 4 + i] * siluf_(z); ss += y[n * 4 + i] * y[n * 4 + i]; }
                        u32x4 w; w.x = pk_bf16(y[0], y[1]); w.y = pk_bf16(y[2], y[3]); w.z = pk_bf16(y[4], y[5]); w.w = pk_bf16(y[6], y[7]);
                        asm volatile("" : "+v"(w.x), "+v"(w.y), "+v"(w.z), "+v"(w.w));
                        yp[ai][m][bj] = w;
                    }
                    ss += shx(ss, 16, lane); ss += shx(ss, 32, lane);
                    if (fq == 0) scr[(ai * 128 + m * 16 + rl) * 4 + wc] = ss;
                }
                asm volatile("" ::: "memory");
            }
        asm volatile("s_waitcnt lgkmcnt(0)" ::: "memory"); __builtin_amdgcn_s_barrier(); asm volatile("" ::: "memory");
        bf16_t* ynb = YN + row0 * 1024 + u.pn * 256 + cl;
        f32x4 g0[2], g1[2];
#pragma unroll
        for (int bj = 0; bj < 2; ++bj) { g0[bj] = *(const f32x4*)(gnorm + u.pn * 256 + bj * 128 + cl); g1[bj] = *(const f32x4*)(gnorm + u.pn * 256 + bj * 128 + cl + 4); }
#pragma unroll
        for (int ai = 0; ai < 2; ++ai)
#pragma unroll
            for (int m = 0; m < 4; ++m) {
                const f32x4 ps = *(const LAS f32x4*)(scr + (ai * 128 + m * 16 + rl) * 4);
                const float rs = rsqrtf((ps[0] + ps[1] + ps[2] + ps[3]) * (1.0f / 256.0f) + EPS);
#pragma unroll
                for (int bj = 0; bj < 2; ++bj) {
                    const u32x4 w = yp[ai][m][bj];
                    const f32x4 y0 = {bflo(w.x), bfhi(w.x), bflo(w.y), bfhi(w.y)}, y1 = {bflo(w.z), bfhi(w.z), bflo(w.w), bfhi(w.w)};
                    *(u32x4*)(ynb + (size_t)(ai * 128 + m * 16) * 1024 + bj * 128) = pg::pack8(y0 * rs * g0[bj], y1 * rs * g1[bj]);
                }
            }
        asm volatile("s_waitcnt lgkmcnt(0)" ::: "memory"); __builtin_amdgcn_s_barrier(); asm volatile("" ::: "memory");
    }
};
struct EpiBranchA {
    const bf16_t* Gt; bf16_t* P;
    DI void operator()(const f32x4 (&acc)[2][2][4][2], const pg::Unit& u, int wr, int wc, int fr, int fq, int) const {
        pg::for_each8(acc, wr, wc, fr, fq, [&](int r, int c, const f32x4& v0, const f32x4& v1) {
            const int R = u.pm * 256 + r, col = u.pn * 256 + c;
            const u32x4 gw = *(const u32x4*)(Gt + (size_t)R * 2048 + col);
            const f32x4 g0 = {bflo(gw.x), bfhi(gw.x), bflo(gw.y), bfhi(gw.y)}, g1 = {bflo(gw.z), bfhi(gw.z), bflo(gw.w), bfhi(gw.w)};
            *(u32x4*)(P + (size_t)R * 1024 + col) = pg::pack8(v0 * g0, v1 * g1);
        });
    }
};
struct EpiBranchS {
    const bf16_t* Gt; const bf16_t* P; bf16_t* U;
    DI void operator()(const f32x4 (&acc)[2][2][4][2], const pg::Unit& u, int wr, int wc, int fr, int fq, int) const {
        pg::for_each8(acc, wr, wc, fr, fq, [&](int r, int c, const f32x4& v0, const f32x4& v1) {
            const int R = u.pm * 256 + r, col = u.pn * 256 + c;
            const u32x4 gw = *(const u32x4*)(Gt + (size_t)R * 2048 + 1024 + col), pw = *(const u32x4*)(P + (size_t)R * 1024 + col);
            const f32x4 g0 = {bflo(gw.x), bfhi(gw.x), bflo(gw.y), bfhi(gw.y)}, g1 = {bflo(gw.z), bfhi(gw.z), bflo(gw.w), bfhi(gw.w)};
            const f32x4 p0 = {bflo(pw.x), bfhi(pw.x), bflo(pw.y), bfhi(pw.y)}, p1 = {bflo(pw.z), bfhi(pw.z), bflo(pw.w), bfhi(pw.w)};
            *(u32x4*)(U + (size_t)R * 1024 + col) = pg::pack8(p0 + v0 * g0, p1 + v1 * g1);
        });
    }
};
struct SchedBranches {
    const bf16_t* O; const bf16_t* YN; const bf16_t* Wa; const bf16_t* Ws; int G, c;
    static constexpr bool GATHER = false; static constexpr bool AUX = false;
    DI bool next(int i, pg::Unit& u) const {
        const int L = i * G + c; if (i >= 2 || c >= (TG / 256) * 4) return false;
        pg::decode_tiles(c, TG / 256, 4, u.pm, u.pn); u.kind = i; u.aux = 0; (void)L; return true;
    }
    DI const char* a_tile(const pg::Unit& u) const { const long d = (const char*)YN - (const char*)O; return (const char*)O + (u.kind ? d : 0L) + (size_t)u.pm * 256 * 1024 * 2; }
    DI int a_row(const pg::Unit&, int) const { return 0; }
    DI const char* b_base(const pg::Unit& u) const { const long d = (const char*)Ws - (const char*)Wa; return (const char*)Wa + (u.kind ? d : 0L) + (size_t)u.pn * 256 * 1024 * 2; }
};
struct EpiBranches {
    const bf16_t* Gt; bf16_t* P; bf16_t* U;
    DI void operator()(const f32x4 (&acc)[2][2][4][2], const pg::Unit& u, int wr, int wc, int fr, int fq, int) const {
        const size_t row0 = (size_t)(u.pm * 256 + wr * 64 + fr); const int col0 = u.pn * 256 + wc * 32 + 8 * fq;
        const bf16_t* gb = Gt + row0 * 2048 + (u.kind == 0 ? 0 : 1024) + col0;
        bf16_t* pb = P + row0 * 1024 + col0; bf16_t* ub = U + row0 * 1024 + col0;
#pragma unroll
        for (int ai = 0; ai < 2; ++ai) {
            u32x4 gw[4][2], pw[4][2];
#pragma unroll
            for (int m = 0; m < 4; ++m)
#pragma unroll
                for (int bj = 0; bj < 2; ++bj) {
                    gw[m][bj] = *(const u32x4*)(gb + (size_t)(ai * 128 + m * 16) * 2048 + bj * 128);
                    if (u.kind != 0) pw[m][bj] = *(const u32x4*)(pb + (size_t)(ai * 128 + m * 16) * 1024 + bj * 128);
                }
#pragma unroll
            for (int m = 0; m < 4; ++m)
#pragma unroll
                for (int bj = 0; bj < 2; ++bj) {
                    const u32x4 g = gw[m][bj];
                    const f32x4 g0 = {bflo(g.x), bfhi(g.x), bflo(g.y), bfhi(g.y)}, g1 = {bflo(g.z), bfhi(g.z), bflo(g.w), bfhi(g.w)};
                    if (u.kind == 0) *(u32x4*)(pb + (size_t)(ai * 128 + m * 16) * 1024 + bj * 128) = pg::pack8(acc[ai][bj][m][0] * g0, acc[ai][bj][m][1] * g1);
                    else {
                        const u32x4 q = pw[m][bj];
                        const f32x4 p0 = {bflo(q.x), bfhi(q.x), bflo(q.y), bfhi(q.y)}, p1 = {bflo(q.z), bfhi(q.z), bflo(q.w), bfhi(q.w)};
                        *(u32x4*)(ub + (size_t)(ai * 128 + m * 16) * 1024 + bj * 128) = pg::pack8(p0 + acc[ai][bj][m][0] * g0, p1 + acc[ai][bj][m][1] * g1);
                    }
                }
            asm volatile("" ::: "memory");
        }
    }
};
struct EpiPlainBf16 {
    bf16_t* O; int ldc;
    DI void operator()(const f32x4 (&acc)[2][2][4][2], const pg::Unit& u, int wr, int wc, int fr, int fq, int) const {
        bf16_t* base = O + (size_t)(u.pm * 256 + wr * 64 + fr) * ldc + u.pn * 256 + wc * 32 + 8 * fq;
#pragma unroll
        for (int ai = 0; ai < 2; ++ai)
#pragma unroll
            for (int m = 0; m < 4; ++m)
#pragma unroll
                for (int bj = 0; bj < 2; ++bj) *(u32x4*)(base + (size_t)(ai * 128 + m * 16) * ldc + bj * 128) = pg::pack8(acc[ai][bj][m][0], acc[ai][bj][m][1]);
    }
};

DI void p8_post(KA a, int grp, int bid, int nblk, int tid_in) {
    int tid_ = tid_in; asm volatile("" : "+v"(tid_)); const int tid = tid_, wid = tid >> 6, lane = tid & 63;
    const bf16_t* MIX = (const bf16_t*)(a.ws + G_MIX); bf16_t* H2 = (bf16_t*)(a.ws + G_H2);
    const float* MOD = (const float*)(a.ws + WS_MOD);
    const float* g1 = a.in[I_GPOST1]; const float* g2 = a.in[I_GPRE2];
    const int stride = nblk * 8;
    for (int row0 = bid * 8 + wid; row0 < TG; row0 += 2 * stride) {
        f32x4 mvv[2][4], xvv[2][4];
#pragma unroll
        for (int j = 0; j < 2; ++j) {
            const int row = min(row0 + j * stride, TG - 1), grow = grp * TG + row;
            const float* xs = a.in[I_X] + (size_t)grow * 1024; const bf16_t* ms = MIX + (size_t)row * 1024;
#pragma unroll
            for (int i = 0; i < 4; ++i) { const u32x2 mw = *(const u32x2*)(ms + i * 256 + lane * 4); mvv[j][i] = (f32x4){bflo(mw.x), bfhi(mw.x), bflo(mw.y), bfhi(mw.y)}; xvv[j][i] = __builtin_nontemporal_load((const f32x4*)(xs + i * 256 + lane * 4)); }
        }
#pragma unroll
        for (int j = 0; j < 2; ++j) {
            const int row = row0 + j * stride;
            if (row >= TG) break;
            const int grow = grp * TG + row; const float* md = MOD + (grow >> 11) * 6144; bf16_t* od = (bf16_t*)(a.ws + G_X1) + (size_t)row * 1024;
            float ss = 0.f;
#pragma unroll
            for (int i = 0; i < 4; ++i) ss += mvv[j][i][0] * mvv[j][i][0] + mvv[j][i][1] * mvv[j][i][1] + mvv[j][i][2] * mvv[j][i][2] + mvv[j][i][3] * mvv[j][i][3];
            ss = wave_sum(ss, lane);
            const float rs = rsqrtf(ss * (1.0f / 1024.0f) + EPS);
            float s2 = 0.f;
#pragma unroll
            for (int i = 0; i < 4; ++i) {
                const int c = i * 256 + lane * 4;
                const f32x4 gg = *(const f32x4*)(g1 + c), gt = *(const f32x4*)(md + 2048 + c);
                xvv[j][i] = xvv[j][i] + gt * (mvv[j][i] * rs * gg);
                { u32x2 w; w.x = pk_bf16(xvv[j][i][0], xvv[j][i][1]); w.y = pk_bf16(xvv[j][i][2], xvv[j][i][3]); *(u32x2*)(od + c) = w; }
                s2 += xvv[j][i][0] * xvv[j][i][0] + xvv[j][i][1] * xvv[j][i][1] + xvv[j][i][2] * xvv[j][i][2] + xvv[j][i][3] * xvv[j][i][3];
            }
            s2 = wave_sum(s2, lane);
            const float rs2 = rsqrtf(s2 * (1.0f / 1024.0f) + EPS);
#pragma unroll
            for (int i = 0; i < 4; ++i) {
                const int c = i * 256 + lane * 4;
                const f32x4 gg = *(const f32x4*)(g2 + c), sh = *(const f32x4*)(md + 3072 + c), sc = *(const f32x4*)(md + 4096 + c);
                const f32x4 y = xvv[j][i] * rs2 * gg * (sc + 1.0f) + sh;
                u32x2 w; w.x = pk_bf16(y[0], y[1]); w.y = pk_bf16(y[2], y[3]);
                *(u32x2*)(H2 + (size_t)row * 1024 + c) = w;
            }
        }
    }
}

struct EpiQ1 {
    bf16_t* HID; float* LOG;
    DI void operator()(const f32x4 (&acc)[2][2][4][2], const pg::Unit& u, int wr, int wc, int fr, int fq, int) const {
        if (u.pn == 2) {
            pg::for_each8(acc, wr, wc, fr, fq, [&](int r, int c, const f32x4& v0, const f32x4& v1) {
                if (c >= 64) return;
                float* o = LOG + (size_t)(u.pm * 256 + r) * 64 + c; *(f32x4*)o = v0; *(f32x4*)(o + 4) = v1;
            });
            return;
        }
#pragma unroll
        for (int ai = 0; ai < 2; ++ai)
#pragma unroll
            for (int m = 0; m < 4; ++m) {
                f32x4 h0, h1;
#pragma unroll
                for (int i = 0; i < 4; ++i) { h0[i] = siluf_(acc[ai][0][m][0][i]) * acc[ai][1][m][0][i]; h1[i] = siluf_(acc[ai][0][m][1][i]) * acc[ai][1][m][1][i]; }
                *(u32x4*)(HID + (size_t)(u.pm * 256 + wr * 64 + fr) * 256 + u.pn * 128 + wc * 32 + 8 * fq + (size_t)(ai * 128 + m * 16) * 256) = pg::pack8(h0, h1);
            }
    }
};
DI void q2_route(KA a, LAS unsigned char* lds, int bid, int nblk, int tid_in) {
    int tid_ = tid_in; asm volatile("" : "+v"(tid_)); const int tid = tid_, wid = tid >> 6, lane = tid & 63;
    const float* LOG = (const float*)(a.ws + M_LOG); int* TOPE = (int*)(a.ws + M_TOPE); float* TOPW = (float*)(a.ws + M_TOPW); int* TPOS = (int*)(a.ws + M_TPOS);
    int* BCNT = (int*)(a.ws + M_BCNT);
    LAS int* hist = (LAS int*)lds;
    if (tid < NQ * NEXP) hist[tid] = 0;
    __syncthreads();
    const float bias = a.in[I_RB][lane];
    for (int t = bid * 8 + wid; t < TG; t += nblk * 8) {
        const int qq = t / QT;
        const float score = sigmoidf_(LOG[(size_t)t * 64 + lane]);
        const float sel = score + bias;
        float m1 = sel;
        m1 = fmaxf(m1, shx(m1, 1, lane)); m1 = fmaxf(m1, shx(m1, 2, lane)); m1 = fmaxf(m1, shx(m1, 4, lane));
        int i1 = (sel == m1) ? lane : 64;
        i1 = min(i1, shxi(i1, 1, lane)); i1 = min(i1, shxi(i1, 2, lane)); i1 = min(i1, shxi(i1, 4, lane));
        float m2 = (lane == i1) ? -INFINITY : sel;
        m2 = fmaxf(m2, shx(m2, 1, lane)); m2 = fmaxf(m2, shx(m2, 2, lane)); m2 = fmaxf(m2, shx(m2, 4, lane));
        const float gs = m1 + m2; const int myg = lane >> 3;
        int grank = 0;
#pragma unroll
        for (int g2 = 0; g2 < 8; ++g2) { const float o = __int_as_float(__builtin_amdgcn_readlane(__float_as_int(gs), g2 * 8)); grank += (o > gs || (o == gs && g2 < myg)) ? 1 : 0; }
        const float v = (grank < 4) ? sel : -INFINITY;
        int rank = 0;
#pragma unroll 4
        for (int e2 = 0; e2 < 64; ++e2) { const float o = __int_as_float(__builtin_amdgcn_readlane(__float_as_int(v), e2)); rank += (o > v || (o == v && e2 < lane)) ? 1 : 0; }
        const bool chosen = (rank < 8) && (grank < 4);
        const float wsum = wave_sum(chosen ? score : 0.f, lane);
        if (chosen) {
            const int pos = __hip_atomic_fetch_add(&hist[qq * NEXP + lane], 1, __ATOMIC_RELAXED, __HIP_MEMORY_SCOPE_WORKGROUP);
            TOPE[t * 8 + rank] = lane; TOPW[t * 8 + rank] = score / wsum * 2.5f; TPOS[t * 8 + rank] = pos;
        }
    }
    __syncthreads();
    if (tid < NQ * NEXP) BCNT[((tid >> 6) * 1024 + bid) * NEXP + (tid & 63)] = hist[tid];
}
DI void q3_scatter(KA a, LAS unsigned char* lds, int bid, int nblk, int tid_in) {
    int tid_ = tid_in; asm volatile("" : "+v"(tid_)); const int tid = tid_, wid = tid >> 6, lane = tid & 63;
    LAS int* tot = (LAS int*)lds; LAS int* base = tot + NQ * 64; LAS int* offs = base + NQ * 64;
    const int* BCNT = (const int*)(a.ws + M_BCNT);
    {
        const int ce = tid & 127, part = tid >> 7, qq = ce >> 6, e = ce & 63;
        int t_ = 0, p_ = 0;
        const int b0 = part * ((nblk + 3) >> 2), b1 = min(nblk, b0 + ((nblk + 3) >> 2));
#pragma unroll 8
        for (int b = b0; b < b1; ++b) { const int c = BCNT[(qq * 1024 + b) * NEXP + e]; t_ += c; p_ += (b < bid) ? c : 0; }
        LAS int* part_t = offs + NQ * 128; LAS int* part_p = part_t + 512;
        part_t[tid] = t_; part_p[tid] = p_;
        __syncthreads();
        if (tid < NQ * NEXP) { tot[tid] = part_t[tid] + part_t[tid + 128] + part_t[tid + 256] + part_t[tid + 384]; base[tid] = part_p[tid] + part_p[tid + 128] + part_p[tid + 256] + part_p[tid + 384]; }
    }
    __syncthreads();
    if (tid < NQ) { int o = 0; for (int e = 0; e < NEXP; ++e) { offs[tid * 128 + e] = o; o += (tot[tid * 64 + e] + 255) & ~255; } offs[tid * 128 + 64] = o; offs[tid * 128 + 65] = o >> 8; }
    __syncthreads();
    if (tid < NQ * NEXP) base[tid] += offs[(tid >> 6) * 128 + (tid & 63)];
    if (bid == 0 && tid < NQ * 128) ((int*)(a.ws + M_OFFS))[tid] = ((tid & 127) < 66) ? offs[tid] : 0;
    if (bid == 0 && tid < NQ * NEXP) { const int qq = tid >> 6, e = tid & 63; int* TILE = (int*)(a.ws + M_TILE) + qq * 1024; for (int tt = offs[qq * 128 + e] >> 8; tt < (offs[qq * 128 + e + 1] >> 8); ++tt) TILE[tt] = e; }
    __syncthreads();
    const int* TOPE = (const int*)(a.ws + M_TOPE); const int* TPOS = (const int*)(a.ws + M_TPOS); int* ROWL = (int*)(a.ws + M_ROWL);
    const float* TOPW = (const float*)(a.ws + M_TOPW); float* ROWW = (float*)(a.ws + M_ROWW);
    for (int t = bid * 8 + wid; t < TG; t += nblk * 8)
        if (lane < 8) { const int qq = t / QT, idx = t * 8 + lane; const size_t rp = (size_t)qq * MAXROWS + base[qq * 64 + TOPE[idx]] + TPOS[idx]; ROWL[rp] = idx - qq * QT * 8; ROWW[rp] = TOPW[idx]; }
    for (int idx = bid * NT + tid; idx < NQ * NEXP * 256; idx += nblk * NT) {
        const int qq = idx >> 14, e = (idx >> 8) & 63, k = idx & 255, c = tot[qq * 64 + e], pad = ((c + 255) & ~255) - c;
        if (k < pad) ROWL[(size_t)qq * MAXROWS + offs[qq * 128 + e] + c + k] = -1;
    }
    __syncthreads();
}
DI void moe_offsets(KA a, LAS int* offs, int tid) {
    if (tid < NQ * 128) offs[tid] = ((const int*)(a.ws + M_OFFS))[tid];
    __syncthreads();
}
struct SchedQ4 {
    const bf16_t* H2; const bf16_t* W1; const int* ROWL; const LAS int* offs; const int* TILE; int G, c;
    static constexpr bool GATHER = true; static constexpr bool AUX = false;
    DI bool next(int i, pg::Unit& u) const {
        const int L = i * G + c; const int t0 = __builtin_amdgcn_readfirstlane(offs[65]), t1 = (NQ > 1) ? __builtin_amdgcn_readfirstlane(offs[(NQ > 1 ? 128 : 0) + 65]) : 0; if (L >= (t0 + t1) * 2) return false;
        pg::decode_tiles(L, t0 + t1, 2, u.pm, u.pn);
        const int qq = (u.pm >= t0) ? 1 : 0; u.pm -= qq * t0;
        u.kind = qq; u.aux = __builtin_amdgcn_readfirstlane(TILE[qq * 1024 + u.pm]); return true;
    }
    DI const char* a_tile(const pg::Unit& u) const { return (const char*)(H2 + (size_t)u.kind * QT * 1024); }
    DI int a_row(const pg::Unit& u, int r) const { const int id = ROWL[(size_t)u.kind * MAXROWS + u.pm * 256 + r]; return id < 0 ? 0 : (id >> 3); }
    DI const char* b_base(const pg::Unit& u) const { return (const char*)(W1 + ((size_t)u.aux * 512 + u.pn * 256) * 1024); }
};
struct EpiQ4 {
    bf16_t* HID;
    DI void operator()(const f32x4 (&acc)[2][2][4][2], const pg::Unit& u, int wr, int wc, int fr, int fq, int) const {
        bf16_t* base = HID + ((size_t)u.kind * MAXROWS + u.pm * 256 + wr * 64 + fr) * 256 + u.pn * 128 + wc * 32 + 8 * fq;
#pragma unroll
        for (int ai = 0; ai < 2; ++ai)
#pragma unroll
            for (int m = 0; m < 4; ++m) {
                f32x4 h0, h1;
#pragma unroll
                for (int i = 0; i < 4; ++i) { h0[i] = siluf_(acc[ai][0][m][0][i]) * acc[ai][1][m][0][i]; h1[i] = siluf_(acc[ai][0][m][1][i]) * acc[ai][1][m][1][i]; }
                *(u32x4*)(base + (size_t)(ai * 128 + m * 16) * 256) = pg::pack8(h0, h1);
            }
    }
};
struct SchedQ5 {
    const bf16_t* HID; const bf16_t* HIDS; const bf16_t* W2; const LAS int* offs; const int* TILE; int G, c;
    static constexpr bool GATHER = false; static constexpr bool AUX = false;
    DI bool next(int i, pg::Unit& u) const {
        const int L = i * G + c; const int ne = __builtin_amdgcn_readfirstlane(offs[65]) * 4; if (L >= ne + (QT / 256) * 4) return false;
        if (L < ne) { pg::decode_tiles(L, ne >> 2, 4, u.pm, u.pn); u.kind = 0; u.aux = __builtin_amdgcn_readfirstlane(TILE[u.pm]); }
        else { pg::decode_tiles(L - ne, QT / 256, 4, u.pm, u.pn); u.kind = 1; u.aux = NEXP; }
        return true;
    }
    DI const char* a_tile(const pg::Unit& u) const { const long d = (const char*)HIDS - (const char*)HID; return (const char*)HID + (u.kind ? d : 0L) + (size_t)u.pm * 256 * 256 * 2; }
    DI int a_row(const pg::Unit&, int) const { return 0; }
    DI const char* b_base(const pg::Unit& u) const { return (const char*)(W2 + ((size_t)u.aux * 1024 + u.pn * 256) * 256); }
};
struct EpiQ5 {
    const int* ROWL; const float* ROWW; unsigned char* AOUT; bf16_t* SOUT;
    DI void operator()(const f32x4 (&acc)[2][2][4][2], const pg::Unit& u, int wr, int wc, int fr, int fq, int) const {
        if (u.kind == 1) {
            bf16_t* base = SOUT + (size_t)(u.pm * 256 + wr * 64 + fr) * 1024 + u.pn * 256 + wc * 32 + 8 * fq;
#pragma unroll
            for (int ai = 0; ai < 2; ++ai)
#pragma unroll
                for (int m = 0; m < 4; ++m)
#pragma unroll
                    for (int bj = 0; bj < 2; ++bj) *(u32x4*)(base + (size_t)(ai * 128 + m * 16) * 1024 + bj * 128) = pg::pack8(acc[ai][bj][m][0], acc[ai][bj][m][1]);
            return;
        }
        int ids[8]; float wts[8];
#pragma unroll
        for (int k = 0; k < 8; ++k) ids[k] = ROWL[u.pm * 256 + (k >> 2) * 128 + wr * 64 + (k & 3) * 16 + fr];
#pragma unroll
        for (int k = 0; k < 8; ++k) wts[k] = ROWW[u.pm * 256 + (k >> 2) * 128 + wr * 64 + (k & 3) * 16 + fr];
#pragma unroll
        for (int ai = 0; ai < 2; ++ai)
#pragma unroll
            for (int m = 0; m < 4; ++m) {
                const int id = ids[ai * 4 + m]; const float w = wts[ai * 4 + m];
                if (id >= 0) {
                    u32x4 pk;
                    { const f32x4 v0 = acc[ai][0][m][0] * w, v1 = acc[ai][0][m][1] * w;
                      int lo = __builtin_amdgcn_cvt_pk_fp8_f32(v0[0], v0[1], 0, false); lo = __builtin_amdgcn_cvt_pk_fp8_f32(v0[2], v0[3], lo, true);
                      int hi2 = __builtin_amdgcn_cvt_pk_fp8_f32(v1[0], v1[1], 0, false); hi2 = __builtin_amdgcn_cvt_pk_fp8_f32(v1[2], v1[3], hi2, true);
                      pk.x = (unsigned)lo; pk.y = (unsigned)hi2; }
                    { const f32x4 v0 = acc[ai][1][m][0] * w, v1 = acc[ai][1][m][1] * w;
                      int lo = __builtin_amdgcn_cvt_pk_fp8_f32(v0[0], v0[1], 0, false); lo = __builtin_amdgcn_cvt_pk_fp8_f32(v0[2], v0[3], lo, true);
                      int hi2 = __builtin_amdgcn_cvt_pk_fp8_f32(v1[0], v1[1], 0, false); hi2 = __builtin_amdgcn_cvt_pk_fp8_f32(v1[2], v1[3], hi2, true);
                      pk.z = (unsigned)lo; pk.w = (unsigned)hi2; }
                    *(u32x4*)(AOUT + (size_t)id * 1024 + u.pn * 256 + wc * 64 + fq * 16) = pk;
                }
            }
    }
};
DI void q6_combine(KA a, int grp, int qi, int bid, int nblk, int tid_in, int nostore) {
    int tid_ = tid_in; asm volatile("" : "+v"(tid_)); const int tid = tid_, wid = tid >> 6, lane = tid & 63;
    const unsigned char* AOUT = (const unsigned char*)(a.ws + M_AOUT); const bf16_t* SOUT = (const bf16_t*)(a.ws + M_SOUT);
    const float* MOD = (const float*)(a.ws + WS_MOD); const float* g = a.in[I_GPOST2];
    for (int t = bid * 8 + wid; t < QT; t += nblk * 8) {
        const int grow = grp * TG + qi * QT + t; const float* md = MOD + (grow >> 11) * 6144; float* od = a.out + (size_t)grow * 1024;
        const bf16_t* x1p = (const bf16_t*)(a.ws + G_X1) + (size_t)(qi * QT + t) * 1024;
        const int cl = (lane >> 5) * 256 + (lane & 1) * 128 + ((lane >> 3) & 3) * 32 + ((lane >> 1) & 3) * 8;
        const u32x4 x1w0 = __builtin_nontemporal_load((const u32x4*)(x1p + cl)), x1w1 = __builtin_nontemporal_load((const u32x4*)(x1p + 512 + cl));
        float f[16];
        { const u32x4 s0 = *(const u32x4*)(SOUT + (size_t)t * 1024 + cl), s1 = *(const u32x4*)(SOUT + (size_t)t * 1024 + 512 + cl);
          f[0] = bflo(s0.x); f[1] = bfhi(s0.x); f[2] = bflo(s0.y); f[3] = bfhi(s0.y); f[4] = bflo(s0.z); f[5] = bfhi(s0.z); f[6] = bflo(s0.w); f[7] = bfhi(s0.w);
          f[8] = bflo(s1.x); f[9] = bfhi(s1.x); f[10] = bflo(s1.y); f[11] = bfhi(s1.y); f[12] = bflo(s1.z); f[13] = bfhi(s1.z); f[14] = bflo(s1.w); f[15] = bfhi(s1.w); }
#pragma unroll
        for (int s = 0; s < 8; ++s) {
            const unsigned char* rp = AOUT + ((size_t)t * 8 + s) * 1024;
            const u32x2 s0 = __builtin_nontemporal_load((const u32x2*)(rp + lane * 8)), s1 = __builtin_nontemporal_load((const u32x2*)(rp + 512 + lane * 8));
#define Q6_ADD4(base_, w_) do { f[(base_) + 0] += __builtin_amdgcn_cvt_f32_fp8((int)(w_), 0); f[(base_) + 1] += __builtin_amdgcn_cvt_f32_fp8((int)(w_), 1); \
                f[(base_) + 2] += __builtin_amdgcn_cvt_f32_fp8((int)(w_), 2); f[(base_) + 3] += __builtin_amdgcn_cvt_f32_fp8((int)(w_), 3); } while (0)
            Q6_ADD4(0, s0.x); Q6_ADD4(4, s0.y); Q6_ADD4(8, s1.x); Q6_ADD4(12, s1.y);
#undef Q6_ADD4
        }
        float ss = 0.f;
#pragma unroll
        for (int i = 0; i < 16; ++i) ss += f[i] * f[i];
        ss = wave_sum(ss, lane);
        const float rs = rsqrtf(ss * (1.0f / 1024.0f) + EPS);
#pragma unroll
        for (int hf = 0; hf < 2; ++hf)
#pragma unroll
            for (int q4 = 0; q4 < 2; ++q4) {
                const int c = hf * 512 + cl + q4 * 4;
                const f32x4 gg = *(const f32x4*)(g + c), gt = *(const f32x4*)(md + 5120 + c);
                const u32x4 xw = hf ? x1w1 : x1w0; const unsigned xa = q4 ? xw.z : xw.x, xb = q4 ? xw.w : xw.y;
                const f32x4 x1 = {bflo(xa), bfhi(xa), bflo(xb), bfhi(xb)};
                f32x4 fv = {f[hf * 8 + q4 * 4 + 0], f[hf * 8 + q4 * 4 + 1], f[hf * 8 + q4 * 4 + 2], f[hf * 8 + q4 * 4 + 3]};
                const f32x4 ov = x1 + gt * (fv * rs * gg);
                if (!nostore) __builtin_nontemporal_store(ov, (f32x4*)(od + c)); else asm volatile("" :: "v"(ov[0]), "v"(ov[1]), "v"(ov[2]), "v"(ov[3]));
            }
    }
}

constexpr int STEPS_PER_GRP = 13 + NQ * 2;
constexpr int N_STEPS = 1 + NGRP * STEPS_PER_GRP;
template <unsigned PH_MASK>
__global__ void __launch_bounds__(NT, 2) fwd(Args a_) {
    extern __shared__ __attribute__((aligned(16))) unsigned char lds_raw[];
    LAS unsigned char* lds = (LAS unsigned char*)lds_raw;
    const int wave_id = __builtin_amdgcn_readfirstlane(threadIdx.x >> 6);
#define TID_NOW (wave_id * 64 + lane_now())
    volatile LAS unsigned* misc = (volatile LAS unsigned*)(lds + MISC_OFF);
    { const int t = TID_NOW; if (t < 4) misc[t] = 0u; }
    __syncthreads();
    const int lo = a_.ph_lo, hi = a_.ph_hi;
    XcdBarrier bar; bar.bar = (unsigned*)(a_.ws + WS_CTL); bar.x = 0; bar.st = misc;
    if (hi - lo > 1) bar = xcd_barrier_post((unsigned*)(a_.ws + WS_CTL), misc, TID_NOW);
#define IN(k) (lo <= (k) && (k) < hi)
#define SEAM(k) do { if (IN(k) && IN((k) + 1)) xcd_barrier(bar, TID_NOW); } while (0)
#define FRESH_ARGS KArgs* ap_ = (KArgs*)__builtin_amdgcn_kernarg_segment_ptr(); asm volatile("" : "+s"(ap_)); KA a = *ap_; unsigned char* ws = a.ws; (void)ws; int bid = blockIdx.x, nblk = gridDim.x; asm volatile("" : "+s"(bid), "+s"(nblk)); int tid = TID_NOW; asm volatile("" : "+v"(tid))
    _Pragma("unroll 1") for (int rep_ = 0; rep_ < (((REPEAT_MASK >> 0) & 1u) ? REPEAT_N : 1); ++rep_) if (((PH_MASK >> 0) & 1) && IN(0)) { FRESH_ARGS; p0_prologue(a, lds, bid, nblk, tid); SEAM(0); }
#pragma unroll 1
    for (int grp = 0; grp < NGRP; ++grp) {
        const int base = 1 + grp * STEPS_PER_GRP;
        _Pragma("unroll 1") for (int rep_ = 0; rep_ < (((REPEAT_MASK >> 1) & 1u) ? REPEAT_N : 1); ++rep_) if (((PH_MASK >> 1) & 1) && IN(base + 0) && grp == 0) { FRESH_ARGS; p1_norm(a, grp, bid, nblk, tid); SEAM(base + 0); }
        _Pragma("unroll 1") for (int rep_ = 0; rep_ < (((REPEAT_MASK >> 2) & 1u) ? REPEAT_N : 1); ++rep_) if (((PH_MASK >> 2) & 1) && IN(base + 1)) { FRESH_ARGS;
            SchedInproj S{(const bf16_t*)(ws + G_H), (const bf16_t*)(ws + WS_WIN), (const bf16_t*)(ws + WS_WV), nblk, bid};
            EpiInproj E{(bf16_t*)(ws + G_Q), (bf16_t*)(ws + G_K), (bf16_t*)(ws + G_VT), (bf16_t*)(ws + G_XBC), (float*)(ws + G_DT), (const float*)(ws + WS_ROPE), a.in[I_DTB], (bf16_t*)(ws + G_HALO)};
            pg::gemm_phase(lds, 1024, S, E, tid);
            SEAM(base + 1);
        }
        _Pragma("unroll 1") for (int rep_ = 0; rep_ < (((REPEAT_MASK >> 15) & 1u) ? REPEAT_N : 1); ++rep_) if (((PH_MASK >> 15) & 1) && IN(base + 2)) { FRESH_ARGS; p2b_conv(a, bid, nblk, tid, rep_); SEAM(base + 2); }
        _Pragma("unroll 1") for (int rep_ = 0; rep_ < (((REPEAT_MASK >> 3) & 1u) ? REPEAT_N : 1); ++rep_) if (((PH_MASK >> 3) & 1) && IN(base + 3)) { FRESH_ARGS;
            unsigned* qhead = (unsigned*)(ws + WS_CTL) + CW_Q3 + grp * 64 + rep_ * 16;
            volatile LAS int* qslot = (volatile LAS int*)(lds + MISC_OFF + 64);
#pragma unroll 1
            for (;;) {
                if (tid == 0) qslot[0] = (int)__hip_atomic_fetch_add(qhead, 1u, __ATOMIC_RELAXED, __HIP_MEMORY_SCOPE_AGENT);
                __syncthreads();
                const int L = __builtin_amdgcn_readfirstlane(qslot[0]);
                __syncthreads();
                if (L >= 64 * (1 + SSD_REPEAT) + 1024 + ((grp == 0 && rep_ == 0) ? CVT_ENTRIES : 0)) break;
                unsigned long long t0_ = 0; if (PROBE_UNIT >= 0 && grp == 0 && L == PROBE_UNIT) t0_ = __builtin_amdgcn_s_memrealtime();
#ifndef NO_SSD
                if (L < 64 * (1 + SSD_REPEAT)) { const int u = L & 63; ssd_unit(a, lds, u >> 3, (u >> 1) & 3, u & 1, tid); }
#endif
#ifndef NO_ATTN
                if (L >= 64 * (1 + SSD_REPEAT) && L < 64 * (1 + SSD_REPEAT) + 1024) { const int j = L - 64 * (1 + SSD_REPEAT); attn_unit(a, lds, grp, j >> 7, (j >> 4) & 7, (j >> 1) & 7, j & 1, tid); }
                if (L >= 64 * (1 + SSD_REPEAT) + 1024) { const int e0 = (L - 64 * (1 + SSD_REPEAT) - 1024) * CVT_ENTRY; cvt_all(a, e0, e0 + CVT_ENTRY, 0, 1, tid, lds); }
#endif
                __syncthreads();
                if (PROBE_UNIT >= 0 && grp == 0 && L == PROBE_UNIT && tid == 0) *(float*)(ws + WS_CTL + 15360) = (float)(__builtin_amdgcn_s_memrealtime() - t0_) * 0.001f;
            }
            SEAM(base + 3);
        }
        _Pragma("unroll 1") for (int rep_ = 0; rep_ < (((REPEAT_MASK >> 4) & 1u) ? REPEAT_N : 1); ++rep_) if (((PH_MASK >> 4) & 1) && IN(base + 4)) { FRESH_ARGS;
            attn_finalize(a, bid, nblk, tid);
            SchedPlain S{(const bf16_t*)(ws + G_H), (const bf16_t*)(ws + WS_WZG), TG / 256, 12, 1024, nblk, bid};
            EpiZG E{(const bf16_t*)(ws + G_YF), (const bf16_t*)(ws + G_YB), (bf16_t*)(ws + G_YN), (bf16_t*)(ws + G_G), a.in[I_GSSD], (LAS float*)(lds + EPI_OFF)};
            pg::gemm_phase(lds, 1024, S, E, tid);
            SEAM(base + 4);
        }
        _Pragma("unroll 1") for (int rep_ = 0; rep_ < (((REPEAT_MASK >> 5) & 1u) ? REPEAT_N : 1); ++rep_) if (((PH_MASK >> 5) & 1) && IN(base + 5)) { FRESH_ARGS;
            SchedBranches S{(const bf16_t*)(ws + G_O), (const bf16_t*)(ws + G_YN), (const bf16_t*)(ws + WS_WA), (const bf16_t*)(ws + WS_WS), nblk, bid};
            EpiBranches E{(const bf16_t*)(ws + G_G), (bf16_t*)(ws + G_P), (bf16_t*)(ws + G_U)};
            pg::gemm_phase(lds, 1024, S, E, tid);
            SEAM(base + 5);
        }
        _Pragma("unroll 1") for (int rep_ = 0; rep_ < (((REPEAT_MASK >> 6) & 1u) ? REPEAT_N : 1); ++rep_) if (((PH_MASK >> 6) & 1) && IN(base + 6)) { FRESH_ARGS;

        }
        _Pragma("unroll 1") for (int rep_ = 0; rep_ < (((REPEAT_MASK >> 7) & 1u) ? REPEAT_N : 1); ++rep_) if (((PH_MASK >> 7) & 1) && IN(base + 7)) { FRESH_ARGS;
            SchedPlain S{(const bf16_t*)(ws + G_U), (const bf16_t*)(ws + WS_WO), TG / 256, 4, 1024, nblk, bid};
            EpiPlainBf16 E{(bf16_t*)(ws + G_MIX), 1024};
            pg::gemm_phase(lds, 1024, S, E, tid);
            SEAM(base + 7);
        }
        _Pragma("unroll 1") for (int rep_ = 0; rep_ < (((REPEAT_MASK >> 8) & 1u) ? REPEAT_N : 1); ++rep_) if (((PH_MASK >> 8) & 1) && IN(base + 8)) { FRESH_ARGS; p8_post(a, grp, bid, nblk, tid); SEAM(base + 8); }
        _Pragma("unroll 1") for (int rep_ = 0; rep_ < (((REPEAT_MASK >> 9) & 1u) ? REPEAT_N : 1); ++rep_) if (((PH_MASK >> 9) & 1) && IN(base + 9)) { FRESH_ARGS;
            SchedPlain S{(const bf16_t*)(ws + G_H2), (const bf16_t*)(ws + WS_W1) + (size_t)NEXP * 512 * 1024, TG / 256, 3, 1024, nblk, bid};
            EpiQ1 E{(bf16_t*)(ws + M_HIDS), (float*)(ws + M_LOG)};
            pg::gemm_phase(lds, 1024, S, E, tid);
            SEAM(base + 9);
        }
        _Pragma("unroll 1") for (int rep_ = 0; rep_ < (((REPEAT_MASK >> 10) & 1u) ? REPEAT_N : 1); ++rep_) if (((PH_MASK >> 10) & 1) && IN(base + 10)) { FRESH_ARGS; q2_route(a, lds, bid, nblk, tid); SEAM(base + 10); }
        _Pragma("unroll 1") for (int rep_ = 0; rep_ < (((REPEAT_MASK >> 11) & 1u) ? REPEAT_N : 1); ++rep_) if (((PH_MASK >> 11) & 1) && IN(base + 11)) { FRESH_ARGS; q3_scatter(a, lds, bid, nblk, tid); SEAM(base + 11); }
        _Pragma("unroll 1") for (int rep_ = 0; rep_ < (((REPEAT_MASK >> 12) & 1u) ? REPEAT_N : 1); ++rep_) if (((PH_MASK >> 12) & 1) && IN(base + 12)) { FRESH_ARGS;
            LAS int* offs = (LAS int*)(lds + EPI_OFF); moe_offsets(a, offs, tid);
            SchedQ4 S{(const bf16_t*)(ws + G_H2), (const bf16_t*)(ws + WS_W1), (const int*)(ws + M_ROWL), offs, (const int*)(ws + M_TILE), nblk, bid};
            EpiQ4 E{(bf16_t*)(ws + M_HID)};
            pg::gemm_phase(lds, 1024, S, E, tid);
            SEAM(base + 12);
        }
#pragma unroll 1
        for (int qi = 0; qi < NQ; ++qi) {
            const int qb = base + 13 + qi * 2;
            _Pragma("unroll 1") for (int rep_ = 0; rep_ < (((REPEAT_MASK >> 13) & 1u) ? REPEAT_N : 1); ++rep_) if (((PH_MASK >> 13) & 1) && IN(qb + 0)) { FRESH_ARGS;
                LAS int* offs = (LAS int*)(lds + EPI_OFF); moe_offsets(a, offs, tid);
                SchedQ5 S{(const bf16_t*)(ws + M_HID) + (size_t)qi * MAXROWS * 256, (const bf16_t*)(ws + M_HIDS) + (size_t)qi * QT * 256, (const bf16_t*)(ws + WS_W2), offs + qi * 128, (const int*)(ws + M_TILE) + qi * 1024, nblk, bid};
                EpiQ5 E{(const int*)(ws + M_ROWL) + (size_t)qi * MAXROWS, (const float*)(ws + M_ROWW) + (size_t)qi * MAXROWS, (unsigned char*)(ws + M_AOUT), (bf16_t*)(ws + M_SOUT)};
                pg::gemm_phase(lds, 256, S, E, tid);
                SEAM(qb + 0);
            }
            _Pragma("unroll 1") for (int rep_ = 0; rep_ < (((REPEAT_MASK >> 14) & 1u) ? REPEAT_N : 1); ++rep_) if (((PH_MASK >> 14) & 1) && IN(qb + 1)) { FRESH_ARGS; q6_combine(a, grp, qi, bid, nblk, tid, rep_);
                if (qi == NQ - 1 && grp + 1 < NGRP && rep_ == 0) { FRESH_ARGS; p1_norm(a, grp + 1, bid, nblk, tid); }
                SEAM(qb + 1); }
        }
    }
    if (PROBE_UNIT >= 0 && hi == N_STEPS && blockIdx.x == 0 && TID_NOW == 0) { __builtin_amdgcn_fence(__ATOMIC_ACQUIRE, "agent"); a_.out[0] += *(volatile float*)(a_.ws + WS_CTL + 15360); }
#undef IN
#undef SEAM
}

typedef void (*KernFn)(Args);
template <unsigned M> static KernFn kern() { return fwd<M>; }
extern "C" void kernel_launch(void* const* d_in, const int* in_sizes, int n_in, void* d_out, int out_size, void* d_ws, size_t ws_size, hipStream_t stream) {
    static int grid = 0;
    if (grid == 0) {
        if (n_in != 33 || ws_size < WS_NEED) { fprintf(stderr, "kernel_launch: need 33 inputs and %zu bytes of workspace (got %d, %zu)\n", (size_t)WS_NEED, n_in, ws_size); grid = -1; return; }
        int dev = 0, cus = 0;
        if (hipGetDevice(&dev) != hipSuccess || hipDeviceGetAttribute(&cus, hipDeviceAttributeMultiprocessorCount, dev) != hipSuccess) { grid = -1; return; }
#if N_LAUNCH_MODE == 1
        if (hipFuncSetAttribute((const void*)kern<0xFFFFu>(), hipFuncAttributeMaxDynamicSharedMemorySize, LDS_BYTES) != hipSuccess) { fprintf(stderr, "kernel_launch: hipFuncSetAttribute failed\n"); grid = -1; return; }
        int per_cu = 0;
        if (hipOccupancyMaxActiveBlocksPerMultiprocessor(&per_cu, (const void*)kern<0xFFFFu>(), NT, LDS_BYTES) != hipSuccess || per_cu < 1) fprintf(stderr, "kernel_launch: occupancy query reports %d\n", per_cu);
#endif
        (void)hipGetLastError();
        grid = cus;
    }
    if (grid < 0) return;
    (void)in_sizes; (void)out_size;
    (void)hipMemsetAsync((char*)d_ws + WS_CTL, 0, CTL_BYTES, stream);
    Args a{};
    for (int i = 0; i < 33; ++i) a.in[i] = (const float*)d_in[i];
    a.out = (float*)d_out; a.ws = (unsigned char*)d_ws;
#if N_LAUNCH_MODE == 1
    a.ph_lo = 0; a.ph_hi = N_STEPS;
    hipLaunchKernelGGL(kern<0xFFFFu>(), dim3(grid), dim3(NT), LDS_BYTES, stream, a);
#endif
}
```

```cpp
#include <hip/hip_runtime.h>
#include <stdint.h>
#include <stdio.h>

#ifndef REPEAT_MASK
#define REPEAT_N 2
#define REPEAT_MASK 0u
#endif
#ifndef N_LAUNCH_MODE
#define N_LAUNCH_MODE 1
#endif

#define LAS __attribute__((address_space(3)))
#define DI __device__ __forceinline__
typedef unsigned short bf16_t;
typedef short bf16x8 __attribute__((ext_vector_type(8)));
typedef float f32x4 __attribute__((ext_vector_type(4)));
typedef float f32x2 __attribute__((ext_vector_type(2)));
typedef float f32x16 __attribute__((ext_vector_type(16)));
typedef unsigned u32x4 __attribute__((ext_vector_type(4)));
typedef unsigned u32x2 __attribute__((ext_vector_type(2)));
typedef __bf16 bf16v2 __attribute__((ext_vector_type(2)));

DI unsigned pk_bf16(float lo, float hi) { f32x2 v = {lo, hi}; bf16v2 b = __builtin_convertvector(v, bf16v2); return __builtin_bit_cast(unsigned, b); }
DI bf16_t f2bf(float x) { return (bf16_t)(pk_bf16(x, 0.f) & 0xffffu); }
DI float bflo(unsigned u) { return __uint_as_float(u << 16); }
DI float bfhi(unsigned u) { return __uint_as_float(u & 0xffff0000u); }
DI float bf2f(bf16_t x) { return __uint_as_float(((unsigned)x) << 16); }
DI float sigmoidf_(float x) { return __builtin_amdgcn_rcpf(1.0f + __expf(-x)); }
DI float siluf_(float x) { return x * __builtin_amdgcn_rcpf(1.0f + __expf(-x)); }
DI int swap23(int i) { return (i & ~12) | ((i & 4) << 1) | ((i & 8) >> 1); }
DI int crow(int reg, int h) { return (reg & 3) + 8 * (reg >> 2) + 4 * h; }
#define MFMA32(a, b, c) __builtin_amdgcn_mfma_f32_32x32x16_bf16((a), (b), (c), 0, 0, 0)
DI bf16x8 pack_step(const f32x16& x, int s) {
    u32x4 p;
    p[0] = pk_bf16(x[8 * s + 0], x[8 * s + 1]); p[1] = pk_bf16(x[8 * s + 2], x[8 * s + 3]);
    p[2] = pk_bf16(x[8 * s + 4], x[8 * s + 5]); p[3] = pk_bf16(x[8 * s + 6], x[8 * s + 7]);
    return __builtin_bit_cast(bf16x8, p);
}
DI float shx(float v, int o, int lane) { return __int_as_float(__builtin_amdgcn_ds_bpermute((lane ^ o) << 2, __float_as_int(v))); }
DI int shxi(int v, int o, int lane) { return __builtin_amdgcn_ds_bpermute((lane ^ o) << 2, v); }
DI float shidx(float v, int src) { return __int_as_float(__builtin_amdgcn_ds_bpermute(src << 2, __float_as_int(v))); }
DI int lane_now() { int l; asm volatile("v_mbcnt_lo_u32_b32 %0, -1, 0\n\tv_mbcnt_hi_u32_b32 %0, -1, %0" : "=v"(l)); return l; }
template <int CTRL> DI float dppf(float v) { return __int_as_float(__builtin_amdgcn_update_dpp(0, __float_as_int(v), CTRL, 0xF, 0xF, true)); }
template <int CTRL> DI int dppi(int v) { return __builtin_amdgcn_update_dpp(0, v, CTRL, 0xF, 0xF, true); }
constexpr int DPP_X1 = 0xB1, DPP_X2 = 0x4E, DPP_HM = 0x141, DPP_RM = 0x140;
DI float grp8_sum(float v) { v += dppf<DPP_X1>(v); v += dppf<DPP_X2>(v); v += dppf<DPP_HM>(v); return v; }
DI float grp8_max(float v) { v = fmaxf(v, dppf<DPP_X1>(v)); v = fmaxf(v, dppf<DPP_X2>(v)); v = fmaxf(v, dppf<DPP_HM>(v)); return v; }
DI int grp8_min(int v) { v = min(v, dppi<DPP_X1>(v)); v = min(v, dppi<DPP_X2>(v)); v = min(v, dppi<DPP_HM>(v)); return v; }
DI float wave_sum(float v, int) {
    v = grp8_sum(v); v += dppf<DPP_RM>(v);
    return (__int_as_float(__builtin_amdgcn_readlane(__float_as_int(v), 0)) + __int_as_float(__builtin_amdgcn_readlane(__float_as_int(v), 16)))
         + (__int_as_float(__builtin_amdgcn_readlane(__float_as_int(v), 32)) + __int_as_float(__builtin_amdgcn_readlane(__float_as_int(v), 48)));
}

constexpr int NB = 16, SEQ = 2048, DM = 1024, CTXL = 256, SALL = SEQ + CTXL;
constexpr int GB = 8;
constexpr int NGRP = NB / GB;
constexpr int TG = GB * SEQ;
constexpr int CG = GB * CTXL;
constexpr int HR = TG + CG;
constexpr int QT = TG;
constexpr int NQ = TG / QT;
constexpr int IN_COLS = 8224;
constexpr float EPS = 1e-6f;
constexpr float LAM_INIT = 0.2f;
constexpr float QSCALE = 0.125f * 1.4426950408889634f;
constexpr int NEXP = 64;
constexpr int MAXROWS = QT * 8 + NEXP * 256;

constexpr size_t AL(size_t x) { return (x + 255) & ~(size_t)255; }
constexpr size_t WS_CTL   = 0;
constexpr size_t CTL_BYTES = 16384;
constexpr size_t WS_MOD   = WS_CTL + CTL_BYTES;
constexpr size_t WS_ROPE  = WS_MOD + AL(17 * 6144 * 4);
constexpr size_t WS_WIN   = WS_ROPE + AL(2048 * 32 * 2 * 4);
constexpr size_t WS_WV    = WS_WIN + AL((size_t)4352 * 1024 * 2);
constexpr size_t WS_WZG   = WS_WV + AL((size_t)1024 * 1024 * 2);
constexpr size_t WS_WA    = WS_WZG + AL((size_t)3072 * 1024 * 2);
constexpr size_t WS_WS    = WS_WA + AL((size_t)1024 * 1024 * 2);
constexpr size_t WS_WO    = WS_WS + AL((size_t)1024 * 1024 * 2);
constexpr size_t WS_W1    = WS_WO + AL((size_t)1024 * 1024 * 2);
constexpr size_t WS_W2    = WS_W1 + AL(((size_t)65 * 512 + 256) * 1024 * 2);
constexpr size_t WS_GRP   = WS_W2 + AL((size_t)65 * 1024 * 256 * 2);
constexpr size_t G_H   = WS_GRP;
constexpr size_t G_Q   = G_H + AL((size_t)HR * 1024 * 2);
constexpr size_t G_K   = G_Q + AL((size_t)TG * 1024 * 2);
constexpr size_t G_VT  = G_K + AL((size_t)GB * SALL * 1024 * 2);
constexpr size_t G_XBC = G_VT + AL((size_t)GB * 1024 * SALL * 2);
constexpr size_t G_DT  = G_XBC + AL((size_t)GB * SALL * 2048 * 2);
constexpr size_t G_O   = G_DT + AL((size_t)GB * SALL * 32 * 4);
constexpr size_t G_YF  = G_O + AL((size_t)TG * 1024 * 2);
constexpr size_t G_YB  = G_YF + AL((size_t)TG * 1024 * 2);
constexpr size_t G_HALO = G_YB + AL((size_t)TG * 1024 * 2);
constexpr size_t G_END = G_HALO + AL((size_t)GB * 72 * 2 * 2048 * 2);
constexpr size_t G_YN  = G_Q;
constexpr size_t G_G   = G_XBC;
constexpr size_t G_P   = G_K;
constexpr size_t G_U   = G_VT;
constexpr size_t G_MIX = G_YF;
constexpr size_t G_H2  = G_O;
constexpr size_t G_X1  = G_YB;
constexpr size_t M_HID  = G_H;
constexpr size_t M_HIDS = M_HID + AL((size_t)NQ * MAXROWS * 256 * 2);
constexpr size_t M_OFFS = M_HIDS + AL((size_t)TG * 256 * 2);
constexpr size_t M_TILE = M_OFFS + AL((size_t)NQ * 128 * 4);
constexpr size_t M_ROWL = M_TILE + AL((size_t)NQ * 1024 * 4);
constexpr size_t M_ROWW = M_ROWL + AL((size_t)NQ * MAXROWS * 4);
constexpr size_t M_AOUT = M_ROWW + AL((size_t)NQ * MAXROWS * 4);
constexpr size_t M_SOUT = M_AOUT + AL((size_t)QT * 8 * 1024);
constexpr size_t M_ENDA = M_SOUT + AL((size_t)QT * 1024 * 2);
static_assert(M_AOUT <= G_O, "the tables that survive until Q5 must end before H2 / the routing scratch");
constexpr size_t M_LOG  = G_YF;
constexpr size_t M_TOPE = M_LOG + AL((size_t)TG * 64 * 4);
constexpr size_t M_TOPW = M_TOPE + AL((size_t)TG * 8 * 4);
constexpr size_t M_TPOS = M_TOPW + AL((size_t)TG * 8 * 4);
constexpr size_t M_BCNT = M_TPOS + AL((size_t)TG * 8 * 4);
constexpr size_t M_ENDB = M_BCNT + AL((size_t)NQ * 1024 * 64 * 4);
static_assert(M_ENDB <= G_END, "routing scratch must fit in the MIX region");
constexpr size_t G_O1 = G_END;
constexpr size_t WS_NEED = (G_O1 + AL((size_t)TG * 1024 * 2) > M_ENDA) ? G_O1 + AL((size_t)TG * 1024 * 2) : M_ENDA;
constexpr int CW_Q3 = 3584;
#ifndef PROBE_UNIT
#define PROBE_UNIT -1
#endif
#ifndef SSD_REPEAT
#define SSD_REPEAT 0
#endif

#define XB_TMO      128
#define XB_XCNT(j)  (256  + 64 * (j))
#define XB_XSUB(j)  (1280 + 64 * (j))
#define XB_XGEN(j)  (2304 + 64 * (j))
#define XB_TOP      3328
#define XB_TOPGEN   3392
#define XCD_BAR_WORDS 3456
#define XB_SPIN_CAP (1u << 18)
DI unsigned xb_ld(unsigned* p)              { return __hip_atomic_load(p, __ATOMIC_RELAXED, __HIP_MEMORY_SCOPE_AGENT); }
DI unsigned xb_add(unsigned* p, unsigned v) { return __hip_atomic_fetch_add(p, v, __ATOMIC_RELAXED, __HIP_MEMORY_SCOPE_AGENT); }
DI unsigned xb_xcc_id() { return (unsigned)__builtin_amdgcn_s_getreg((3 << 11) | 20) & 0xFu; }
#define XB_SPIN(cond, bar) do { unsigned _sp = 0; while (cond) { __builtin_amdgcn_s_sleep(1); \
    if ((++_sp & 255u) == 0u) { if (xb_ld(&(bar)[XB_TMO])) break; if (_sp > XB_SPIN_CAP) { atomicAdd(&(bar)[XB_TMO], 1u); break; } } } } while (0)
struct XcdBarrier { unsigned* bar; unsigned x; volatile LAS unsigned* st; };
DI XcdBarrier xcd_barrier_post(unsigned* bar, volatile LAS unsigned* st, int tid) {
    XcdBarrier b; b.bar = bar; b.x = xb_xcc_id(); b.st = st;
    if (tid == 0) (void)xb_add(&bar[XB_XCNT(b.x)], 1u);
    return b;
}
DI void xcd_barrier_complete(unsigned* bar, unsigned x, unsigned& nloc, unsigned& nx) {
    const unsigned G = gridDim.x * gridDim.y * gridDim.z;
    unsigned sum, cnt, mine, sp = 0u;
    for (;;) {
        sum = 0u; cnt = 0u; mine = 0u;
#pragma unroll 1
        for (unsigned j = 0; j < 16; ++j) { const unsigned c = xb_ld(&bar[XB_XCNT(j)]); sum += c; cnt += (c > 0u) ? 1u : 0u; mine = (j == x) ? c : mine; }
        if (sum == G) break;
        __builtin_amdgcn_s_sleep(1);
        if ((++sp & 255u) == 0u) { if (xb_ld(&bar[XB_TMO])) break; if (sp > XB_SPIN_CAP) { atomicAdd(&bar[XB_TMO], 1u); break; } }
    }
    nloc = mine > 0u ? mine : 1u; nx = cnt > 0u ? cnt : 1u;
}
DI void xcd_barrier(const XcdBarrier& b, int tid) {
    asm volatile("s_waitcnt vmcnt(0)" ::: "memory");
    __syncthreads();
    if (tid == 0) {
        unsigned* bar = b.bar;
        __builtin_amdgcn_s_waitcnt(0);
        unsigned nloc = b.st[0], nx = b.st[1];
        if (nloc == 0u) { xcd_barrier_complete(bar, b.x, nloc, nx); b.st[0] = nloc; b.st[1] = nx; }
        const unsigned old = xb_add(&bar[XB_XSUB(b.x)], 1u);
        const unsigned gen = old / nloc;
        if (old + 1u == (gen + 1u) * nloc) {
            __builtin_amdgcn_fence(__ATOMIC_RELEASE, "agent");
            asm volatile("s_waitcnt vmcnt(0)" ::: "memory");
            const unsigned og = xb_add(&bar[XB_TOP], 1u);
            const unsigned tg = og / nx;
            if (og + 1u == (tg + 1u) * nx) xb_add(&bar[XB_TOPGEN], 1u);
            else XB_SPIN(xb_ld(&bar[XB_TOPGEN]) == tg, bar);
            __builtin_amdgcn_fence(__ATOMIC_ACQUIRE, "agent");
            xb_add(&bar[XB_XGEN(b.x)], 1u);
            asm volatile("s_waitcnt vmcnt(0)" ::: "memory");
        } else {
            XB_SPIN(xb_ld(&bar[XB_XGEN(b.x)]) == gen, bar);
            __builtin_amdgcn_fence(__ATOMIC_ACQUIRE, "agent");
            asm volatile("s_waitcnt vmcnt(0)" ::: "memory");
        }
    }
    __syncthreads();
}

namespace pg {
constexpr int BM = 256, BK = 64, HALF = 128, HTB = HALF * BK * 2, STAGE_BYTES = 8 * HTB;
DI int lds_byte(int r, int c) { const int st = (r >> 4) * 2 + (c >> 5), rr = r & 15, cc = c & 31, ob = rr * 64 + cc * 2; return st * 1024 + (ob ^ (((ob >> 9) & 1) << 5)); }
DI void stage_rc(int b, int& R, int& C) { const int st = b / 1024, sb = b % 1024, swz = sb ^ (((sb >> 9) & 1) << 5); R = (st >> 1) * 16 + swz / 64; C = (st & 1) * 32 + (swz % 64) / 2; }
DI int perm32(int rho) { const int n = rho >> 4, i = rho & 15; return 8 * (i >> 2) + 4 * n + (i & 3); }
struct Unit { int pm, pn, kind, aux; };
DI void decode_tiles(int L, int nM, int nN, int& pm, int& pn) {
    const int nwg = nM * nN; int wgid = L;
    { const int q = nwg / 8, r = nwg % 8, xcd = wgid % 8, off = wgid / 8; wgid = (xcd < r ? xcd * (q + 1) : r * (q + 1) + (xcd - r) * q) + off; }
    const int nig = 8 * nN, gid = wgid / nig, fm = gid * 8, gsz = (nM - fm) < 8 ? (nM - fm) : 8;
    pm = fm + ((wgid % nig) % gsz); pn = (wgid % nig) / gsz;
}
template <class Epi, class Sched>
DI void gemm_phase(LAS unsigned char* lds, const int K, const Sched& S, const Epi& E, int tid_in) {
    constexpr bool GATHER = Sched::GATHER;
    int tid = tid_in; asm volatile("" : "+v"(tid));
    const int wid = __builtin_amdgcn_readfirstlane(tid >> 6), lane = tid & 63, wr = wid >> 2, wc = wid & 3, fr = lane & 15, fq = lane >> 4;
    const int nt = K / BK;
    unsigned voffA[2], voffB[2];
    int Rr[2], Cc[2];
#pragma unroll
    for (int i = 0; i < 2; ++i) { int R, C; stage_rc(tid * 16 + i * 8192, R, C); const int Rb = (R & ~31) + perm32(R & 31);
        Rr[i] = R; Cc[i] = C; voffA[i] = (unsigned)(R * K + C) * 2u; voffB[i] = (unsigned)(Rb * K + C) * 2u; }
    const size_t kstep = (size_t)(BK * 2);
    const size_t hstep = (size_t)HALF * K * 2;
    const unsigned ldsw = (unsigned)wid * 1024u;
    const int aoff = lds_byte(wr * 64 + fr, fq * 8), boff = lds_byte(wc * 32 + fr, fq * 8);
#define PG_SA(b, h) (((b) * 2 + (h)) * HTB)
#define PG_SB(b, h) ((4 + (b) * 2 + (h)) * HTB)
#define PG_STAGE(bufoff, gbase, voff) do { _Pragma("unroll") for (int _i = 0; _i < 2; ++_i) \
        __builtin_amdgcn_global_load_lds((const unsigned*)((const char*)(gbase) + (voff)[_i]), (LAS unsigned*)(lds + (bufoff) + ldsw + _i * 8192), 16, 0, 0); } while (0)
#define PG_STAGE_A(bufoff, gb, kofs, h, o0, o1) do { if constexpr (GATHER) { if ((h) == 0) PG_STAGE(bufoff, (gb) + (kofs), o0); else PG_STAGE(bufoff, (gb) + (kofs), o1); } \
        else { PG_STAGE(bufoff, (gb) + (kofs) + (h) * hstep, voffA); } } while (0)
#define PG_LDA(dst, b, h) do { _Pragma("unroll") for (int m = 0; m < 4; ++m) _Pragma("unroll") for (int k = 0; k < 2; ++k) dst[m][k] = *(const LAS bf16x8*)(lds + PG_SA(b, h) + aoff + m * 2048 + k * 1024); } while (0)
#define PG_LDB(dst, b, h) do { _Pragma("unroll") for (int n = 0; n < 2; ++n) _Pragma("unroll") for (int k = 0; k < 2; ++k) dst[n][k] = *(const LAS bf16x8*)(lds + PG_SB(b, h) + boff + n * 2048 + k * 1024); } while (0)
#define PG_MMA(ai, bj, At, Bt) do { __builtin_amdgcn_s_setprio(1); _Pragma("unroll") for (int m = 0; m < 4; ++m) _Pragma("unroll") for (int n = 0; n < 2; ++n) _Pragma("unroll") for (int k = 0; k < 2; ++k) \
        acc[ai][bj][m][n] = __builtin_amdgcn_mfma_f32_16x16x32_bf16(Bt[n][k], At[m][k], acc[ai][bj][m][n], 0, 0, 0); __builtin_amdgcn_s_setprio(0); } while (0)
#define PG_WAIT_V(n) asm volatile("s_waitcnt vmcnt(" #n ")" ::: "memory")
#define PG_WAIT_L(n) asm volatile("s_waitcnt lgkmcnt(" #n ")" ::: "memory")
#define PG_BAR __builtin_amdgcn_s_barrier()
#define PG_SCHED __builtin_amdgcn_sched_barrier(0)
#define PG_AOFFS(u, o0, o1) do { if constexpr (GATHER) { _Pragma("unroll") for (int _i = 0; _i < 2; ++_i) { \
        o0[_i] = (unsigned)(S.a_row(u, Rr[_i]) * K + Cc[_i]) * 2u; o1[_i] = (unsigned)(S.a_row(u, HALF + Rr[_i]) * K + Cc[_i]) * 2u; } } } while (0)
    Unit cur, nxt; int ui = 0;
    if (!S.next(0, cur)) return;
    f32x4 acc[2][2][4][2];
#pragma unroll
    for (int a = 0; a < 2; ++a)
#pragma unroll
        for (int b = 0; b < 2; ++b)
#pragma unroll
            for (int m = 0; m < 4; ++m)
#pragma unroll
                for (int n = 0; n < 2; ++n) acc[a][b][m][n] = (f32x4){0.f, 0.f, 0.f, 0.f};
    bf16x8 At[4][2], B0[2][2], B1[2][2];
    unsigned cA0[2] = {0u, 0u}, cA1[2] = {0u, 0u}, nA0[2] = {0u, 0u}, nA1[2] = {0u, 0u};
    const char* cA = S.a_tile(cur); const char* cB = S.b_base(cur);
    PG_AOFFS(cur, cA0, cA1);
    if constexpr (Sched::AUX) S.aux(cur, lds, wid, lane);
    PG_STAGE(PG_SB(0, 0), cB, voffB); PG_STAGE(PG_SB(0, 1), cB + hstep, voffB); PG_STAGE_A(PG_SA(0, 0), cA, 0, 0, cA0, cA1); PG_STAGE_A(PG_SA(0, 1), cA, 0, 1, cA0, cA1);
    if (wr == 1) PG_BAR;
    PG_WAIT_V(2); PG_BAR;
    PG_STAGE(PG_SB(1, 0), cB + kstep, voffB); PG_STAGE_A(PG_SA(1, 0), cA, kstep, 0, cA0, cA1); PG_STAGE(PG_SB(1, 1), cB + hstep + kstep, voffB);
    PG_WAIT_V(6); PG_BAR;
    for (;;) {
        const bool has_next = S.next(ui + 1, nxt);
        const char* nA = cA; const char* nB = cB;
        if (has_next) { nA = S.a_tile(nxt); nB = S.b_base(nxt); PG_AOFFS(nxt, nA0, nA1); if constexpr (Sched::AUX) S.aux(nxt, lds, wid, lane); }
        else if constexpr (GATHER) { nA0[0] = cA0[0]; nA0[1] = cA0[1]; nA1[0] = cA1[0]; nA1[1] = cA1[1]; }
        for (int t = 0; t < nt; t += 2) {
            const bool last = (t == nt - 2);
            const char* a1 = cA + (size_t)(t + 1) * kstep;
            const char* a2 = last ? nA : cA + (size_t)(t + 2) * kstep; const char* b2 = last ? nB : cB + (size_t)(t + 2) * kstep;
            const char* b3 = b2 + kstep;
            unsigned s0[2] = {0u, 0u}, s1[2] = {0u, 0u};
            if constexpr (GATHER) { s0[0] = last ? nA0[0] : cA0[0]; s0[1] = last ? nA0[1] : cA0[1]; s1[0] = last ? nA1[0] : cA1[0]; s1[1] = last ? nA1[1] : cA1[1]; }
            PG_LDB(B0, 0, 0); PG_LDB(B1, 0, 1); PG_SCHED; PG_LDA(At, 0, 0); PG_STAGE_A(PG_SA(1, 1), a1, 0, 1, cA0, cA1);
            PG_WAIT_V(8); PG_WAIT_L(0); PG_BAR; PG_MMA(0, 0, At, B0); PG_MMA(0, 1, At, B1); PG_BAR; PG_SCHED;
            PG_LDA(At, 0, 1); PG_STAGE(PG_SB(0, 0), b2, voffB); PG_STAGE(PG_SB(0, 1), b2 + hstep, voffB); PG_STAGE_A(PG_SA(0, 0), a2, 0, 0, s0, s1);
            PG_WAIT_V(8); PG_WAIT_L(0); PG_BAR; PG_MMA(1, 0, At, B0); PG_MMA(1, 1, At, B1); PG_BAR; PG_SCHED;
            PG_LDB(B0, 1, 0); PG_LDB(B1, 1, 1); PG_SCHED; PG_LDA(At, 1, 0); PG_STAGE_A(PG_SA(0, 1), a2, 0, 1, s0, s1);
            PG_WAIT_V(8); PG_WAIT_L(0); PG_BAR; PG_MMA(0, 0, At, B0); PG_MMA(0, 1, At, B1); PG_BAR; PG_SCHED;
            PG_LDA(At, 1, 1); PG_STAGE(PG_SB(1, 0), b3, voffB); PG_STAGE(PG_SB(1, 1), b3 + hstep, voffB); PG_STAGE_A(PG_SA(1, 0), a2, kstep, 0, s0, s1);
            PG_WAIT_V(8); PG_WAIT_L(0); PG_BAR; PG_MMA(1, 0, At, B0); PG_MMA(1, 1, At, B1); PG_BAR; PG_SCHED;
        }
        if (wr == 0) PG_BAR;
        { const int ln_ = lane_now(); const int fr_ = ln_ & 15, fq_ = ln_ >> 4;
          E(acc, cur, wr, wc, fr_, fq_, ln_); }
        if (!has_next) break;
#pragma unroll
        for (int a = 0; a < 2; ++a)
#pragma unroll
            for (int b = 0; b < 2; ++b)
#pragma unroll
                for (int m = 0; m < 4; ++m)
#pragma unroll
                    for (int n = 0; n < 2; ++n) acc[a][b][m][n] = (f32x4){0.f, 0.f, 0.f, 0.f};
        cur = nxt; cA = nA; cB = nB; ++ui;
        if constexpr (GATHER) { cA0[0] = nA0[0]; cA0[1] = nA0[1]; cA1[0] = nA1[0]; cA1[1] = nA1[1]; }
        if (wr == 1) PG_BAR;
    }
    PG_WAIT_V(0);
    PG_BAR;
#undef PG_SA
#undef PG_SB
#undef PG_STAGE
#undef PG_STAGE_A
#undef PG_LDA
#undef PG_LDB
#undef PG_MMA
#undef PG_WAIT_V
#undef PG_WAIT_L
#undef PG_BAR
#undef PG_SCHED
#undef PG_AOFFS
}
template <int FE = 8, class F> DI void for_each8(const f32x4 (&acc)[2][2][4][2], int wr, int wc, int fr, int fq, F&& f) {
#pragma unroll
    for (int ai = 0; ai < 2; ++ai)
#pragma unroll
        for (int m = 0; m < 4; ++m)
#pragma unroll
            for (int bj = 0; bj < 2; ++bj) { f(ai * HALF + wr * 64 + m * 16 + fr, bj * HALF + wc * 32 + 8 * fq, acc[ai][bj][m][0], acc[ai][bj][m][1]); if (((ai * 8 + m * 2 + bj) % FE) == FE - 1) asm volatile("" ::: "memory"); }
}
DI u32x4 pack8(const f32x4& a, const f32x4& b) { u32x4 w; w.x = pk_bf16(a[0], a[1]); w.y = pk_bf16(a[2], a[3]); w.z = pk_bf16(b[0], b[1]); w.w = pk_bf16(b[2], b[3]); return w; }
}

struct Args { const float* in[33]; float* out; unsigned char* ws; int ph_lo, ph_hi; };
typedef const Args __attribute__((address_space(4))) KArgs;
#define KA KArgs&
enum { I_X = 0, I_C, I_CTX, I_CCTX, I_WADA, I_BADA, I_GPRE1, I_GPOST1, I_GPRE2, I_GPOST2, I_WIN, I_LQ1, I_LK1, I_LQ2, I_LK2, I_GSUB, I_CONVW, I_CONVB, I_DTB, I_ALOG,
       I_DSKIP, I_GSSD, I_WBA, I_WBS, I_WOUT, I_WR, I_RB, I_WEG, I_WEU, I_WED, I_WSG, I_WSU, I_WSD };
constexpr int NT = 512;
constexpr int RING_BYTES = pg::STAGE_BYTES;
constexpr int EPI_OFF = RING_BYTES;
constexpr int YT_OFF = EPI_OFF + 9216;
constexpr int MISC_OFF = YT_OFF + 16384;
constexpr int LDS_BYTES = MISC_OFF + 256;

struct CvtSeg { int in_idx, ld, col0, ncols, nvalid, K, mode, rowoff, nbatch; size_t dst_off, sstride, dstride; };
constexpr int cvt_items(const CvtSeg& g) { return (g.ncols / 256) * (g.K / 64) * g.nbatch; }
constexpr int N_CVT = 20;
__device__ constexpr CvtSeg kCvt[N_CVT] = {
    {I_WEG, 256, 0, 256, 256, 1024, 2, 0,   NEXP, WS_W1, (size_t)1024 * 256, (size_t)512 * 1024},
    {I_WEU, 256, 0, 256, 256, 1024, 2, 128, NEXP, WS_W1, (size_t)1024 * 256, (size_t)512 * 1024},
    {I_WED, 1024, 0, 1024, 1024, 256, 0, 0, NEXP, WS_W2, (size_t)256 * 1024, (size_t)1024 * 256},
    {I_WIN, IN_COLS, 0,    1024, 1024, 1024, 1, 0,    1, WS_WIN, 0, 0},
    {I_WIN, IN_COLS, 1024, 1024, 1024, 1024, 1, 1024, 1, WS_WIN, 0, 0},
    {I_WIN, IN_COLS, 4096, 2048, 2048, 1024, 0, 2048, 1, WS_WIN, 0, 0},
    {I_WIN, IN_COLS, 6144, 256,  32,   1024, 0, 4096, 1, WS_WIN, 0, 0},
    {I_WIN, IN_COLS, 2048, 1024, 1024, 1024, 0, 0,    1, WS_WV, 0, 0},
    {I_WIN, IN_COLS, 3072, 1024, 1024, 1024, 0, 0,    1, WS_WZG, 0, 0},
    {I_WIN, IN_COLS, 6176, 2048, 2048, 1024, 0, 1024, 1, WS_WZG, 0, 0},
    {I_WBA,  1024, 0, 1024, 1024, 1024, 0, 0, 1, WS_WA, 0, 0},
    {I_WBS,  1024, 0, 1024, 1024, 1024, 0, 0, 1, WS_WS, 0, 0},
    {I_WOUT, 1024, 0, 1024, 1024, 1024, 0, 0, 1, WS_WO, 0, 0},
    {I_WSG, 256, 0, 256, 256, 1024, 2, 0,   1, WS_W1 + (size_t)NEXP * 512 * 1024 * 2, 0, 0},
    {I_WSU, 256, 0, 256, 256, 1024, 2, 128, 1, WS_W1 + (size_t)NEXP * 512 * 1024 * 2, 0, 0},
    {I_WSD, 1024, 0, 1024, 1024, 256, 0, 0, 1, WS_W2 + (size_t)NEXP * 1024 * 256 * 2, 0, 0},
    {I_WR, 64, 0, 256, 64, 1024, 0, 0, 1, WS_W1 + (size_t)65 * 512 * 1024 * 2, 0, 0},
    {0, 0, 0, 0, 0, 256, 0, 0, 0, 0, 0, 0}, {0, 0, 0, 0, 0, 256, 0, 0, 0, 0, 0, 0}, {0, 0, 0, 0, 0, 256, 0, 0, 0, 0, 0, 0}
};
constexpr int cvt_total() { int t = 0; for (int i = 0; i < N_CVT; ++i) t += cvt_items(kCvt[i]); return t; }
constexpr int CVT_EXPERT_ITEMS = 3 * NEXP * 16;
constexpr int CVT_ENTRY = 4, CVT_ENTRIES = CVT_EXPERT_ITEMS / CVT_ENTRY;
DI void cvt_all(KA a, int gfirst, int gend, int bid, int nblk, int tid_in, LAS unsigned char* lds) {
    int tid_ = tid_in; asm volatile("" : "+v"(tid_)); const int tid = tid_, jl = tid & 63, kg = tid >> 6;
    const int nitems = gend;
    auto locate = [&](int g, int& sg, int& bt, int& jb, int& kb) {
        sg = 0; int base = 0;
#pragma unroll 1
        for (int i = 0; i < N_CVT; ++i) { const int n = (kCvt[i].ncols / 256) * (kCvt[i].K / 64) * kCvt[i].nbatch; if (g >= base + n) { base += n; sg = i + 1; } else break; }
        const int it = g - base, njb = kCvt[sg].ncols / 256, nper = njb * (kCvt[sg].K / 64);
        bt = it / nper; const int r = it % nper; jb = r % njb; kb = r / njb;
    };
    f32x4 v[8];
    auto load_item = [&](int g) {
        int sg, bt, jb, kb; locate(g, sg, bt, jb, kb);
        const float* src = a.in[kCvt[sg].in_idx] + (size_t)bt * kCvt[sg].sstride;
        const int j = jb * 256 + jl * 4, k0 = kb * 64 + kg * 8, ld = kCvt[sg].ld, col0 = kCvt[sg].col0;
        const bool ok = j < kCvt[sg].nvalid;
#pragma unroll
        for (int i = 0; i < 8; ++i) v[i] = ok ? __builtin_nontemporal_load((const f32x4*)(src + (size_t)(k0 + i) * ld + col0 + j)) : (f32x4){0.f, 0.f, 0.f, 0.f};
    };
    if (gfirst + bid < nitems) load_item(gfirst + bid);
    for (int g = gfirst + bid; g < nitems; g += nblk) {
        int sg, bt, jb, kb; locate(g, sg, bt, jb, kb);
        bf16_t* dst = (bf16_t*)(a.ws + kCvt[sg].dst_off) + (size_t)bt * kCvt[sg].dstride;
        const int K = kCvt[sg].K, mode = kCvt[sg].mode, rowoff = kCvt[sg].rowoff;
        u32x4 w[4];
#pragma unroll
        for (int c = 0; c < 4; ++c) { w[c].x = pk_bf16(v[0][c], v[1][c]); w[c].y = pk_bf16(v[2][c], v[3][c]); w[c].z = pk_bf16(v[4][c], v[5][c]); w[c].w = pk_bf16(v[6][c], v[7][c]); }
        if (g + nblk < nitems) load_item(g + nblk);
        __syncthreads();
#pragma unroll
        for (int c = 0; c < 4; ++c) *(LAS u32x4*)(lds + (jl * 4 + c) * 144 + kg * 16) = w[c];
        __syncthreads();
#pragma unroll
        for (int q = 0; q < 4; ++q) {
            const int idx = q * NT + tid, r = idx >> 3, ch = idx & 7, jj = jb * 256 + r;
            int row = jj;
            if (mode == 1) { const int blk = jj >> 6, d = jj & 63; row = blk * 64 + 2 * (d & 31) + (d >> 5); }
            else if (mode == 2) { row = (jj >> 7) * 256 + (jj & 127); }
            *(u32x4*)(dst + (size_t)(rowoff + row) * K + kb * 64 + ch * 8) = *(const LAS u32x4*)(lds + r * 144 + ch * 16);
        }
    }
    __syncthreads();
}
DI void p0_prologue(KA a, LAS unsigned char* lds, int bid, int nblk, int tid_in) {
    unsigned char* ws = a.ws;
    int tid_ = tid_in; asm volatile("" : "+v"(tid_)); const int tid = tid_;
    cvt_all(a, CVT_EXPERT_ITEMS, cvt_total(), bid, nblk, tid, lds);
    {
        float* rope = (float*)(ws + WS_ROPE);
        for (int idx = bid * NT + tid; idx < 2048 * 32; idx += nblk * NT) {
            const int n = idx >> 5, i = idx & 31, m = i & 15;
            const float inv = powf(10000.0f, -(float)(2 * m) / 32.0f);
            const float ang = (float)(i < 16 ? (n >> 6) : (n & 63)) * inv;
            float s, c; sincosf(ang, &s, &c);
            rope[idx * 2] = c; rope[idx * 2 + 1] = s;
        }
    }
    {
        LAS float* sc = (LAS float*)lds;
        LAS float* red = (LAS float*)(lds + 17 * 1024 * 4);
        float* MOD = (float*)(ws + WS_MOD);
        const float* w_ada = a.in[I_WADA];
        bool filled = false;
        for (int it = bid; it < 6144 / 32; it += nblk) {
            if (!filled) {
                for (int idx = tid; idx < 17 * 1024; idx += NT) { const int r = idx >> 10, k = idx & 1023; const float c = (r < 16) ? a.in[I_C][r * 1024 + k] : a.in[I_CCTX][k]; sc[idx] = siluf_(c); }
                filled = true;
            }
            __syncthreads();
            const int jl = tid & 31, kg = tid >> 5, j = it * 32 + jl;
            float acc[17];
#pragma unroll
            for (int r = 0; r < 17; ++r) acc[r] = 0.f;
#pragma unroll 2
            for (int k = kg * 64; k < kg * 64 + 64; k += 4) {
                const float w0 = w_ada[(size_t)k * 6144 + j], w1 = w_ada[(size_t)(k + 1) * 6144 + j], w2 = w_ada[(size_t)(k + 2) * 6144 + j], w3 = w_ada[(size_t)(k + 3) * 6144 + j];
#pragma unroll
                for (int r = 0; r < 17; ++r) { const f32x4 c4 = *(const LAS f32x4*)(sc + r * 1024 + k); acc[r] += (c4[0] * w0 + c4[1] * w1) + (c4[2] * w2 + c4[3] * w3); }
            }
#pragma unroll
            for (int r = 0; r < 17; ++r) red[(kg * 32 + jl) * 17 + r] = acc[r];
            __syncthreads();
            for (int idx = tid; idx < 32 * 17; idx += NT) {
                const int jj = idx / 17, r = idx % 17; float sum = 0.f;
#pragma unroll
                for (int g = 0; g < 16; ++g) sum += red[(g * 32 + jj) * 17 + r];
                MOD[r * 6144 + it * 32 + jj] = sum + a.in[I_BADA][it * 32 + jj];
            }
            __syncthreads();
        }
    }
}

DI void p1_norm(KA a, int grp, int bid, int nblk, int tid_in) {
    int tid_ = tid_in; asm volatile("" : "+v"(tid_)); const int tid = tid_, wid = tid >> 6, lane = tid & 63;
    bf16_t* H = (bf16_t*)(a.ws + G_H);
    const float* MOD = (const float*)(a.ws + WS_MOD);
    const float* g = a.in[I_GPRE1];
    f32x4 gg[4];
#pragma unroll
    for (int i = 0; i < 4; ++i) gg[i] = *(const f32x4*)(g + i * 256 + lane * 4);
    const int stride = nblk * 8;
    for (int row0 = bid * 8 + wid; row0 < HR; row0 += 3 * stride) {
        f32x4 v[3][4], s1[3][4], s2[3][4];
#pragma unroll
        for (int j = 0; j < 3; ++j) {
            const int row = row0 + j * stride; const float* src = a.in[I_X]; int mrow = 0;
            if (row < TG) { const int grow = grp * TG + row; src = a.in[I_X] + (size_t)grow * 1024; mrow = grow >> 11; }
            else if (row < HR) { const int crow_ = grp * CG + (row - TG); src = a.in[I_CTX] + (size_t)crow_ * 1024; mrow = 16; }
            const float* sh = MOD + mrow * 6144;
#pragma unroll
            for (int i = 0; i < 4; ++i) { v[j][i] = __builtin_nontemporal_load((const f32x4*)(src + i * 256 + lane * 4)); s1[j][i] = *(const f32x4*)(sh + i * 256 + lane * 4); s2[j][i] = *(const f32x4*)(sh + 1024 + i * 256 + lane * 4); }
        }
#pragma unroll
        for (int j = 0; j < 3; ++j) {
            const int row = row0 + j * stride;
            if (row >= HR) break;
            float ss = 0.f;
#pragma unroll
            for (int i = 0; i < 4; ++i) ss += v[j][i][0] * v[j][i][0] + v[j][i][1] * v[j][i][1] + v[j][i][2] * v[j][i][2] + v[j][i][3] * v[j][i][3];
            ss = wave_sum(ss, lane);
            const float rs = rsqrtf(ss * (1.0f / 1024.0f) + EPS);
#pragma unroll
            for (int i = 0; i < 4; ++i) {
                const int c = i * 256 + lane * 4;
                f32x4 y = v[j][i] * rs * gg[i] * (s2[j][i] + 1.0f) + s1[j][i];
                u32x2 w; w.x = pk_bf16(y[0], y[1]); w.y = pk_bf16(y[2], y[3]);
                *(u32x2*)(H + (size_t)row * 1024 + c) = w;
            }
        }
    }
}

struct SchedInproj {
    const bf16_t* H; const bf16_t* WIN; const bf16_t* WV; int G, c;
    static constexpr int NL = 64 * 17, NA = NL + 8 * 13, NTOT = NA + 4 * 72;
    DI bool next(int i, pg::Unit& u) const {
        const int L = i * G + c; if (L >= NTOT) return false;
        if (L < NL) { pg::decode_tiles(L, 64, 17, u.pm, u.pn); u.kind = 0; }
        else if (L < NA) { pg::decode_tiles(L - NL, 8, 13, u.pm, u.pn); u.pm += 64; u.pn += 4; u.kind = 0; }
        else { const int j = L - NA; u.pm = j & 3; u.pn = j >> 2; u.kind = 1; }
        u.aux = 0; return true;
    }
    static constexpr bool GATHER = false; static constexpr bool AUX = false;
    DI const char* a_tile(const pg::Unit& u) const { return (const char*)((u.kind == 0 ? H : WV) + (size_t)u.pm * 256 * 1024); }
    DI int a_row(const pg::Unit&, int) const { return 0; }
    DI const char* b_base(const pg::Unit& u) const { return (const char*)((u.kind == 0 ? WIN : H) + (size_t)u.pn * 256 * 1024); }
};
struct EpiInproj {
    bf16_t* Q; bf16_t* Kb; bf16_t* VT; bf16_t* XBC; float* DT; const float* rope; const float* dtb; bf16_t* HALO;
    DI void operator()(const f32x4 (&acc)[2][2][4][2], const pg::Unit& u, int wr, int wc, int fr, int fq, int lane) const {
        const int rl = wr * 64 + fr, cl = wc * 32 + 8 * fq;
        if (u.kind == 1) {
            const int b = (u.pn < 64) ? (u.pn >> 3) : (u.pn - 64), pos0 = (u.pn < 64) ? (CTXL + (u.pn & 7) * 256) : 0;
            bf16_t* base = VT + ((size_t)b * 1024 + u.pm * 256 + rl) * SALL + pos0 + cl;
#pragma unroll
            for (int ai = 0; ai < 2; ++ai)
#pragma unroll
                for (int m = 0; m < 4; ++m)
#pragma unroll
                    for (int bj = 0; bj < 2; ++bj) *(u32x4*)(base + (size_t)(ai * 128 + m * 16) * SALL + bj * 128) = pg::pack8(acc[ai][bj][m][0], acc[ai][bj][m][1]);
            return;
        }
        const bool isctx = u.pm >= 64;
        const int b = isctx ? (u.pm - 64) : (u.pm >> 3), pos0 = isctx ? 0 : (CTXL + (u.pm & 7) * 256);
        const size_t drow0 = (size_t)b * SALL + pos0 + rl;
        if (u.pn < 8) {
            if (isctx && u.pn < 4) return;
            const bool isq = u.pn < 4;
            const long qk = (const char*)Kb - (const char*)Q;
            bf16_t* base = (bf16_t*)((char*)Q + (isq ? 0L : qk)) + (isq ? ((size_t)u.pm * 256 + rl) : drow0) * 1024 + (u.pn & 3) * 256 + cl;
            if (isctx) {
#pragma unroll
                for (int ai = 0; ai < 2; ++ai)
#pragma unroll
                    for (int m = 0; m < 4; ++m)
#pragma unroll
                        for (int bj = 0; bj < 2; ++bj) *(u32x4*)(base + (size_t)(ai * 128 + m * 16) * 1024 + bj * 128) = pg::pack8(acc[ai][bj][m][0], acc[ai][bj][m][1]);
                return;
            }
            const float* rp = rope + ((size_t)((u.pm & 7) * 256 + rl) * 32 + ((cl & 63) >> 1)) * 2;
            const float qs = isq ? QSCALE : 1.0f;
#pragma unroll
            for (int ai = 0; ai < 2; ++ai) {
                f32x4 cs0[4], cs1[4];
#pragma unroll
                for (int m = 0; m < 4; ++m) { cs0[m] = *(const f32x4*)(rp + (ai * 128 + m * 16) * 64) * qs; cs1[m] = *(const f32x4*)(rp + (ai * 128 + m * 16) * 64 + 4) * qs; }
#pragma unroll
                for (int m = 0; m < 4; ++m)
#pragma unroll
                    for (int bj = 0; bj < 2; ++bj) {
                        const f32x4 v0 = acc[ai][bj][m][0], v1 = acc[ai][bj][m][1]; f32x4 o0, o1;
                        o0[0] = v0[0] * cs0[m][0] - v0[1] * cs0[m][1]; o0[1] = v0[1] * cs0[m][0] + v0[0] * cs0[m][1];
                        o0[2] = v0[2] * cs0[m][2] - v0[3] * cs0[m][3]; o0[3] = v0[3] * cs0[m][2] + v0[2] * cs0[m][3];
                        o1[0] = v1[0] * cs1[m][0] - v1[1] * cs1[m][1]; o1[1] = v1[1] * cs1[m][0] + v1[0] * cs1[m][1];
                        o1[2] = v1[2] * cs1[m][2] - v1[3] * cs1[m][3]; o1[3] = v1[3] * cs1[m][2] + v1[2] * cs1[m][3];
                        *(u32x4*)(base + (size_t)(ai * 128 + m * 16) * 1024 + bj * 128) = pg::pack8(o0, o1);
                    }
                asm volatile("" ::: "memory");
            }
            return;
        }
        if (u.pn < 16) {
            bf16_t* base = XBC + drow0 * 2048 + (u.pn - 8) * 256 + cl;
            bf16_t* hb = HALO + (((size_t)b * 72 + (pos0 >> 5) + wr * 2) * 2) * 2048 + (u.pn - 8) * 256 + cl;
#pragma unroll
            for (int ai = 0; ai < 2; ++ai)
#pragma unroll
                for (int m = 0; m < 4; ++m)
#pragma unroll
                    for (int bj = 0; bj < 2; ++bj) {
                        const u32x4 w = pg::pack8(acc[ai][bj][m][0], acc[ai][bj][m][1]);
                        *(u32x4*)(base + (size_t)(ai * 128 + m * 16) * 2048 + bj * 128) = w;
                        if ((m & 1) == 0) { if (fr == 0) *(u32x4*)(hb + (size_t)((ai * 4 + (m >> 1)) * 2 + 0) * 2048 + bj * 128) = w; }
                        else { if (fr == 15) *(u32x4*)(hb + (size_t)((ai * 4 + (m >> 1)) * 2 + 1) * 2048 + bj * 128) = w; }
                    }
            return;
        }
        if (wc != 0) return;
        float* base = DT + drow0 * 32 + cl;
        const f32x4 db0 = *(const f32x4*)(dtb + cl), db1 = *(const f32x4*)(dtb + cl + 4);
#pragma unroll
        for (int ai = 0; ai < 2; ++ai)
#pragma unroll
            for (int m = 0; m < 4; ++m) {
                f32x4 o0, o1;
#pragma unroll
                for (int i = 0; i < 4; ++i) {
                    const float x0 = acc[ai][0][m][0][i] + db0[i], x1 = acc[ai][0][m][1][i] + db1[i];
                    const float e0 = __expf(-fabsf(x0)), e1 = __expf(-fabsf(x1));
                    o0[i] = fmaxf(x0, 0.f) + (e0 < 0.004f ? e0 * (1.0f - 0.5f * e0) : __logf(1.0f + e0));
                    o1[i] = fmaxf(x1, 0.f) + (e1 < 0.004f ? e1 * (1.0f - 0.5f * e1) : __logf(1.0f + e1));
                }
                *(f32x4*)(base + (size_t)(ai * 128 + m * 16) * 32) = o0; *(f32x4*)(base + (size_t)(ai * 128 + m * 16) * 32 + 4) = o1;
            }
        (void)lane;
    }
};

constexpr int AT_K = 0, AT_V = 32768, AT_KB = 16384, AT_VB = 32768;
static_assert(AT_V + 3 * AT_VB <= RING_BYTES, "attention rings");
DI void attn_unit(KA a, LAS unsigned char* lds, int grp, int b, int head, int qb, int c, int tid_in) {
    int tid = tid_in; asm volatile("" : "+v"(tid));
    const int wid = __builtin_amdgcn_readfirstlane(tid >> 6), lane = tid & 63, l31 = lane & 31, hh = lane >> 5;
    const unsigned qoff = (unsigned)((b * SEQ + qb * 256 + wid * 32 + l31) * 1024 + head * 128);
#define Qg ((const bf16_t*)(a.ws + G_Q) + qoff)
#define Og ((bf16_t*)(a.ws + (c == 0 ? G_O : G_O1)) + qoff)
    const bf16_t* Kg = (const bf16_t*)(a.ws + G_K) + (size_t)b * SALL * 1024 + head * 128;
    const bf16_t* Vg = (const bf16_t*)(a.ws + G_VT) + ((size_t)b * 1024 + head * 128) * SALL;
    const int kr0 = swap23(l31);
    {
        bf16x8 qf[4];
#pragma unroll
        for (int s = 0; s < 4; ++s) qf[s] = *(const bf16x8*)(Qg + c * 64 + 16 * s + 8 * hh);
        f32x16 O[4];
#pragma unroll
        for (int d = 0; d < 4; ++d)
#pragma unroll
            for (int r = 0; r < 16; ++r) O[d][r] = 0.f;
        float mrun = 0.f, lrun = 0.f;
        f32x16 NM;
#pragma unroll
        for (int r = 0; r < 16; ++r) NM[r] = 0.f;
        auto dma_stage = [&](int st, int kk, int kv) {
            const int key0 = st * 128;
            int lane_ = lane; asm volatile("" : "+v"(lane_));
#pragma unroll
            for (int q6 = 0; q6 < 6; ++q6) {
                const int q = wid * 6 + q6;
                if (q < 16) {
                    const int row = 8 * q + (lane_ >> 3), ch = (lane_ & 7) ^ ((row >> 1) & 7);
                    __builtin_amdgcn_global_load_lds((const unsigned*)(Kg + (size_t)(key0 + row) * 1024 + c * 64 + ch * 8), (LAS unsigned*)(lds + AT_K + kk * AT_KB + q * 1024), 16, 0, 0);
                } else {
                    const int d = 4 * (q - 16) + (lane_ >> 4), ch = (lane_ & 15) ^ (d & 15);
                    __builtin_amdgcn_global_load_lds((const unsigned*)(Vg + (size_t)d * SALL + key0 + ch * 8), (LAS unsigned*)(lds + AT_V + kv * AT_VB + (q - 16) * 1024), 16, 0, 0);
                }
            }
        };
#define ATT_LDK(dst, t2, kh) do { const int row_ = (t2) * 64 + (kh) * 32 + kr0; _Pragma("unroll") for (int s = 0; s < 4; ++s) \
            dst[s] = *(const LAS bf16x8*)(Kb + row_ * 128 + (((2 * s + hh) ^ ((row_ >> 1) & 7)) * 16)); } while (0)
#define ATT_LDV(dst, t2, d) do { const int row_ = (d) * 32 + l31; _Pragma("unroll") for (int kh = 0; kh < 2; ++kh) _Pragma("unroll") for (int s2 = 0; s2 < 2; ++s2) \
            dst[kh * 2 + s2] = *(const LAS bf16x8*)(Vb + row_ * 256 + ((((t2) * 8 + kh * 4 + s2 * 2 + hh) ^ (row_ & 15)) * 16)); } while (0)
#define ATT_QK4(Sx, fr) do { Sx = MFMA32(fr[0], qf[0], NM); _Pragma("unroll") for (int s = 1; s < 4; ++s) Sx = MFMA32(fr[s], qf[s], Sx); } while (0)
#define ATT_PV4(Ox, fr) do { _Pragma("unroll") for (int kh = 0; kh < 2; ++kh) _Pragma("unroll") for (int s2 = 0; s2 < 2; ++s2) Ox = MFMA32(fr[kh * 2 + s2], pf[kh][s2], Ox); } while (0)
#define ATT_SG(mask, n) __builtin_amdgcn_sched_group_barrier(mask, n, 0)
#define ATT_PIPE4 do { _Pragma("unroll") for (int i_ = 0; i_ < 4; ++i_) { ATT_SG(0x008, 1); ATT_SG(0x100, 1); } } while (0)
#define ATT_QKALL(kk) do { const LAS unsigned char* Kb = lds + AT_K + (kk) * AT_KB; bf16x8 f0[4], f1[4]; \
            ATT_LDK(f0, 0, 0); ATT_LDK(f1, 0, 1); \
            ATT_QK4(S[0][0], f0); ATT_LDK(f0, 1, 0); \
            ATT_QK4(S[0][1], f1); ATT_LDK(f1, 1, 1); \
            ATT_QK4(S[1][0], f0); \
            ATT_QK4(S[1][1], f1); \
            ATT_SG(0x100, 8); ATT_PIPE4; ATT_PIPE4; ATT_SG(0x008, 8); } while (0)
#define ATT_SM(t2, FIRST, PF) do { \
            float mx = S[t2][0][0]; \
            _Pragma("unroll") for (int r = 0; r < 16; ++r) { mx = fmaxf(mx, S[t2][0][r]); mx = fmaxf(mx, S[t2][1][r]); } \
            { const auto rr = __builtin_amdgcn_permlane32_swap(__float_as_uint(mx), __float_as_uint(mx), false, false); mx = fmaxf(__uint_as_float(rr[0]), __uint_as_float(rr[1])); } \
            const bool first = (FIRST);                        \
            if (first || !__all(mx <= 8.0f)) {                 \
                const float delta = first ? mx : fmaxf(mx, 0.f); \
                if (!first) { \
                    const float alpha = __builtin_amdgcn_exp2f(-delta); \
                    lrun *= alpha; \
                    _Pragma("unroll") for (int d = 0; d < 4; ++d) _Pragma("unroll") for (int r = 0; r < 16; ++r) O[d][r] *= alpha; \
                } \
                mrun += delta; \
                _Pragma("unroll") for (int r = 0; r < 16; ++r) NM[r] = -mrun; \
                  \
                _Pragma("unroll") for (int kh = 0; kh < 2; ++kh) _Pragma("unroll") for (int r = 0; r < 16; ++r) { S[t2][kh][r] -= delta; if ((t2) == 0) S[1][kh][r] -= delta; } \
            } \
            float ls = 0.f; \
            _Pragma("unroll") for (int kh = 0; kh < 2; ++kh) _Pragma("unroll") for (int r = 0; r < 16; ++r) { const float pv = __builtin_amdgcn_exp2f(S[t2][kh][r]); S[t2][kh][r] = pv; ls += pv; } \
            lrun += ls; \
            _Pragma("unroll") for (int kh = 0; kh < 2; ++kh) _Pragma("unroll") for (int s2 = 0; s2 < 2; ++s2) PF[kh][s2] = pack_step(S[t2][kh], s2); } while (0)
#define ATT_PVREST(t2) do { \
            ATT_LDV(f1, t2, 1); \
            ATT_PV4(O[0], f0); ATT_LDV(f0, t2, 2); \
            ATT_PV4(O[1], f1); ATT_LDV(f1, t2, 3); \
            ATT_PV4(O[2], f0); \
            ATT_PV4(O[3], f1); \
            ATT_SG(0x100, 4); ATT_PIPE4; ATT_PIPE4; ATT_SG(0x008, 8); } while (0)
#define ATT_SUB(t2, kv, FIRST) do { const LAS unsigned char* Vb = lds + AT_V + (kv) * AT_VB; bf16x8 f0[4], f1[4]; bf16x8 pf[2][2]; \
            ATT_LDV(f0, t2, 0); ATT_SM(t2, FIRST, pf); ATT_PVREST(t2); } while (0)
#define ATT_PVONLY(t2, kv, PFC) do { const LAS unsigned char* Vb = lds + AT_V + (kv) * AT_VB; bf16x8 f0[4], f1[4]; bf16x8 pf[2][2]; \
            ATT_LDV(f0, t2, 0); \
            _Pragma("unroll") for (int kh = 0; kh < 2; ++kh) _Pragma("unroll") for (int s2 = 0; s2 < 2; ++s2) pf[kh][s2] = PFC[kh][s2]; \
            ATT_PVREST(t2); } while (0)
        f32x16 S[2][2];
        __syncthreads();
        dma_stage(0, 0, 0);
        __syncthreads();
        constexpr int NST = SALL / 128;
        if (wid < 4) {
            int kv = 0;
#pragma unroll 1
            for (int st = 0; st < NST; ++st) {
                const int kk = st & 1, kvn = (kv == 2) ? 0 : kv + 1;
                if (st + 1 < NST) dma_stage(st + 1, kk ^ 1, kvn);
                ATT_QKALL(kk);
                ATT_SUB(0, kv, st == 0);
                ATT_SUB(1, kv, false);
                kv = kvn;
                __syncthreads();
            }
        } else {
            int kv = 0, kvp = 0;
            bf16x8 pfc[2][2];
#pragma unroll 1
            for (int st = 0; st < NST; ++st) {
                const int kk = st & 1, kvn = (kv == 2) ? 0 : kv + 1;
                if (st + 1 < NST) dma_stage(st + 1, kk ^ 1, kvn);
                if (st > 0) ATT_PVONLY(1, kvp, pfc);
                ATT_QKALL(kk);
                ATT_SUB(0, kv, st == 0);
                ATT_SM(1, false, pfc);
                kvp = kv; kv = kvn;
                __syncthreads();
            }
            ATT_PVONLY(1, kvp, pfc);
        }
#undef ATT_LDK
#undef ATT_LDV
#undef ATT_QK4
#undef ATT_PV4
#undef ATT_SG
#undef ATT_PIPE4
#undef ATT_QKALL
#undef ATT_SUB
#undef ATT_SM
#undef ATT_PVREST
#undef ATT_PVONLY
        float ltot; { const auto rr = __builtin_amdgcn_permlane32_swap(__float_as_uint(lrun), __float_as_uint(lrun), false, false); ltot = __uint_as_float(rr[0]) + __uint_as_float(rr[1]); }
        const float inv = 1.0f / ltot;
        __syncthreads();
        LAS unsigned char* ot = lds + wid * 8192;
#pragma unroll
        for (int d = 0; d < 4; ++d)
#pragma unroll
            for (int rp = 0; rp < 2; ++rp) {
                const int r0 = (2 * rp) * 4, r1 = (2 * rp + 1) * 4;
                const unsigned x0 = pk_bf16(O[d][r0 + 0] * inv, O[d][r0 + 1] * inv), x1 = pk_bf16(O[d][r0 + 2] * inv, O[d][r0 + 3] * inv);
                const unsigned y0 = pk_bf16(O[d][r1 + 0] * inv, O[d][r1 + 1] * inv), y1 = pk_bf16(O[d][r1 + 2] * inv, O[d][r1 + 3] * inv);
                const auto s0 = __builtin_amdgcn_permlane32_swap(x0, y0, false, false), s1 = __builtin_amdgcn_permlane32_swap(x1, y1, false, false);
                const u32x4 w = {s0[0], s1[0], s0[1], s1[1]};
                const int ch = d * 4 + 2 * rp + hh;
                *(LAS u32x4*)(ot + l31 * 256 + ((ch ^ (l31 & 15)) * 16)) = w;
            }
        asm volatile("s_waitcnt lgkmcnt(0)" ::: "memory");
        {
            bf16_t* ob = (bf16_t*)(a.ws + (c == 0 ? G_O : G_O1)) + (size_t)(b * SEQ + qb * 256 + wid * 32) * 1024 + head * 128;
            const int rr = lane >> 4, cc = lane & 15;
#pragma unroll
            for (int i = 0; i < 8; ++i) {
                const int row = i * 4 + rr;
                const u32x4 w = *(const LAS u32x4*)(ot + row * 256 + ((cc ^ (row & 15)) * 16));
                *(u32x4*)(ob + (size_t)row * 1024 + cc * 8) = w;
            }
        }
    }
    (void)grp;
#undef Qg
#undef Og
}

DI void p2b_conv(KA a, int bid, int nblk, int tid_in, int nostore) {
    int tid_ = tid_in; asm volatile("" : "+v"(tid_)); const int tid = tid_;
    bf16_t* XBC = (bf16_t*)(a.ws + G_XBC); const bf16_t* HALO = (const bf16_t*)(a.ws + G_HALO);
    const int cg = tid & 255, col = cg * 8;
    const float* cw = a.in[I_CONVW]; const float* cb = a.in[I_CONVB];
    float w0[8], w1[8], w2[8], bb[8];
#pragma unroll
    for (int i = 0; i < 8; ++i) { w0[i] = cw[col + i]; w1[i] = cw[2048 + col + i]; w2[i] = cw[4096 + col + i]; bb[i] = cb[col + i]; }
    for (int it = bid; it < GB * 36; it += nblk) {
        const int b = it / 36, blk = (it % 36) * 2 + (tid >> 8);
        const int pos0 = blk * 32;
        bf16_t* base = XBC + ((size_t)b * SALL + pos0) * 2048 + col;
        const bool first = (blk == 0 || blk == 8), last = (blk == 7 || blk == 71);
        u32x4 prev = (u32x4){0u, 0u, 0u, 0u}, nextblk = (u32x4){0u, 0u, 0u, 0u};
        if (!first) prev = *(const u32x4*)(HALO + (((size_t)b * 72 + blk - 1) * 2 + 1) * 2048 + col);
        if (!last) nextblk = *(const u32x4*)(HALO + (((size_t)b * 72 + blk + 1) * 2 + 0) * 2048 + col);
        u32x4 rows[32];
#pragma unroll
        for (int r = 0; r < 32; ++r) rows[r] = *(const u32x4*)(base + (size_t)r * 2048);
#pragma unroll
        for (int r = 0; r < 32; ++r) {
            const u32x4 pv = (r == 0) ? prev : rows[r - 1], cur = rows[r], nxt = (r < 31) ? rows[r + 1] : nextblk;
            const float p[8] = {bflo(pv.x), bfhi(pv.x), bflo(pv.y), bfhi(pv.y), bflo(pv.z), bfhi(pv.z), bflo(pv.w), bfhi(pv.w)};
            const float c[8] = {bflo(cur.x), bfhi(cur.x), bflo(cur.y), bfhi(cur.y), bflo(cur.z), bfhi(cur.z), bflo(cur.w), bfhi(cur.w)};
            const float n[8] = {bflo(nxt.x), bfhi(nxt.x), bflo(nxt.y), bfhi(nxt.y), bflo(nxt.z), bfhi(nxt.z), bflo(nxt.w), bfhi(nxt.w)};
            float v[8];
#pragma unroll
            for (int i = 0; i < 8; ++i) v[i] = siluf_(bb[i] + w0[i] * p[i] + w1[i] * c[i] + w2[i] * n[i]);
            u32x4 w; w.x = pk_bf16(v[0], v[1]); w.y = pk_bf16(v[2], v[3]); w.z = pk_bf16(v[4], v[5]); w.w = pk_bf16(v[6], v[7]);
            if (!nostore) *(u32x4*)(base + (size_t)r * 2048) = w; else asm volatile("" :: "v"(w.x), "v"(w.y), "v"(w.z), "v"(w.w));
        }
    }
}

constexpr int SS_BUF = 65536, SS_C = 0, SS_B = 16384, SS_X = 32768;
constexpr int SM_SET = 4352;
typedef short s16x4 __attribute__((ext_vector_type(4)));
DI int fsw(int r) { return ((r & 3) << 1) | ((r >> 2) & 1) | (r & 8); }
DI bf16x8 tr_frag(const LAS unsigned char* img, int rowb, int r0, int cblk, int lane) {
    const int i16 = lane & 15, q = i16 >> 2, p = i16 & 3;
    const int ra = r0 + q, rb = r0 + 4 + q, ch = (cblk >> 3) + (p >> 1);
    const s16x4 lo = __builtin_amdgcn_ds_read_tr16_b64_v4i16((LAS s16x4*)(img + ra * rowb + (((ch & 16) | ((ch & 15) ^ fsw(ra))) * 16) + 8 * (p & 1)));
    const s16x4 hi = __builtin_amdgcn_ds_read_tr16_b64_v4i16((LAS s16x4*)(img + rb * rowb + (((ch & 16) | ((ch & 15) ^ fsw(rb))) * 16) + 8 * (p & 1)));
    return __builtin_shufflevector(lo, hi, 0, 1, 2, 3, 4, 5, 6, 7);
}
DI void ssd_unit(KA a, LAS unsigned char* lds, int b, int g, int dir, int tid_in) {
    int tid = tid_in; asm volatile("" : "+v"(tid));
    const int wid = __builtin_amdgcn_readfirstlane(tid >> 6);
    const int hl = wid >> 1, pt = wid & 1, head = g * 4 + hl;
    const bf16_t* xa = (const bf16_t*)(a.ws + G_XBC) + (size_t)b * SALL * 2048;
    const float* dtp = (const float*)(a.ws + G_DT) + (size_t)b * SALL * 32;
    bf16_t* Ybase = (bf16_t*)(a.ws + (dir == 0 ? G_YF : G_YB)) + (size_t)b * SEQ * 1024 + head * 64 + pt * 32;
    const float dsk = (dir == 0) ? a.in[I_DSKIP][head] : 0.f;
    const float av = -__expf(a.in[I_ALOG][dir * 16 + g * 4 + (wid & 3)]);
#define SSD_GEOM(ci, seg0_, t0_) const int seg0_ = ((ci) < 4) ? 0 : CTXL; const int t0_ = (dir == 0) ? (((ci) < 4) ? (ci) : (ci) - 4) * 64 : (((ci) < 4) ? CTXL : SEQ) - 64 * ((((ci) < 4) ? (ci) : (ci) - 4) + 1)
    auto dma_chunk = [&](int ci, int k) {
        SSD_GEOM(ci, seg0, t0);
        const int lane = tid & 63;
#pragma unroll
        for (int q8 = 0; q8 < 8; ++q8) {
            const int q = wid * 8 + q8;
            int row, chp, colbase, imgoff;
            if (q < 32) { row = 4 * (q & 15) + (lane >> 4); chp = lane & 15; colbase = (q < 16) ? 1536 + g * 128 : 1024 + g * 128; imgoff = ((q < 16) ? SS_C : SS_B) + (q & 15) * 1024; }
            else { row = 2 * (q - 32) + (lane >> 5); chp = lane & 31; colbase = g * 256; imgoff = SS_X + (q - 32) * 1024; }
            const int ch = (chp & 16) | ((chp & 15) ^ fsw(row));
            const int tok = seg0 + ((dir == 0) ? t0 + row : t0 + 63 - row);
            __builtin_amdgcn_global_load_lds((const unsigned*)(xa + (size_t)tok * 2048 + colbase + ch * 8), (LAS unsigned*)(lds + k * SS_BUF + imgoff), 16, 0, 0);
        }
    };
    auto step_a = [&](int ci, int k, float dtv) {
        const int lane = tid & 63;
        LAS float* sm = (LAS float*)(lds + EPI_OFF + k * SM_SET);
        float v = dtv * av;
#pragma unroll
        for (int o = 1; o < 64; o <<= 1) { const float n = shidx(v, lane - o); if (lane >= o) v += n; }
        const float tot = shidx(v, 63);
        const int h4 = wid & 3;
        sm[h4 * 64 + lane] = v; sm[256 + h4 * 64 + lane] = dtv; sm[512 + h4 * 64 + lane] = __expf(tot - v) * dtv; sm[768 + h4 * 64 + lane] = __expf(v);
        if (lane == 63) sm[1024 + h4] = __expf(tot);
        (void)ci;
    };
    auto load_dt = [&](int ci) -> float {
        SSD_GEOM(ci, seg0, t0);
        const int lane = tid & 63;
        const int tok = seg0 + ((dir == 0) ? t0 + lane : t0 + 63 - lane);
        return dtp[(size_t)tok * 32 + dir * 16 + g * 4 + (wid & 3)];
    };
    f32x16 hT[4];
#pragma unroll
    for (int n = 0; n < 4; ++n)
#pragma unroll
        for (int r = 0; r < 16; ++r) hT[n][r] = 0.f;
    __syncthreads();
    dma_chunk(0, 0);
    if (wid < 4) step_a(0, 0, load_dt(0));
    __syncthreads();
#pragma unroll 1
    for (int ci = 0; ci < 36; ++ci) {
        const int k = ci & 1;
        const bool isctx = ci < 4;
        SSD_GEOM(ci, seg0_unused, t0); (void)seg0_unused;
        float dtn = 0.f;
        if (ci + 1 < 36) { dma_chunk(ci + 1, k ^ 1); if (wid < 4) dtn = load_dt(ci + 1); }
        int lo_ = tid & 63; asm volatile("" : "+v"(lo_));
        const int lane = lo_, l31 = lo_ & 31, hh = lo_ >> 5;
        const LAS unsigned char* Ci = lds + k * SS_BUF + SS_C; const LAS unsigned char* Bi = lds + k * SS_BUF + SS_B; const LAS unsigned char* Xi = lds + k * SS_BUF + SS_X;
        const LAS float* sm = (const LAS float*)(lds + EPI_OFF + k * SM_SET);
        const LAS float* sm_acum = sm + hl * 64; const LAS float* sm_dt = sm + 256 + hl * 64; const LAS float* sm_w = sm + 512 + hl * 64; const LAS float* sm_ea = sm + 768 + hl * 64;
        const int xcb = hl * 64 + pt * 32 + 16 * ((lane >> 4) & 1);
        if (!isctx) {
            f32x16 accs[2];
#pragma unroll
            for (int it = 0; it < 2; ++it)
#pragma unroll
                for (int r = 0; r < 16; ++r) accs[it][r] = 0.f;
#pragma unroll
            for (int nt = 0; nt < 4; ++nt)
#pragma unroll
                for (int s = 0; s < 2; ++s) {
                    const bf16x8 hb = pack_step(hT[nt], s);
                    const int c0 = nt * 4 + 2 * s;
#pragma unroll
                    for (int it = 0; it < 2; ++it) {
                        const int irow = it * 32 + l31;
                        const u32x2 f0 = *(const LAS u32x2*)(Ci + irow * 256 + ((c0 ^ fsw(irow)) * 16) + 8 * hh), f1 = *(const LAS u32x2*)(Ci + irow * 256 + (((c0 + 1) ^ fsw(irow)) * 16) + 8 * hh);
                        const u32x4 cfw = {f0.x, f0.y, f1.x, f1.y};
                        accs[it] = MFMA32(__builtin_bit_cast(bf16x8, cfw), hb, accs[it]);
                    }
                }
            __builtin_amdgcn_sched_barrier(0);
#pragma unroll
            for (int it = 0; it < 2; ++it) {
                f32x16 acc = accs[it];
                const int irow = it * 32 + l31;
#pragma unroll
                for (int a4 = 0; a4 < 4; ++a4) { const f32x4 e4 = *(const LAS f32x4*)(sm_ea + it * 32 + 8 * a4 + 4 * hh); acc[a4 * 4 + 0] *= e4[0]; acc[a4 * 4 + 1] *= e4[1]; acc[a4 * 4 + 2] *= e4[2]; acc[a4 * 4 + 3] *= e4[3]; }
                const float acum_i = sm_acum[irow];
                __builtin_amdgcn_sched_barrier(0);
#pragma unroll
                for (int jt = 0; jt <= it; ++jt) {
                    f32x16 cb;
#pragma unroll
                    for (int r = 0; r < 16; ++r) cb[r] = 0.f;
                    const int jrow = jt * 32 + l31;
#pragma unroll
                    for (int ks = 0; ks < 8; ++ks) {
                        const bf16x8 bf = *(const LAS bf16x8*)(Bi + jrow * 256 + (((2 * ks + hh) ^ fsw(jrow)) * 16));
                        const bf16x8 cf = *(const LAS bf16x8*)(Ci + irow * 256 + (((2 * ks + hh) ^ fsw(irow)) * 16));
                        cb = MFMA32(bf, cf, cb);
                    }
                    __builtin_amdgcn_sched_barrier(0);
#pragma unroll
                    for (int a4 = 0; a4 < 4; ++a4) {
                        const f32x4 aj = *(const LAS f32x4*)(sm_acum + jt * 32 + 8 * a4 + 4 * hh), dj = *(const LAS f32x4*)(sm_dt + jt * 32 + 8 * a4 + 4 * hh);
#pragma unroll
                        for (int b4 = 0; b4 < 4; ++b4) {
                            const float dec = __expf(fminf(acum_i - aj[b4], 0.f)) * dj[b4];
                            const int j = jt * 32 + 8 * a4 + 4 * hh + b4;
                            cb[a4 * 4 + b4] = (jt < it || j <= irow) ? cb[a4 * 4 + b4] * dec : 0.f;
                        }
                    }
#pragma unroll
                    for (int s = 0; s < 2; ++s) {
                        const int i16 = lane & 15, q = i16 >> 2, p = i16 & 3, ch = (xcb >> 3) + (p >> 1);
                        const int ra = jt * 32 + 16 * s + 4 * hh + q, rb = ra + 8;
                        const s16x4 lo = __builtin_amdgcn_ds_read_tr16_b64_v4i16((LAS s16x4*)(Xi + ra * 512 + (((ch & 16) | ((ch & 15) ^ fsw(ra))) * 16) + 8 * (p & 1)));
                        const s16x4 hi = __builtin_amdgcn_ds_read_tr16_b64_v4i16((LAS s16x4*)(Xi + rb * 512 + (((ch & 16) | ((ch & 15) ^ fsw(rb))) * 16) + 8 * (p & 1)));
                        acc = MFMA32(pack_step(cb, s), __builtin_shufflevector(lo, hi, 0, 1, 2, 3, 4, 5, 6, 7), acc);
                    }
                    __builtin_amdgcn_sched_barrier(0);
                }
                LAS unsigned char* yt = lds + YT_OFF + wid * 2048;
#pragma unroll
                for (int rq = 0; rq < 4; ++rq) {
                    const int i16 = lane & 15, q = i16 >> 2, p = i16 & 3, ch = (xcb >> 3) + (p >> 1);
                    const int ra = it * 32 + 8 * rq + 4 * hh + q;
                    const s16x4 xs = __builtin_amdgcn_ds_read_tr16_b64_v4i16((LAS s16x4*)(Xi + ra * 512 + (((ch & 16) | ((ch & 15) ^ fsw(ra))) * 16) + 8 * (p & 1)));
#pragma unroll
                    for (int j = 0; j < 4; ++j) *(LAS bf16_t*)(yt + (8 * rq + 4 * hh + j) * 64 + l31 * 2) = f2bf(acc[rq * 4 + j] + dsk * bf2f((bf16_t)xs[j]));
                }
                __builtin_amdgcn_sched_barrier(0);
#pragma unroll
                for (int q2 = 0; q2 < 2; ++q2) {
                    const int idx = q2 * 64 + lane, rw = idx >> 2, c4 = idx & 3;
                    const int i = it * 32 + rw, tnat = (dir == 0) ? t0 + i : t0 + 63 - i;
                    *(u32x4*)(Ybase + (size_t)tnat * 1024 + c4 * 8) = *(const LAS u32x4*)(yt + rw * 64 + c4 * 16);
                }
                __builtin_amdgcn_sched_barrier(0);
            }
        }
        {
            const float dec = sm[1024 + hl];
            bf16x8 wx[4];
#pragma unroll
            for (int ks = 0; ks < 4; ++ks) {
                const bf16x8 xf = tr_frag(Xi, 512, 16 * ks + 8 * hh, xcb, lane);
                const f32x4 wa = *(const LAS f32x4*)(sm_w + 16 * ks + 8 * hh), wb = *(const LAS f32x4*)(sm_w + 16 * ks + 8 * hh + 4);
                u32x4 o;
                o.x = pk_bf16(bf2f((bf16_t)xf[0]) * wa[0], bf2f((bf16_t)xf[1]) * wa[1]); o.y = pk_bf16(bf2f((bf16_t)xf[2]) * wa[2], bf2f((bf16_t)xf[3]) * wa[3]);
                o.z = pk_bf16(bf2f((bf16_t)xf[4]) * wb[0], bf2f((bf16_t)xf[5]) * wb[1]); o.w = pk_bf16(bf2f((bf16_t)xf[6]) * wb[2], bf2f((bf16_t)xf[7]) * wb[3]);
                wx[ks] = __builtin_bit_cast(bf16x8, o);
            }
            __builtin_amdgcn_sched_barrier(0);
#pragma unroll
            for (int nt = 0; nt < 4; ++nt) {
#pragma unroll
                for (int r = 0; r < 16; ++r) hT[nt][r] *= dec;
#pragma unroll
                for (int ks = 0; ks < 4; ++ks) {
                    const bf16x8 bt = tr_frag(Bi, 256, 16 * ks + 8 * hh, nt * 32 + 16 * ((lane >> 4) & 1), lane);
                    hT[nt] = MFMA32(bt, wx[ks], hT[nt]);
                }
                __builtin_amdgcn_sched_barrier(0);
            }
        }
        if (ci + 1 < 36 && wid < 4) step_a(ci + 1, k ^ 1, dtn);
        __syncthreads();
    }
#undef SSD_GEOM
}

DI void attn_finalize(KA a, int bid, int nblk, int tid_in) {
    int tid_ = tid_in; asm volatile("" : "+v"(tid_)); const int tid = tid_, wid = tid >> 6, lane = tid & 63;
    bf16_t* O0 = (bf16_t*)(a.ws + G_O); const bf16_t* O1 = (const bf16_t*)(a.ws + G_O1);
    float lam;
    { const float p1 = wave_sum(a.in[I_LQ1][lane] * a.in[I_LK1][lane], lane), p2 = wave_sum(a.in[I_LQ2][lane] * a.in[I_LK2][lane], lane); lam = __expf(p1) - __expf(p2) + LAM_INIT; }
    const float* gs = a.in[I_GSUB] + (lane & 7) * 16;
    float g[16];
#pragma unroll
    for (int i = 0; i < 16; ++i) g[i] = gs[i] * (1.0f - LAM_INIT);
    const int stride = nblk * 8;
    for (int row0 = bid * 8 + wid; row0 < TG; row0 += 8 * stride) {
        u32x4 av[8][2], bv[8][2];
#pragma unroll
        for (int j = 0; j < 8; ++j) {
            const size_t off = (size_t)min(row0 + j * stride, TG - 1) * 1024 + lane * 16;
            av[j][0] = *(const u32x4*)(O0 + off); av[j][1] = *(const u32x4*)(O0 + off + 8); bv[j][0] = *(const u32x4*)(O1 + off); bv[j][1] = *(const u32x4*)(O1 + off + 8);
        }
#pragma unroll
        for (int j = 0; j < 8; ++j) {
            const int row = row0 + j * stride;
            if (row >= TG) break;
            const size_t off = (size_t)row * 1024 + lane * 16;
            const unsigned aw[8] = {av[j][0].x, av[j][0].y, av[j][0].z, av[j][0].w, av[j][1].x, av[j][1].y, av[j][1].z, av[j][1].w};
            const unsigned bw[8] = {bv[j][0].x, bv[j][0].y, bv[j][0].z, bv[j][0].w, bv[j][1].x, bv[j][1].y, bv[j][1].z, bv[j][1].w};
            float o[16]; float ss = 0.f;
#pragma unroll
            for (int i = 0; i < 8; ++i) { o[2 * i] = bflo(aw[i]) - lam * bflo(bw[i]); o[2 * i + 1] = bfhi(aw[i]) - lam * bfhi(bw[i]); ss += o[2 * i] * o[2 * i] + o[2 * i + 1] * o[2 * i + 1]; }
            ss = grp8_sum(ss);
            const float rs = rsqrtf(ss * (1.0f / 128.0f) + EPS);
            u32x4 w0, w1;
            w0.x = pk_bf16(o[0] * rs * g[0], o[1] * rs * g[1]); w0.y = pk_bf16(o[2] * rs * g[2], o[3] * rs * g[3]); w0.z = pk_bf16(o[4] * rs * g[4], o[5] * rs * g[5]); w0.w = pk_bf16(o[6] * rs * g[6], o[7] * rs * g[7]);
            w1.x = pk_bf16(o[8] * rs * g[8], o[9] * rs * g[9]); w1.y = pk_bf16(o[10] * rs * g[10], o[11] * rs * g[11]); w1.z = pk_bf16(o[12] * rs * g[12], o[13] * rs * g[13]); w1.w = pk_bf16(o[14] * rs * g[14], o[15] * rs * g[15]);
            *(u32x4*)(O0 + off) = w0; *(u32x4*)(O0 + off + 8) = w1;
        }
    }
}

struct SchedPlain {
    const bf16_t* A; const bf16_t* Bt; int nM, nN, K, G, c;
    DI bool next(int i, pg::Unit& u) const {
        const int L = i * G + c; if (L >= nM * nN) return false;
        pg::decode_tiles(L, nM, nN, u.pm, u.pn); u.kind = 0; u.aux = 0; return true;
    }
    static constexpr bool GATHER = false; static constexpr bool AUX = false;
    DI const char* a_tile(const pg::Unit& u) const { return (const char*)(A + (size_t)u.pm * 256 * K); }
    DI int a_row(const pg::Unit&, int) const { return 0; }
    DI const char* b_base(const pg::Unit& u) const { return (const char*)(Bt + (size_t)u.pn * 256 * K); }
};
struct EpiZG {
    const bf16_t* YF; const bf16_t* YB; bf16_t* YN; bf16_t* Gt; const float* gnorm; LAS float* scr;
    DI void operator()(const f32x4 (&acc)[2][2][4][2], const pg::Unit& u, int wr, int wc, int fr, int fq, int lane) const {
        const int rl = wr * 64 + fr, cl = wc * 32 + 8 * fq;
        const size_t row0 = (size_t)(u.pm * 256 + rl);
        if (u.pn >= 4) {
            bf16_t* gb = Gt + row0 * 2048 + (u.pn - 4) * 256 + cl;
#pragma unroll
            for (int ai = 0; ai < 2; ++ai)
#pragma unroll
                for (int m = 0; m < 4; ++m)
#pragma unroll
                    for (int bj = 0; bj < 2; ++bj) {
                        f32x4 s0, s1;
#pragma unroll
                        for (int i = 0; i < 4; ++i) { s0[i] = sigmoidf_(acc[ai][bj][m][0][i]); s1[i] = sigmoidf_(acc[ai][bj][m][1][i]); }
                        *(u32x4*)(gb + (size_t)(ai * 128 + m * 16) * 2048 + bj * 128) = pg::pack8(s0, s1);
                    }
            return;
        }
        const bf16_t* yfb = YF + row0 * 1024 + u.pn * 256 + cl; const bf16_t* ybb = YB + row0 * 1024 + u.pn * 256 + cl;
        u32x4 yp[2][4][2];
#pragma unroll
        for (int ai = 0; ai < 2; ++ai)
#pragma unroll
            for (int mh = 0; mh < 2; ++mh) {
                u32x4 fw[2][2], bw[2][2];
#pragma unroll
                for (int mm = 0; mm < 2; ++mm)
#pragma unroll
                    for (int bj = 0; bj < 2; ++bj) { const size_t o = (size_t)(ai * 128 + (mh * 2 + mm) * 16) * 1024 + bj * 128; fw[mm][bj] = *(const u32x4*)(yfb + o); bw[mm][bj] = *(const u32x4*)(ybb + o); }
#pragma unroll
                for (int mm = 0; mm < 2; ++mm) {
                    const int m = mh * 2 + mm; float ss = 0.f;
#pragma unroll
                    for (int bj = 0; bj < 2; ++bj) {
                        const u32x4 f = fw[mm][bj], b2 = bw[mm][bj];
                        const float yv[8] = {bflo(f.x) + bflo(b2.x), bfhi(f.x) + bfhi(b2.x), bflo(f.y) + bflo(b2.y), bfhi(f.y) + bfhi(b2.y),
                                             bflo(f.z) + bflo(b2.z), bfhi(f.z) + bfhi(b2.z), bflo(f.w) + bflo(b2.w), bfhi(f.w) + bfhi(b2.w)};
                        float y[8];
#pragma unroll
                        for (int n = 0; n < 2; ++n)
#pragma unroll
                            for (int i = 0; i < 4; ++i) { const float z = acc[ai][bj][m][n][i]; y[n * 4 + i] = yv[n * 4 + i] * siluf_(z); ss += y[n * 4 + i] * y[n * 4 + i]; }
                        u32x4 w; w.x = pk_bf16(y[0], y[1]); w.y = pk_bf16(y[2], y[3]); w.z = pk_bf16(y[4], y[5]); w.w = pk_bf16(y[6], y[7]);
                        asm volatile("" : "+v"(w.x), "+v"(w.y), "+v"(w.z), "+v"(w.w));
                        yp[ai][m][bj] = w;
                    }
                    ss += shx(ss, 16, lane); ss += shx(ss, 32, lane);
                    if (fq == 0) scr[(ai * 128 + m * 16 + rl) * 4 + wc] = ss;
                }
                asm volatile("" ::: "memory");
            }
        asm volatile("s_waitcnt lgkmcnt(0)" ::: "memory"); __builtin_amdgcn_s_barrier(); asm volatile("" ::: "memory");
        bf16_t* ynb = YN + row0 * 1024 + u.pn * 256 + cl;
        f32x4 g0[2], g1[2];
#pragma unroll
        for (int bj = 0; bj < 2; ++bj) { g0[bj] = *(const f32x4*)(gnorm + u.pn * 256 + bj * 128 + cl); g1[bj] = *(const f32x4*)(gnorm + u.pn * 256 + bj * 128 + cl + 4); }
#pragma unroll
        for (int ai = 0; ai < 2; ++ai)
#pragma unroll
            for (int m = 0; m < 4; ++m) {
                const f32x4 ps = *(const LAS f32x4*)(scr + (ai * 128 + m * 16 + rl) * 4);
                const float rs = rsqrtf((ps[0] + ps[1] + ps[2] + ps[3]) * (1.0f / 256.0f) + EPS);
#pragma unroll
                for (int bj = 0; bj < 2; ++bj) {
                    const u32x4 w = yp[ai][m][bj];
                    const f32x4 y0 = {bflo(w.x), bfhi(w.x), bflo(w.y), bfhi(w.y)}, y1 = {bflo(w.z), bfhi(w.z), bflo(w.w), bfhi(w.w)};
                    *(u32x4*)(ynb + (size_t)(ai * 128 + m * 16) * 1024 + bj * 128) = pg::pack8(y0 * rs * g0[bj], y1 * rs * g1[bj]);
                }
            }
        asm volatile("s_waitcnt lgkmcnt(0)" ::: "memory"); __builtin_amdgcn_s_barrier(); asm volatile("" ::: "memory");
    }
};
struct EpiBranchA {
    const bf16_t* Gt; bf16_t* P;
    DI void operator()(const f32x4 (&acc)[2][2][4][2], const pg::Unit& u, int wr, int wc, int fr, int fq, int) const {
        pg::for_each8(acc, wr, wc, fr, fq, [&](int r, int c, const f32x4& v0, const f32x4& v1) {
            const int R = u.pm * 256 + r, col = u.pn * 256 + c;
            const u32x4 gw = *(const u32x4*)(Gt + (size_t)R * 2048 + col);
            const f32x4 g0 = {bflo(gw.x), bfhi(gw.x), bflo(gw.y), bfhi(gw.y)}, g1 = {bflo(gw.z), bfhi(gw.z), bflo(gw.w), bfhi(gw.w)};
            *(u32x4*)(P + (size_t)R * 1024 + col) = pg::pack8(v0 * g0, v1 * g1);
        });
    }
};
struct EpiBranchS {
    const bf16_t* Gt; const bf16_t* P; bf16_t* U;
    DI void operator()(const f32x4 (&acc)[2][2][4][2], const pg::Unit& u, int wr, int wc, int fr, int fq, int) const {
        pg::for_each8(acc, wr, wc, fr, fq, [&](int r, int c, const f32x4& v0, const f32x4& v1) {
            const int R = u.pm * 256 + r, col = u.pn * 256 + c;
            const u32x4 gw = *(const u32x4*)(Gt + (size_t)R * 2048 + 1024 + col), pw = *(const u32x4*)(P + (size_t)R * 1024 + col);
            const f32x4 g0 = {bflo(gw.x), bfhi(gw.x), bflo(gw.y), bfhi(gw.y)}, g1 = {bflo(gw.z), bfhi(gw.z), bflo(gw.w), bfhi(gw.w)};
            const f32x4 p0 = {bflo(pw.x), bfhi(pw.x), bflo(pw.y), bfhi(pw.y)}, p1 = {bflo(pw.z), bfhi(pw.z), bflo(pw.w), bfhi(pw.w)};
            *(u32x4*)(U + (size_t)R * 1024 + col) = pg::pack8(p0 + v0 * g0, p1 + v1 * g1);
        });
    }
};
struct SchedBranches {
    const bf16_t* O; const bf16_t* YN; const bf16_t* Wa; const bf16_t* Ws; int G, c;
    static constexpr bool GATHER = false; static constexpr bool AUX = false;
    DI bool next(int i, pg::Unit& u) const {
        const int L = i * G + c; if (i >= 2 || c >= (TG / 256) * 4) return false;
        pg::decode_tiles(c, TG / 256, 4, u.pm, u.pn); u.kind = i; u.aux = 0; (void)L; return true;
    }
    DI const char* a_tile(const pg::Unit& u) const { const long d = (const char*)YN - (const char*)O; return (const char*)O + (u.kind ? d : 0L) + (size_t)u.pm * 256 * 1024 * 2; }
    DI int a_row(const pg::Unit&, int) const { return 0; }
    DI const char* b_base(const pg::Unit& u) const { const long d = (const char*)Ws - (const char*)Wa; return (const char*)Wa + (u.kind ? d : 0L) + (size_t)u.pn * 256 * 1024 * 2; }
};
struct EpiBranches {
    const bf16_t* Gt; bf16_t* P; bf16_t* U;
    DI void operator()(const f32x4 (&acc)[2][2][4][2], const pg::Unit& u, int wr, int wc, int fr, int fq, int) const {
        const size_t row0 = (size_t)(u.pm * 256 + wr * 64 + fr); const int col0 = u.pn * 256 + wc * 32 + 8 * fq;
        const bf16_t* gb = Gt + row0 * 2048 + (u.kind == 0 ? 0 : 1024) + col0;
        bf16_t* pb = P + row0 * 1024 + col0; bf16_t* ub = U + row0 * 1024 + col0;
#pragma unroll
        for (int ai = 0; ai < 2; ++ai) {
            u32x4 gw[4][2], pw[4][2];
#pragma unroll
            for (int m = 0; m < 4; ++m)
#pragma unroll
                for (int bj = 0; bj < 2; ++bj) {
                    gw[m][bj] = *(const u32x4*)(gb + (size_t)(ai * 128 + m * 16) * 2048 + bj * 128);
                    if (u.kind != 0) pw[m][bj] = *(const u32x4*)(pb + (size_t)(ai * 128 + m * 16) * 1024 + bj * 128);
                }
#pragma unroll
            for (int m = 0; m < 4; ++m)
#pragma unroll
                for (int bj = 0; bj < 2; ++bj) {
                    const u32x4 g = gw[m][bj];
                    const f32x4 g0 = {bflo(g.x), bfhi(g.x), bflo(g.y), bfhi(g.y)}, g1 = {bflo(g.z), bfhi(g.z), bflo(g.w), bfhi(g.w)};
                    if (u.kind == 0) *(u32x4*)(pb + (size_t)(ai * 128 + m * 16) * 1024 + bj * 128) = pg::pack8(acc[ai][bj][m][0] * g0, acc[ai][bj][m][1] * g1);
                    else {
                        const u32x4 q = pw[m][bj];
                        const f32x4 p0 = {bflo(q.x), bfhi(q.x), bflo(q.y), bfhi(q.y)}, p1 = {bflo(q.z), bfhi(q.z), bflo(q.w), bfhi(q.w)};
                        *(u32x4*)(ub + (size_t)(ai * 128 + m * 16) * 1024 + bj * 128) = pg::pack8(p0 + acc[ai][bj][m][0] * g0, p1 + acc[ai][bj][m][1] * g1);
                    }
                }
            asm volatile("" ::: "memory");
        }
    }
};
struct EpiPlainBf16 {
    bf16_t* O; int ldc;
    DI void operator()(const f32x4 (&acc)[2][2][4][2], const pg::Unit& u, int wr, int wc, int fr, int fq, int) const {
        bf16_t* base = O + (size_t)(u.pm * 256 + wr * 64 + fr) * ldc + u.pn * 256 + wc * 32 + 8 * fq;
#pragma unroll
        for (int ai = 0; ai < 2; ++ai)
#pragma unroll
            for (int m = 0; m < 4; ++m)
#pragma unroll
                for (int bj = 0; bj < 2; ++bj) *(u32x4*)(base + (size_t)(ai * 128 + m * 16) * ldc + bj * 128) = pg::pack8(acc[ai][bj][m][0], acc[ai][bj][m][1]);
    }
};

DI void p8_post(KA a, int grp, int bid, int nblk, int tid_in) {
    int tid_ = tid_in; asm volatile("" : "+v"(tid_)); const int tid = tid_, wid = tid >> 6, lane = tid & 63;
    const bf16_t* MIX = (const bf16_t*)(a.ws + G_MIX); bf16_t* H2 = (bf16_t*)(a.ws + G_H2);
    const float* MOD = (const float*)(a.ws + WS_MOD);
    f32x4 g1[4], g2[4];
#pragma unroll
    for (int i = 0; i < 4; ++i) { g1[i] = *(const f32x4*)(a.in[I_GPOST1] + i * 256 + lane * 4); g2[i] = *(const f32x4*)(a.in[I_GPRE2] + i * 256 + lane * 4); }
    const int stride = nblk * 8;
    for (int row0 = bid * 8 + wid; row0 < TG; row0 += 2 * stride) {
        u32x2 mw[2][4]; f32x4 xvv[2][4], gt[2][4], sh[2][4], sc[2][4];
#pragma unroll
        for (int j = 0; j < 2; ++j) {
            const int row = min(row0 + j * stride, TG - 1), grow = grp * TG + row; const float* md = MOD + (grow >> 11) * 6144;
            const float* xs = a.in[I_X] + (size_t)grow * 1024; const bf16_t* ms = MIX + (size_t)row * 1024;
#pragma unroll
            for (int i = 0; i < 4; ++i) { const int c = i * 256 + lane * 4; mw[j][i] = *(const u32x2*)(ms + c); xvv[j][i] = __builtin_nontemporal_load((const f32x4*)(xs + c));
                gt[j][i] = *(const f32x4*)(md + 2048 + c); sh[j][i] = *(const f32x4*)(md + 3072 + c); sc[j][i] = *(const f32x4*)(md + 4096 + c); }
        }
#pragma unroll
        for (int j = 0; j < 2; ++j) {
            const int row = row0 + j * stride;
            if (row >= TG) break;
            bf16_t* od = (bf16_t*)(a.ws + G_X1) + (size_t)row * 1024;
            f32x4 mv[4]; float ss = 0.f;
#pragma unroll
            for (int i = 0; i < 4; ++i) { mv[i] = (f32x4){bflo(mw[j][i].x), bfhi(mw[j][i].x), bflo(mw[j][i].y), bfhi(mw[j][i].y)}; ss += mv[i][0] * mv[i][0] + mv[i][1] * mv[i][1] + mv[i][2] * mv[i][2] + mv[i][3] * mv[i][3]; }
            ss = wave_sum(ss, lane);
            const float rs = rsqrtf(ss * (1.0f / 1024.0f) + EPS);
            float s2 = 0.f;
#pragma unroll
            for (int i = 0; i < 4; ++i) {
                const int c = i * 256 + lane * 4;
                xvv[j][i] = xvv[j][i] + gt[j][i] * (mv[i] * rs * g1[i]);
                { u32x2 w; w.x = pk_bf16(xvv[j][i][0], xvv[j][i][1]); w.y = pk_bf16(xvv[j][i][2], xvv[j][i][3]); *(u32x2*)(od + c) = w; }
                s2 += xvv[j][i][0] * xvv[j][i][0] + xvv[j][i][1] * xvv[j][i][1] + xvv[j][i][2] * xvv[j][i][2] + xvv[j][i][3] * xvv[j][i][3];
            }
            s2 = wave_sum(s2, lane);
            const float rs2 = rsqrtf(s2 * (1.0f / 1024.0f) + EPS);
#pragma unroll
            for (int i = 0; i < 4; ++i) {
                const int c = i * 256 + lane * 4;
                const f32x4 y = xvv[j][i] * rs2 * g2[i] * (sc[j][i] + 1.0f) + sh[j][i];
                u32x2 w; w.x = pk_bf16(y[0], y[1]); w.y = pk_bf16(y[2], y[3]);
                *(u32x2*)(H2 + (size_t)row * 1024 + c) = w;
            }
        }
    }
}

struct EpiQ1 {
    bf16_t* HID; float* LOG;
    DI void operator()(const f32x4 (&acc)[2][2][4][2], const pg::Unit& u, int wr, int wc, int fr, int fq, int) const {
        if (u.pn == 2) {
            pg::for_each8(acc, wr, wc, fr, fq, [&](int r, int c, const f32x4& v0, const f32x4& v1) {
                if (c >= 64) return;
                float* o = LOG + (size_t)(u.pm * 256 + r) * 64 + c; *(f32x4*)o = v0; *(f32x4*)(o + 4) = v1;
            });
            return;
        }
#pragma unroll
        for (int ai = 0; ai < 2; ++ai)
#pragma unroll
            for (int m = 0; m < 4; ++m) {
                f32x4 h0, h1;
#pragma unroll
                for (int i = 0; i < 4; ++i) { h0[i] = siluf_(acc[ai][0][m][0][i]) * acc[ai][1][m][0][i]; h1[i] = siluf_(acc[ai][0][m][1][i]) * acc[ai][1][m][1][i]; }
                *(u32x4*)(HID + (size_t)(u.pm * 256 + wr * 64 + fr) * 256 + u.pn * 128 + wc * 32 + 8 * fq + (size_t)(ai * 128 + m * 16) * 256) = pg::pack8(h0, h1);
            }
    }
};
DI void q2_route(KA a, LAS unsigned char* lds, int bid, int nblk, int tid_in) {
    int tid_ = tid_in; asm volatile("" : "+v"(tid_)); const int tid = tid_, wid = tid >> 6, lane = tid & 63;
    const float* LOG = (const float*)(a.ws + M_LOG); int* TOPE = (int*)(a.ws + M_TOPE); float* TOPW = (float*)(a.ws + M_TOPW); int* TPOS = (int*)(a.ws + M_TPOS);
    int* BCNT = (int*)(a.ws + M_BCNT);
    LAS int* hist = (LAS int*)lds;
    if (tid < NQ * NEXP) hist[tid] = 0;
    __syncthreads();
    const float bias = a.in[I_RB][lane];
    for (int t = bid * 8 + wid; t < TG; t += nblk * 8) {
        const int qq = t / QT;
        const float score = sigmoidf_(LOG[(size_t)t * 64 + lane]);
        const float sel = score + bias;
        float m1 = sel;
        m1 = grp8_max(m1);
        int i1 = (sel == m1) ? lane : 64;
        i1 = grp8_min(i1);
        float m2 = (lane == i1) ? -INFINITY : sel;
        m2 = grp8_max(m2);
        const float gs = m1 + m2; const int myg = lane >> 3;
        int grank = 0;
#pragma unroll
        for (int g2 = 0; g2 < 8; ++g2) { const float o = __int_as_float(__builtin_amdgcn_readlane(__float_as_int(gs), g2 * 8)); grank += (o > gs || (o == gs && g2 < myg)) ? 1 : 0; }
        const float v = (grank < 4) ? sel : -INFINITY;
        int rank = 0;
        const unsigned long long gmask = __builtin_amdgcn_ballot_w64(grank < 4);
#pragma unroll 1
        for (int g2 = 0; g2 < 8; ++g2) {
            if (!((gmask >> (g2 * 8)) & 1ull)) continue;
#pragma unroll
            for (int e3 = 0; e3 < 8; ++e3) { const int e2 = g2 * 8 + e3; const float o = __int_as_float(__builtin_amdgcn_readlane(__float_as_int(v), e2)); rank += (o > v || (o == v && e2 < lane)) ? 1 : 0; }
        }
        const bool chosen = (rank < 8) && (grank < 4);
        const float wsum = wave_sum(chosen ? score : 0.f, lane);
        if (chosen) {
            const int pos = __hip_atomic_fetch_add(&hist[qq * NEXP + lane], 1, __ATOMIC_RELAXED, __HIP_MEMORY_SCOPE_WORKGROUP);
            TOPE[t * 8 + rank] = lane; TOPW[t * 8 + rank] = score / wsum * 2.5f; TPOS[t * 8 + rank] = pos;
        }
    }
    __syncthreads();
    if (tid < NQ * NEXP) BCNT[((tid >> 6) * 1024 + bid) * NEXP + (tid & 63)] = hist[tid];
}
DI void q3_scatter(KA a, LAS unsigned char* lds, int bid, int nblk, int tid_in) {
    int tid_ = tid_in; asm volatile("" : "+v"(tid_)); const int tid = tid_, wid = tid >> 6, lane = tid & 63;
    LAS int* tot = (LAS int*)lds; LAS int* base = tot + NQ * 64; LAS int* offs = base + NQ * 64;
    const int* BCNT = (const int*)(a.ws + M_BCNT);
    {
        const int ce = tid & 127, part = tid >> 7, qq = ce >> 6, e = ce & 63;
        int t_ = 0, p_ = 0;
        const int b0 = part * ((nblk + 3) >> 2), b1 = min(nblk, b0 + ((nblk + 3) >> 2));
#pragma unroll 8
        for (int b = b0; b < b1; ++b) { const int c = BCNT[(qq * 1024 + b) * NEXP + e]; t_ += c; p_ += (b < bid) ? c : 0; }
        LAS int* part_t = offs + NQ * 128; LAS int* part_p = part_t + 512;
        part_t[tid] = t_; part_p[tid] = p_;
        __syncthreads();
        if (tid < NQ * NEXP) { tot[tid] = part_t[tid] + part_t[tid + 128] + part_t[tid + 256] + part_t[tid + 384]; base[tid] = part_p[tid] + part_p[tid + 128] + part_p[tid + 256] + part_p[tid + 384]; }
    }
    __syncthreads();
    if (tid < NQ) { int o = 0; for (int e = 0; e < NEXP; ++e) { offs[tid * 128 + e] = o; o += (tot[tid * 64 + e] + 255) & ~255; } offs[tid * 128 + 64] = o; offs[tid * 128 + 65] = o >> 8; }
    __syncthreads();
    if (tid < NQ * NEXP) base[tid] += offs[(tid >> 6) * 128 + (tid & 63)];
    if (bid == 0 && tid < NQ * 128) ((int*)(a.ws + M_OFFS))[tid] = ((tid & 127) < 66) ? offs[tid] : 0;
    if (bid == 0 && tid < NQ * NEXP) { const int qq = tid >> 6, e = tid & 63; int* TILE = (int*)(a.ws + M_TILE) + qq * 1024; for (int tt = offs[qq * 128 + e] >> 8; tt < (offs[qq * 128 + e + 1] >> 8); ++tt) TILE[tt] = e; }
    __syncthreads();
    const int* TOPE = (const int*)(a.ws + M_TOPE); const int* TPOS = (const int*)(a.ws + M_TPOS); int* ROWL = (int*)(a.ws + M_ROWL);
    for (int t = bid * 8 + wid; t < TG; t += nblk * 8)
        if (lane < 8) { const int qq = t / QT, idx = t * 8 + lane; const size_t rp = (size_t)qq * MAXROWS + base[qq * 64 + TOPE[idx]] + TPOS[idx]; ROWL[rp] = idx - qq * QT * 8; }
    for (int idx = bid * NT + tid; idx < NQ * NEXP * 256; idx += nblk * NT) {
        const int qq = idx >> 14, e = (idx >> 8) & 63, k = idx & 255, c = tot[qq * 64 + e], pad = ((c + 255) & ~255) - c;
        if (k < pad) ROWL[(size_t)qq * MAXROWS + offs[qq * 128 + e] + c + k] = -1;
    }
    __syncthreads();
}
DI void moe_offsets(KA a, LAS int* offs, LAS unsigned char* lds, int tid) {
    if (tid < NQ * 128) offs[tid] = ((const int*)(a.ws + M_OFFS))[tid];
    LAS int* tl = (LAS int*)(lds + YT_OFF);
    for (int i = tid; i < NQ * 1024; i += NT) tl[i] = ((const int*)(a.ws + M_TILE))[i];
    __syncthreads();
}
struct SchedQ4 {
    const bf16_t* H2; const bf16_t* W1; const int* ROWL; const LAS int* offs; const LAS int* TILE; int G, c;
    static constexpr bool GATHER = true; static constexpr bool AUX = false;
    DI bool next(int i, pg::Unit& u) const {
        const int L = i * G + c; const int t0 = __builtin_amdgcn_readfirstlane(offs[65]), t1 = (NQ > 1) ? __builtin_amdgcn_readfirstlane(offs[(NQ > 1 ? 128 : 0) + 65]) : 0; if (L >= (t0 + t1) * 2) return false;
        pg::decode_tiles(L, t0 + t1, 2, u.pm, u.pn);
        const int qq = (u.pm >= t0) ? 1 : 0; u.pm -= qq * t0;
        u.kind = qq; u.aux = __builtin_amdgcn_readfirstlane(TILE[qq * 1024 + u.pm]); return true;
    }
    DI const char* a_tile(const pg::Unit& u) const { return (const char*)(H2 + (size_t)u.kind * QT * 1024); }
    DI int a_row(const pg::Unit& u, int r) const { const int id = ROWL[(size_t)u.kind * MAXROWS + u.pm * 256 + r]; return id < 0 ? 0 : (id >> 3); }
    DI const char* b_base(const pg::Unit& u) const { return (const char*)(W1 + ((size_t)u.aux * 512 + u.pn * 256) * 1024); }
};
struct EpiQ4 {
    bf16_t* HID;
    DI void operator()(const f32x4 (&acc)[2][2][4][2], const pg::Unit& u, int wr, int wc, int fr, int fq, int) const {
        bf16_t* base = HID + ((size_t)u.kind * MAXROWS + u.pm * 256 + wr * 64 + fr) * 256 + u.pn * 128 + wc * 32 + 8 * fq;
#pragma unroll
        for (int ai = 0; ai < 2; ++ai)
#pragma unroll
            for (int m = 0; m < 4; ++m) {
                f32x4 h0, h1;
#pragma unroll
                for (int i = 0; i < 4; ++i) { h0[i] = siluf_(acc[ai][0][m][0][i]) * acc[ai][1][m][0][i]; h1[i] = siluf_(acc[ai][0][m][1][i]) * acc[ai][1][m][1][i]; }
                *(u32x4*)(base + (size_t)(ai * 128 + m * 16) * 256) = pg::pack8(h0, h1);
            }
    }
};
struct SchedQ5 {
    const bf16_t* HID; const bf16_t* HIDS; const bf16_t* W2; const LAS int* offs; const LAS int* TILE; int G, c;
    static constexpr bool GATHER = false; static constexpr bool AUX = false;
    DI bool next(int i, pg::Unit& u) const {
        const int L = i * G + c; const int ne = __builtin_amdgcn_readfirstlane(offs[65]) * 4; if (L >= ne + (QT / 256) * 4) return false;
        if (L < ne) { pg::decode_tiles(L, ne >> 2, 4, u.pm, u.pn); u.kind = 0; u.aux = __builtin_amdgcn_readfirstlane(TILE[u.pm]); }
        else { pg::decode_tiles(L - ne, QT / 256, 4, u.pm, u.pn); u.kind = 1; u.aux = NEXP; }
        return true;
    }
    DI const char* a_tile(const pg::Unit& u) const { const long d = (const char*)HIDS - (const char*)HID; return (const char*)HID + (u.kind ? d : 0L) + (size_t)u.pm * 256 * 256 * 2; }
    DI int a_row(const pg::Unit&, int) const { return 0; }
    DI const char* b_base(const pg::Unit& u) const { return (const char*)(W2 + ((size_t)u.aux * 1024 + u.pn * 256) * 256); }
};
struct EpiQ5 {
    const int* ROWL; unsigned char* AOUT; bf16_t* SOUT;
    DI void operator()(const f32x4 (&acc)[2][2][4][2], const pg::Unit& u, int wr, int wc, int fr, int fq, int) const {
        if (u.kind == 1) {
            bf16_t* base = SOUT + (size_t)(u.pm * 256 + wr * 64 + fr) * 1024 + u.pn * 256 + wc * 32 + 8 * fq;
#pragma unroll
            for (int ai = 0; ai < 2; ++ai)
#pragma unroll
                for (int m = 0; m < 4; ++m)
#pragma unroll
                    for (int bj = 0; bj < 2; ++bj) *(u32x4*)(base + (size_t)(ai * 128 + m * 16) * 1024 + bj * 128) = pg::pack8(acc[ai][bj][m][0], acc[ai][bj][m][1]);
            return;
        }
        int ids[8];
#pragma unroll
        for (int k = 0; k < 8; ++k) ids[k] = ROWL[u.pm * 256 + (k >> 2) * 128 + wr * 64 + (k & 3) * 16 + fr];
#pragma unroll
        for (int ai = 0; ai < 2; ++ai)
#pragma unroll
            for (int m = 0; m < 4; ++m) {
                const int id = ids[ai * 4 + m];
                if (id >= 0) {
                    u32x4 pk;
                    { const f32x4 v0 = acc[ai][0][m][0], v1 = acc[ai][0][m][1];
                      int lo = __builtin_amdgcn_cvt_pk_fp8_f32(v0[0], v0[1], 0, false); lo = __builtin_amdgcn_cvt_pk_fp8_f32(v0[2], v0[3], lo, true);
                      int hi2 = __builtin_amdgcn_cvt_pk_fp8_f32(v1[0], v1[1], 0, false); hi2 = __builtin_amdgcn_cvt_pk_fp8_f32(v1[2], v1[3], hi2, true);
                      pk.x = (unsigned)lo; pk.y = (unsigned)hi2; }
                    { const f32x4 v0 = acc[ai][1][m][0], v1 = acc[ai][1][m][1];
                      int lo = __builtin_amdgcn_cvt_pk_fp8_f32(v0[0], v0[1], 0, false); lo = __builtin_amdgcn_cvt_pk_fp8_f32(v0[2], v0[3], lo, true);
                      int hi2 = __builtin_amdgcn_cvt_pk_fp8_f32(v1[0], v1[1], 0, false); hi2 = __builtin_amdgcn_cvt_pk_fp8_f32(v1[2], v1[3], hi2, true);
                      pk.z = (unsigned)lo; pk.w = (unsigned)hi2; }
                    *(u32x4*)(AOUT + (size_t)id * 1024 + u.pn * 256 + wc * 64 + fq * 16) = pk;
                }
            }
    }
};
DI void q6_combine(KA a, int grp, int qi, int bid, int nblk, int tid_in, int nostore) {
    int tid_ = tid_in; asm volatile("" : "+v"(tid_)); const int tid = tid_, wid = tid >> 6, lane = tid & 63;
    const unsigned char* AOUT = (const unsigned char*)(a.ws + M_AOUT); const bf16_t* SOUT = (const bf16_t*)(a.ws + M_SOUT);
    const float* MOD = (const float*)(a.ws + WS_MOD); const float* g = a.in[I_GPOST2];
    const int cl = (lane >> 5) * 256 + (lane & 1) * 128 + ((lane >> 3) & 3) * 32 + ((lane >> 1) & 3) * 8;
    f32x4 gg[4];
#pragma unroll
    for (int i = 0; i < 4; ++i) gg[i] = *(const f32x4*)(g + (i >> 1) * 512 + cl + (i & 1) * 4);
    const int stride = nblk * 8;
    for (int t0 = bid * 8 + wid; t0 < QT; t0 += 2 * stride) {
        u32x4 x1w[2][2], sw[2][2]; f32x4 tw[2][2], gt[2][4]; u32x2 ar[2][8][2];
#pragma unroll
        for (int j = 0; j < 2; ++j) {
            const int t = min(t0 + j * stride, QT - 1), grow = grp * TG + qi * QT + t; const float* md = MOD + (grow >> 11) * 6144;
            const bf16_t* x1p = (const bf16_t*)(a.ws + G_X1) + (size_t)(qi * QT + t) * 1024;
            x1w[j][0] = __builtin_nontemporal_load((const u32x4*)(x1p + cl)); x1w[j][1] = __builtin_nontemporal_load((const u32x4*)(x1p + 512 + cl));
            sw[j][0] = *(const u32x4*)(SOUT + (size_t)t * 1024 + cl); sw[j][1] = *(const u32x4*)(SOUT + (size_t)t * 1024 + 512 + cl);
            const float* twp = (const float*)(a.ws + M_TOPW) + (size_t)(qi * QT + t) * 8;
            tw[j][0] = *(const f32x4*)twp; tw[j][1] = *(const f32x4*)(twp + 4);
#pragma unroll
            for (int i = 0; i < 4; ++i) gt[j][i] = *(const f32x4*)(md + 5120 + (i >> 1) * 512 + cl + (i & 1) * 4);
#pragma unroll
            for (int s = 0; s < 8; ++s) { const unsigned char* rp = AOUT + ((size_t)t * 8 + s) * 1024;
                ar[j][s][0] = __builtin_nontemporal_load((const u32x2*)(rp + lane * 8)); ar[j][s][1] = __builtin_nontemporal_load((const u32x2*)(rp + 512 + lane * 8)); }
        }
#pragma unroll
        for (int j = 0; j < 2; ++j) {
            const int t = t0 + j * stride;
            if (t >= QT) break;
            const int grow = grp * TG + qi * QT + t; float* od = a.out + (size_t)grow * 1024;
            float f[16];
            { const u32x4 s0 = sw[j][0], s1 = sw[j][1];
              f[0] = bflo(s0.x); f[1] = bfhi(s0.x); f[2] = bflo(s0.y); f[3] = bfhi(s0.y); f[4] = bflo(s0.z); f[5] = bfhi(s0.z); f[6] = bflo(s0.w); f[7] = bfhi(s0.w);
              f[8] = bflo(s1.x); f[9] = bfhi(s1.x); f[10] = bflo(s1.y); f[11] = bfhi(s1.y); f[12] = bflo(s1.z); f[13] = bfhi(s1.z); f[14] = bflo(s1.w); f[15] = bfhi(s1.w); }
#pragma unroll
            for (int s = 0; s < 8; ++s) {
                const float wq = (s < 4) ? tw[j][0][s & 3] : tw[j][1][s & 3];
                const u32x2 s0 = ar[j][s][0], s1 = ar[j][s][1];
#define Q6_ADD4(base_, w_) do { f[(base_) + 0] += wq * __builtin_amdgcn_cvt_f32_fp8((int)(w_), 0); f[(base_) + 1] += wq * __builtin_amdgcn_cvt_f32_fp8((int)(w_), 1); \
                f[(base_) + 2] += wq * __builtin_amdgcn_cvt_f32_fp8((int)(w_), 2); f[(base_) + 3] += wq * __builtin_amdgcn_cvt_f32_fp8((int)(w_), 3); } while (0)
                Q6_ADD4(0, s0.x); Q6_ADD4(4, s0.y); Q6_ADD4(8, s1.x); Q6_ADD4(12, s1.y);
#undef Q6_ADD4
            }
            float ss = 0.f;
#pragma unroll
            for (int i = 0; i < 16; ++i) ss += f[i] * f[i];
            ss = wave_sum(ss, lane);
            const float rs = rsqrtf(ss * (1.0f / 1024.0f) + EPS);
#pragma unroll
            for (int hf = 0; hf < 2; ++hf)
#pragma unroll
                for (int q4 = 0; q4 < 2; ++q4) {
                    const int c = hf * 512 + cl + q4 * 4;
                    const u32x4 xw = x1w[j][hf]; const unsigned xa = q4 ? xw.z : xw.x, xb = q4 ? xw.w : xw.y;
                    const f32x4 x1 = {bflo(xa), bfhi(xa), bflo(xb), bfhi(xb)};
                    f32x4 fv = {f[hf * 8 + q4 * 4 + 0], f[hf * 8 + q4 * 4 + 1], f[hf * 8 + q4 * 4 + 2], f[hf * 8 + q4 * 4 + 3]};
                    const f32x4 ov = x1 + gt[j][hf * 2 + q4] * (fv * rs * gg[hf * 2 + q4]);
                    if (!nostore) __builtin_nontemporal_store(ov, (f32x4*)(od + c)); else asm volatile("" :: "v"(ov[0]), "v"(ov[1]), "v"(ov[2]), "v"(ov[3]));
                }
        }
    }
}

constexpr int STEPS_PER_GRP = 13 + NQ * 2;
constexpr int N_STEPS = 1 + NGRP * STEPS_PER_GRP;
template <unsigned PH_MASK>
__global__ void __launch_bounds__(NT, 2) fwd(Args a_) {
    extern __shared__ __attribute__((aligned(16))) unsigned char lds_raw[];
    LAS unsigned char* lds = (LAS unsigned char*)lds_raw;
    const int wave_id = __builtin_amdgcn_readfirstlane(threadIdx.x >> 6);
#define TID_NOW (wave_id * 64 + lane_now())
    volatile LAS unsigned* misc = (volatile LAS unsigned*)(lds + MISC_OFF);
    { const int t = TID_NOW; if (t < 4) misc[t] = 0u; }
    __syncthreads();
    const int lo = a_.ph_lo, hi = a_.ph_hi;
    XcdBarrier bar; bar.bar = (unsigned*)(a_.ws + WS_CTL); bar.x = 0; bar.st = misc;
    if (hi - lo > 1) bar = xcd_barrier_post((unsigned*)(a_.ws + WS_CTL), misc, TID_NOW);
#define IN(k) (lo <= (k) && (k) < hi)
#define SEAM(k) do { if (IN(k) && IN((k) + 1)) xcd_barrier(bar, TID_NOW); } while (0)
#define FRESH_ARGS KArgs* ap_ = (KArgs*)__builtin_amdgcn_kernarg_segment_ptr(); asm volatile("" : "+s"(ap_)); KA a = *ap_; unsigned char* ws = a.ws; (void)ws; int bid = blockIdx.x, nblk = gridDim.x; asm volatile("" : "+s"(bid), "+s"(nblk)); int tid = TID_NOW; asm volatile("" : "+v"(tid))
    _Pragma("unroll 1") for (int rep_ = 0; rep_ < (((REPEAT_MASK >> 0) & 1u) ? REPEAT_N : 1); ++rep_) if (((PH_MASK >> 0) & 1) && IN(0)) { FRESH_ARGS; p0_prologue(a, lds, bid, nblk, tid); SEAM(0); }
#pragma unroll 1
    for (int grp = 0; grp < NGRP; ++grp) {
        const int base = 1 + grp * STEPS_PER_GRP;
        _Pragma("unroll 1") for (int rep_ = 0; rep_ < (((REPEAT_MASK >> 1) & 1u) ? REPEAT_N : 1); ++rep_) if (((PH_MASK >> 1) & 1) && IN(base + 0)) { FRESH_ARGS; p1_norm(a, grp, bid, nblk, tid); SEAM(base + 0); }
        _Pragma("unroll 1") for (int rep_ = 0; rep_ < (((REPEAT_MASK >> 2) & 1u) ? REPEAT_N : 1); ++rep_) if (((PH_MASK >> 2) & 1) && IN(base + 1)) { FRESH_ARGS;
            SchedInproj S{(const bf16_t*)(ws + G_H), (const bf16_t*)(ws + WS_WIN), (const bf16_t*)(ws + WS_WV), nblk, bid};
            EpiInproj E{(bf16_t*)(ws + G_Q), (bf16_t*)(ws + G_K), (bf16_t*)(ws + G_VT), (bf16_t*)(ws + G_XBC), (float*)(ws + G_DT), (const float*)(ws + WS_ROPE), a.in[I_DTB], (bf16_t*)(ws + G_HALO)};
            pg::gemm_phase(lds, 1024, S, E, tid);
            SEAM(base + 1);
        }
        _Pragma("unroll 1") for (int rep_ = 0; rep_ < (((REPEAT_MASK >> 15) & 1u) ? REPEAT_N : 1); ++rep_) if (((PH_MASK >> 15) & 1) && IN(base + 2)) { FRESH_ARGS; p2b_conv(a, bid, nblk, tid, rep_); SEAM(base + 2); }
        _Pragma("unroll 1") for (int rep_ = 0; rep_ < (((REPEAT_MASK >> 3) & 1u) ? REPEAT_N : 1); ++rep_) if (((PH_MASK >> 3) & 1) && IN(base + 3)) { FRESH_ARGS;
            unsigned* qhead = (unsigned*)(ws + WS_CTL) + CW_Q3 + grp * 64 + rep_ * 16;
            volatile LAS int* qslot = (volatile LAS int*)(lds + MISC_OFF + 64);
#pragma unroll 1
            for (;;) {
                if (tid == 0) qslot[0] = (int)__hip_atomic_fetch_add(qhead, 1u, __ATOMIC_RELAXED, __HIP_MEMORY_SCOPE_AGENT);
                __syncthreads();
                const int L = __builtin_amdgcn_readfirstlane(qslot[0]);
                __syncthreads();
                if (L >= 64 * (1 + SSD_REPEAT) + 1024 + ((grp == 0 && rep_ == 0) ? CVT_ENTRIES : 0)) break;
                unsigned long long t0_ = 0; if (PROBE_UNIT >= 0 && grp == 0 && L == PROBE_UNIT) t0_ = __builtin_amdgcn_s_memrealtime();
#ifndef NO_SSD
                if (L < 64 * (1 + SSD_REPEAT)) { const int u = L & 63; ssd_unit(a, lds, u >> 3, (u >> 1) & 3, u & 1, tid); }
#endif
#ifndef NO_ATTN
                if (L >= 64 * (1 + SSD_REPEAT) && L < 64 * (1 + SSD_REPEAT) + 1024) { const int j = L - 64 * (1 + SSD_REPEAT); attn_unit(a, lds, grp, j >> 7, (j >> 4) & 7, (j >> 1) & 7, j & 1, tid); }
                if (L >= 64 * (1 + SSD_REPEAT) + 1024) { const int e0 = (L - 64 * (1 + SSD_REPEAT) - 1024) * CVT_ENTRY; cvt_all(a, e0, e0 + CVT_ENTRY, 0, 1, tid, lds); }
#endif
                __syncthreads();
                if (PROBE_UNIT >= 0 && grp == 0 && L == PROBE_UNIT && tid == 0) *(float*)(ws + WS_CTL + 15360) = (float)(__builtin_amdgcn_s_memrealtime() - t0_) * 0.001f;
            }
            SEAM(base + 3);
        }
        _Pragma("unroll 1") for (int rep_ = 0; rep_ < (((REPEAT_MASK >> 4) & 1u) ? REPEAT_N : 1); ++rep_) if (((PH_MASK >> 4) & 1) && IN(base + 4)) { FRESH_ARGS;
            attn_finalize(a, bid, nblk, tid);
            SchedPlain S{(const bf16_t*)(ws + G_H), (const bf16_t*)(ws + WS_WZG), TG / 256, 12, 1024, nblk, bid};
            EpiZG E{(const bf16_t*)(ws + G_YF), (const bf16_t*)(ws + G_YB), (bf16_t*)(ws + G_YN), (bf16_t*)(ws + G_G), a.in[I_GSSD], (LAS float*)(lds + EPI_OFF)};
            pg::gemm_phase(lds, 1024, S, E, tid);
            SEAM(base + 4);
        }
        _Pragma("unroll 1") for (int rep_ = 0; rep_ < (((REPEAT_MASK >> 5) & 1u) ? REPEAT_N : 1); ++rep_) if (((PH_MASK >> 5) & 1) && IN(base + 5)) { FRESH_ARGS;
            SchedBranches S{(const bf16_t*)(ws + G_O), (const bf16_t*)(ws + G_YN), (const bf16_t*)(ws + WS_WA), (const bf16_t*)(ws + WS_WS), nblk, bid};
            EpiBranches E{(const bf16_t*)(ws + G_G), (bf16_t*)(ws + G_P), (bf16_t*)(ws + G_U)};
            pg::gemm_phase(lds, 1024, S, E, tid);
            SEAM(base + 5);
        }
        _Pragma("unroll 1") for (int rep_ = 0; rep_ < (((REPEAT_MASK >> 6) & 1u) ? REPEAT_N : 1); ++rep_) if (((PH_MASK >> 6) & 1) && IN(base + 6)) { FRESH_ARGS;

        }
        _Pragma("unroll 1") for (int rep_ = 0; rep_ < (((REPEAT_MASK >> 7) & 1u) ? REPEAT_N : 1); ++rep_) if (((PH_MASK >> 7) & 1) && IN(base + 7)) { FRESH_ARGS;
            SchedPlain S{(const bf16_t*)(ws + G_U), (const bf16_t*)(ws + WS_WO), TG / 256, 4, 1024, nblk, bid};
            EpiPlainBf16 E{(bf16_t*)(ws + G_MIX), 1024};
            pg::gemm_phase(lds, 1024, S, E, tid);
            SEAM(base + 7);
        }
        _Pragma("unroll 1") for (int rep_ = 0; rep_ < (((REPEAT_MASK >> 8) & 1u) ? REPEAT_N : 1); ++rep_) if (((PH_MASK >> 8) & 1) && IN(base + 8)) { FRESH_ARGS; p8_post(a, grp, bid, nblk, tid); SEAM(base + 8); }
        _Pragma("unroll 1") for (int rep_ = 0; rep_ < (((REPEAT_MASK >> 9) & 1u) ? REPEAT_N : 1); ++rep_) if (((PH_MASK >> 9) & 1) && IN(base + 9)) { FRESH_ARGS;
            SchedPlain S{(const bf16_t*)(ws + G_H2), (const bf16_t*)(ws + WS_W1) + (size_t)NEXP * 512 * 1024, TG / 256, 3, 1024, nblk, bid};
            EpiQ1 E{(bf16_t*)(ws + M_HIDS), (float*)(ws + M_LOG)};
            pg::gemm_phase(lds, 1024, S, E, tid);
            SEAM(base + 9);
        }
        _Pragma("unroll 1") for (int rep_ = 0; rep_ < (((REPEAT_MASK >> 10) & 1u) ? REPEAT_N : 1); ++rep_) if (((PH_MASK >> 10) & 1) && IN(base + 10)) { FRESH_ARGS; q2_route(a, lds, bid, nblk, tid); SEAM(base + 10); }
        _Pragma("unroll 1") for (int rep_ = 0; rep_ < (((REPEAT_MASK >> 11) & 1u) ? REPEAT_N : 1); ++rep_) if (((PH_MASK >> 11) & 1) && IN(base + 11)) { FRESH_ARGS; q3_scatter(a, lds, bid, nblk, tid); SEAM(base + 11); }
        _Pragma("unroll 1") for (int rep_ = 0; rep_ < (((REPEAT_MASK >> 12) & 1u) ? REPEAT_N : 1); ++rep_) if (((PH_MASK >> 12) & 1) && IN(base + 12)) { FRESH_ARGS;
            LAS int* offs = (LAS int*)(lds + EPI_OFF); moe_offsets(a, offs, lds, tid);
            SchedQ4 S{(const bf16_t*)(ws + G_H2), (const bf16_t*)(ws + WS_W1), (const int*)(ws + M_ROWL), offs, (const LAS int*)(lds + YT_OFF), nblk, bid};
            EpiQ4 E{(bf16_t*)(ws + M_HID)};
            pg::gemm_phase(lds, 1024, S, E, tid);
            SEAM(base + 12);
        }
#pragma unroll 1
        for (int qi = 0; qi < NQ; ++qi) {
            const int qb = base + 13 + qi * 2;
            _Pragma("unroll 1") for (int rep_ = 0; rep_ < (((REPEAT_MASK >> 13) & 1u) ? REPEAT_N : 1); ++rep_) if (((PH_MASK >> 13) & 1) && IN(qb + 0)) { FRESH_ARGS;
                LAS int* offs = (LAS int*)(lds + EPI_OFF); moe_offsets(a, offs, lds, tid);
                SchedQ5 S{(const bf16_t*)(ws + M_HID) + (size_t)qi * MAXROWS * 256, (const bf16_t*)(ws + M_HIDS) + (size_t)qi * QT * 256, (const bf16_t*)(ws + WS_W2), offs + qi * 128, (const LAS int*)(lds + YT_OFF) + qi * 1024, nblk, bid};
                EpiQ5 E{(const int*)(ws + M_ROWL) + (size_t)qi * MAXROWS, (unsigned char*)(ws + M_AOUT), (bf16_t*)(ws + M_SOUT)};
                pg::gemm_phase(lds, 256, S, E, tid);
                SEAM(qb + 0);
            }
            _Pragma("unroll 1") for (int rep_ = 0; rep_ < (((REPEAT_MASK >> 14) & 1u) ? REPEAT_N : 1); ++rep_) if (((PH_MASK >> 14) & 1) && IN(qb + 1)) { FRESH_ARGS; q6_combine(a, grp, qi, bid, nblk, tid, rep_); SEAM(qb + 1); }
        }
    }
    if (PROBE_UNIT >= 0 && hi == N_STEPS && blockIdx.x == 0 && TID_NOW == 0) { __builtin_amdgcn_fence(__ATOMIC_ACQUIRE, "agent"); a_.out[0] += *(volatile float*)(a_.ws + WS_CTL + 15360); }
#undef IN
#undef SEAM
}

typedef void (*KernFn)(Args);
template <unsigned M> static KernFn kern() { return fwd<M>; }
extern "C" void kernel_launch(void* const* d_in, const int* in_sizes, int n_in, void* d_out, int out_size, void* d_ws, size_t ws_size, hipStream_t stream) {
    static int grid = 0;
    if (grid == 0) {
        if (n_in != 33 || ws_size < WS_NEED) { fprintf(stderr, "kernel_launch: need 33 inputs and %zu bytes of workspace (got %d, %zu)\n", (size_t)WS_NEED, n_in, ws_size); grid = -1; return; }
        int dev = 0, cus = 0;
        if (hipGetDevice(&dev) != hipSuccess || hipDeviceGetAttribute(&cus, hipDeviceAttributeMultiprocessorCount, dev) != hipSuccess) { grid = -1; return; }
#if N_LAUNCH_MODE == 1
        if (hipFuncSetAttribute((const void*)kern<0xFFFFu>(), hipFuncAttributeMaxDynamicSharedMemorySize, LDS_BYTES) != hipSuccess) { fprintf(stderr, "kernel_launch: hipFuncSetAttribute failed\n"); grid = -1; return; }
        int per_cu = 0;
        if (hipOccupancyMaxActiveBlocksPerMultiprocessor(&per_cu, (const void*)kern<0xFFFFu>(), NT, LDS_BYTES) != hipSuccess || per_cu < 1) fprintf(stderr, "kernel_launch: occupancy query reports %d\n", per_cu);
#endif
        (void)hipGetLastError();
        grid = cus;
    }
    if (grid < 0) return;
    (void)in_sizes; (void)out_size;
    (void)hipMemsetAsync((char*)d_ws + WS_CTL, 0, CTL_BYTES, stream);
    Args a{};
    for (int i = 0; i < 33; ++i) a.in[i] = (const float*)d_in[i];
    a.out = (float*)d_out; a.ws = (unsigned char*)d_ws;
#if N_LAUNCH_MODE == 1
    a.ph_lo = 0; a.ph_hi = N_STEPS;
    hipLaunchKernelGGL(kern<0xFFFFu>(), dim3(grid), dim3(NT), LDS_BYTES, stream, a);
#endif
}
```
